# Optimizing an MI355X kernel written in HIP

```python
import math
import jax, jax.numpy as jnp
from jax import lax
import numpy as np

D_MODEL = 1024
BATCH = 4
SEQ = 4096
DEPTH = 2
DEC_BATCH = 32
DEC_SEQ = 8
PAST_LEN = 8192
PAGE_SIZE = 128

N_EVEN = (DEPTH + 1) // 2
N_ODD = DEPTH // 2
MIX_W = D_MODEL
HALF_W = MIX_W // 2
A_HEADS = 4
A_V = HALF_W // A_HEADS
A_QK = A_V // 2
QK_W = A_HEADS * 2 * A_QK
V_W = A_HEADS * A_V
Q_BLOCK = 128
B_W = HALF_W
B_BLOCKS = 8
B_BS = B_W // B_BLOCKS
B_CONV = 4
C_RG = 8.0
C_W = HALF_W
C_GROUP = 16
C_GROUPS = C_W // C_GROUP
C_STATE = 64
D_W = HALF_W
D_CONV = 31
D_FF = 2752
IN_EVEN = 2 * QK_W + V_W + 2 * B_W
IN_ODD = C_W + 2 * D_W
EPS = 1e-6

kernel_name = 'hybrid_diffattn_rglru_s5_conformer_step'


def _rmsnorm(x, g):
    x32 = x.astype(jnp.float32)
    y = x32 * lax.rsqrt(jnp.mean(x32 * x32, axis=-1, keepdims=True) + EPS)
    return (y * g.astype(jnp.float32)).astype(x.dtype)


def _layernorm(x, g, b):
    x32 = x.astype(jnp.float32)
    xc = x32 - jnp.mean(x32, axis=-1, keepdims=True)
    y = xc * lax.rsqrt(jnp.mean(xc * xc, axis=-1, keepdims=True) + EPS)
    return (y * g.astype(jnp.float32) + b.astype(jnp.float32)).astype(x.dtype)


def _swiglu_ffn(x, g, w_gu, w_down):
    gate, up = jnp.split(_rmsnorm(x, g) @ w_gu, 2, axis=-1)
    return (jax.nn.silu(gate) * up) @ w_down


def _causal_dwconv(x, buf, w, b):
    inp = jnp.concatenate([buf.astype(x.dtype), x], axis=1)
    out = lax.conv_general_dilated(inp, w[:, None, :].astype(x.dtype), (1,), 'VALID',
                                   dimension_numbers=('NWC', 'WIO', 'NWC'),
                                   feature_group_count=x.shape[-1])
    return out + b.astype(x.dtype), inp[:, inp.shape[1] - (w.shape[0] - 1):]


def _diff_attn_core(q, q_pos, keys, vals, k_pos, lam):
    s = jnp.einsum('nqhjd,nkhjd->nhjqk', q, keys).astype(jnp.float32) * (A_QK ** -0.5)
    s = jnp.where(k_pos[None, :] <= q_pos[:, None], s, -jnp.inf)
    p = jax.nn.softmax(s, axis=-1)
    w = p[:, :, 0] - lam * p[:, :, 1]
    return jnp.einsum('nhqk,nkhd->nqhd', w.astype(vals.dtype), vals)


def _diff_attn_prompt(q, k, v, lam):
    n, t = q.shape[:2]
    k_pos = jnp.arange(t)

    def block(i):
        start = i * Q_BLOCK
        qb = lax.dynamic_slice_in_dim(q, start, Q_BLOCK, axis=1)
        return _diff_attn_core(qb, start + jnp.arange(Q_BLOCK), k, v, k_pos, lam)

    out = lax.map(block, jnp.arange(t // Q_BLOCK))
    return jnp.moveaxis(out, 0, 1).reshape(n, t, A_HEADS, A_V)


def _linear_scan(a, b):
    def comb(e1, e2):
        return (e1[0] * e2[0], e2[0] * e1[1] + e2[1])
    _, h = lax.associative_scan(comb, (a, b), axis=1)
    return h


def _complex_scan(ar, ai, br, bi):
    def comb(e1, e2):
        a1r, a1i, b1r, b1i = e1
        a2r, a2i, b2r, b2i = e2
        return (a2r * a1r - a2i * a1i, a2r * a1i + a2i * a1r,
                a2r * b1r - a2i * b1i + b2r, a2r * b1i + a2i * b1r + b2i)
    _, _, hr, hi = lax.associative_scan(comb, (ar, ai, br, bi), axis=1)
    return hr, hi


def _rglru(xb, gb, conv0, h0, conv_w, conv_b, gate_w, gate_b, lam_p):
    f32 = jnp.float32
    n, t, _ = xb.shape
    xc, conv_new = _causal_dwconv(xb, conv0, conv_w, conv_b)
    xblk = xc.reshape(n, t, B_BLOCKS, B_BS)
    pre = jnp.einsum('ntbi,gbij->gntbj', xblk, gate_w).reshape(2, n, t, B_W)
    gates = jax.nn.sigmoid(pre.astype(f32) + gate_b.astype(f32)[:, None, None, :])
    log_a = -C_RG * gates[0] * jax.nn.softplus(-lam_p.astype(f32))
    a = jnp.exp(log_a)
    b = jnp.sqrt(-jnp.expm1(2.0 * log_a)) * (gates[1] * xc.astype(f32))
    b = b.at[:, 0].add(a[:, 0] * h0.astype(f32))
    h = _linear_scan(a, b)
    y = jax.nn.gelu(gb.astype(f32)) * h
    return y.astype(xb.dtype), conv_new, h[:, -1].astype(xb.dtype)


def _s5(u, re0, im0, a_re, a_im, log_dt, b_re, b_im, c_re, c_im, d, glu_w, glu_b):
    f32 = jnp.float32
    n, t, _ = u.shape
    u32 = u.astype(f32).reshape(n, t, C_GROUPS, C_GROUP)
    a_re = a_re.astype(f32)
    a_im = a_im.astype(f32)
    dt = jnp.exp(log_dt.astype(f32))[:, None]
    mag = jnp.exp(dt * a_re)
    ab_re = mag * jnp.cos(dt * a_im)
    ab_im = mag * jnp.sin(dt * a_im)
    den = a_re * a_re + a_im * a_im
    nr = ab_re - 1.0
    coef_re = (nr * a_re + ab_im * a_im) / den
    coef_im = (ab_im * a_re - nr * a_im) / den
    bu_re = jnp.einsum('ntgc,gpc->ntgp', u32, b_re.astype(f32))
    bu_im = jnp.einsum('ntgc,gpc->ntgp', u32, b_im.astype(f32))
    v_re = coef_re * bu_re - coef_im * bu_im
    v_im = coef_re * bu_im + coef_im * bu_re
    h0r = re0.astype(f32)
    h0i = im0.astype(f32)
    v_re = v_re.at[:, 0].add(ab_re * h0r - ab_im * h0i)
    v_im = v_im.at[:, 0].add(ab_re * h0i + ab_im * h0r)
    s_re, s_im = _complex_scan(jnp.broadcast_to(ab_re, v_re.shape), jnp.broadcast_to(ab_im, v_re.shape), v_re, v_im)
    y = (jnp.einsum('ntgp,gcp->ntgc', s_re, c_re.astype(f32))
         - jnp.einsum('ntgp,gcp->ntgc', s_im, c_im.astype(f32))
         + d.astype(f32).reshape(C_GROUPS, C_GROUP) * u32).reshape(n, t, C_W)
    z = jax.nn.gelu(y)
    out = z * jax.nn.sigmoid(z @ glu_w.astype(f32) + glu_b.astype(f32))
    return out.astype(u.dtype), s_re[:, -1].astype(u.dtype), s_im[:, -1].astype(u.dtype)


def _conformer_conv(dp, conv0, w, b, ln_g, ln_b):
    val, gate = jnp.split(dp, 2, axis=-1)
    g = val * jax.nn.sigmoid(gate)
    c, conv_new = _causal_dwconv(g, conv0, w, b)
    return jax.nn.silu(_layernorm(c, ln_g, ln_b)), conv_new


def _run_group(x, cache_k, cache_v, page_table, conv_b0, h_b0, c_re0, c_im0, conv_d0, p):
    n, t, _ = x.shape
    ks, vs, cbs, hbs, cres, cims, cds = [], [], [], [], [], [], []
    for l in range(DEPTH):
        x = x + 0.5 * _swiglu_ffn(x, p['ffn1_g'][l], p['ffn1_w_gu'][l], p['ffn1_w_down'][l])
        h = _rmsnorm(x, p['mix_g'][l])
        if l % 2 == 0:
            e = l // 2
            proj = h @ p['even_w_in'][e]
            q, k, v, xb, gb = jnp.split(proj, [QK_W, 2 * QK_W, 2 * QK_W + V_W, 2 * QK_W + V_W + B_W], axis=-1)
            q = _rmsnorm(q.reshape(n, t, A_HEADS, 2, A_QK), p['a_q_g'][e])
            k = _rmsnorm(k.reshape(n, t, A_HEADS, 2, A_QK), p['a_k_g'][e])
            v = v.reshape(n, t, A_HEADS, A_V)
            lam_init = 0.8 - 0.6 * math.exp(-0.3 * l)
            lv = p['a_lambda'][e].astype(jnp.float32)
            lam = jnp.exp(jnp.sum(lv[0] * lv[1])) - jnp.exp(jnp.sum(lv[2] * lv[3])) + lam_init
            if cache_k is None:
                att = _diff_attn_prompt(q, k, v, lam)
            else:
                past_len = page_table.shape[1] * cache_k.shape[2]
                pk = cache_k[e][page_table].reshape(n, past_len, A_HEADS, 2, A_QK).astype(k.dtype)
                pv = cache_v[e][page_table].reshape(n, past_len, A_HEADS, A_V).astype(v.dtype)
                att = _diff_attn_core(q, past_len + jnp.arange(t), jnp.concatenate([pk, k], axis=1),
                                      jnp.concatenate([pv, v], axis=1), jnp.arange(past_len + t), lam)
            att = (_rmsnorm(att, p['a_head_g'][e]) * (1.0 - lam_init)).reshape(n, t, V_W)
            rec, cb, hb = _rglru(xb, gb, conv_b0[e], h_b0[e], p['b_conv_w'][e], p['b_conv_b'][e],
                                 p['b_gate_w'][e], p['b_gate_b'][e], p['b_lambda'][e])
            y = jnp.concatenate([att, rec], axis=-1) @ p['even_w_out'][e]
            ks.append(k.reshape(n, t, A_HEADS, 2 * A_QK))
            vs.append(v)
            cbs.append(cb)
            hbs.append(hb)
        else:
            o = l // 2
            proj = h @ p['odd_w_in'][o]
            u, dp = jnp.split(proj, [C_W], axis=-1)
            c_out, cre, cim = _s5(u, c_re0[o], c_im0[o], p['c_a_re'][o], p['c_a_im'][o], p['c_log_dt'][o],
                                  p['c_b_re'][o], p['c_b_im'][o], p['c_c_re'][o], p['c_c_im'][o],
                                  p['c_d'][o], p['c_glu_w'][o], p['c_glu_b'][o])
            d_out, cd = _conformer_conv(dp, conv_d0[o], p['d_conv_w'][o], p['d_conv_b'][o],
                                        p['d_ln_g'][o], p['d_ln_b'][o])
            y = jnp.concatenate([c_out, d_out], axis=-1) @ p['odd_w_out'][o]
            cres.append(cre)
            cims.append(cim)
            cds.append(cd)
        x = x + y
        x = x + 0.5 * _swiglu_ffn(x, p['ffn2_g'][l], p['ffn2_w_gu'][l], p['ffn2_w_down'][l])
    return (x, jnp.stack(ks), jnp.stack(vs), jnp.stack(cbs), jnp.stack(hbs),
            jnp.stack(cres), jnp.stack(cims), jnp.stack(cds))


def setup_inputs(seed: int = 0) -> dict:
    key = jax.random.key(seed)
    ks = iter(jax.random.split(key, 64))
    f32 = jnp.float32

    def nrm(shape, scale):
        return scale * jax.random.normal(next(ks), shape, f32)

    def gain(shape):
        return 1.0 + nrm(shape, 0.01)

    n_pages = PAST_LEN // PAGE_SIZE
    n_used = DEC_BATCH * n_pages
    n_pool = n_used + n_used // 4
    page_table = jax.random.permutation(next(ks), n_pool)[:n_used].reshape(DEC_BATCH, n_pages).astype(jnp.int32)

    u_a = jax.random.uniform(next(ks), (N_EVEN, B_W), f32, 0.9, 0.999)
    a_base = u_a ** (1.0 / C_RG)
    b_lambda = jnp.log(a_base) - jnp.log1p(-a_base)

    c_a_re = -0.5 + nrm((N_ODD, C_GROUPS, C_STATE), 0.01)
    c_a_im = math.pi * jnp.arange(C_STATE, dtype=f32) + nrm((N_ODD, C_GROUPS, C_STATE), 0.01)
    c_log_dt = jax.random.uniform(next(ks), (N_ODD, C_GROUPS), f32, math.log(1e-3), math.log(1e-1))

    return {
        'x_prompt': nrm((BATCH, SEQ, D_MODEL), 1.0),
        'x_sample': nrm((DEC_BATCH, DEC_SEQ, D_MODEL), 1.0),
        'cache_k': nrm((N_EVEN, n_pool, PAGE_SIZE, A_HEADS, 2 * A_QK), 1.0),
        'cache_v': nrm((N_EVEN, n_pool, PAGE_SIZE, A_HEADS, A_V), 1.0),
        'state_conv_b': nrm((N_EVEN, DEC_BATCH, B_CONV - 1, B_W), 1.0),
        'state_h_b': nrm((N_EVEN, DEC_BATCH, B_W), 0.5),
        'state_c_re': nrm((N_ODD, DEC_BATCH, C_GROUPS, C_STATE), 0.1),
        'state_c_im': nrm((N_ODD, DEC_BATCH, C_GROUPS, C_STATE), 0.1),
        'state_conv_d': nrm((N_ODD, DEC_BATCH, D_CONV - 1, D_W), 1.0),
        'page_table': page_table,
        'ffn1_g': gain((DEPTH, D_MODEL)),
        'ffn1_w_gu': nrm((DEPTH, D_MODEL, 2 * D_FF), D_MODEL ** -0.5),
        'ffn1_w_down': nrm((DEPTH, D_FF, D_MODEL), D_FF ** -0.5),
        'mix_g': gain((DEPTH, D_MODEL)),
        'ffn2_g': gain((DEPTH, D_MODEL)),
        'ffn2_w_gu': nrm((DEPTH, D_MODEL, 2 * D_FF), D_MODEL ** -0.5),
        'ffn2_w_down': nrm((DEPTH, D_FF, D_MODEL), D_FF ** -0.5),
        'even_w_in': nrm((N_EVEN, D_MODEL, IN_EVEN), D_MODEL ** -0.5),
        'even_w_out': nrm((N_EVEN, MIX_W, D_MODEL), MIX_W ** -0.5),
        'a_q_g': gain((N_EVEN, A_QK)),
        'a_k_g': gain((N_EVEN, A_QK)),
        'a_lambda': nrm((N_EVEN, 4, A_QK), 0.1),
        'a_head_g': gain((N_EVEN, A_V)),
        'b_conv_w': nrm((N_EVEN, B_CONV, B_W), B_CONV ** -0.5),
        'b_conv_b': nrm((N_EVEN, B_W), 0.01),
        'b_gate_w': nrm((N_EVEN, 2, B_BLOCKS, B_BS, B_BS), B_BS ** -0.5),
        'b_gate_b': nrm((N_EVEN, 2, B_W), 0.01),
        'b_lambda': b_lambda,
        'odd_w_in': nrm((N_ODD, D_MODEL, IN_ODD), D_MODEL ** -0.5),
        'odd_w_out': nrm((N_ODD, MIX_W, D_MODEL), MIX_W ** -0.5),
        'c_a_re': c_a_re,
        'c_a_im': c_a_im,
        'c_log_dt': c_log_dt,
        'c_b_re': nrm((N_ODD, C_GROUPS, C_STATE, C_GROUP), (2 * C_GROUP) ** -0.5),
        'c_b_im': nrm((N_ODD, C_GROUPS, C_STATE, C_GROUP), (2 * C_GROUP) ** -0.5),
        'c_c_re': nrm((N_ODD, C_GROUPS, C_GROUP, C_STATE), (2 * C_STATE) ** -0.5),
        'c_c_im': nrm((N_ODD, C_GROUPS, C_GROUP, C_STATE), (2 * C_STATE) ** -0.5),
        'c_d': nrm((N_ODD, C_W), 0.5),
        'c_glu_w': nrm((N_ODD, C_W, C_W), C_W ** -0.5),
        'c_glu_b': nrm((N_ODD, C_W), 0.01),
        'd_conv_w': nrm((N_ODD, D_CONV, D_W), D_CONV ** -0.5),
        'd_conv_b': nrm((N_ODD, D_W), 0.01),
        'd_ln_g': gain((N_ODD, D_W)),
        'd_ln_b': nrm((N_ODD, D_W), 0.01),
    }


def reference(x_prompt, x_sample, cache_k, cache_v, state_conv_b, state_h_b, state_c_re, state_c_im,
              state_conv_d, page_table, ffn1_g, ffn1_w_gu, ffn1_w_down, mix_g, ffn2_g, ffn2_w_gu,
              ffn2_w_down, even_w_in, even_w_out, a_q_g, a_k_g, a_lambda, a_head_g, b_conv_w, b_conv_b,
              b_gate_w, b_gate_b, b_lambda, odd_w_in, odd_w_out, c_a_re, c_a_im, c_log_dt, c_b_re, c_b_im,
              c_c_re, c_c_im, c_d, c_glu_w, c_glu_b, d_conv_w, d_conv_b, d_ln_g, d_ln_b):
    p = dict(ffn1_g=ffn1_g, ffn1_w_gu=ffn1_w_gu, ffn1_w_down=ffn1_w_down, mix_g=mix_g,
             ffn2_g=ffn2_g, ffn2_w_gu=ffn2_w_gu, ffn2_w_down=ffn2_w_down,
             even_w_in=even_w_in, even_w_out=even_w_out, a_q_g=a_q_g, a_k_g=a_k_g,
             a_lambda=a_lambda, a_head_g=a_head_g, b_conv_w=b_conv_w, b_conv_b=b_conv_b,
             b_gate_w=b_gate_w, b_gate_b=b_gate_b, b_lambda=b_lambda,
             odd_w_in=odd_w_in, odd_w_out=odd_w_out, c_a_re=c_a_re, c_a_im=c_a_im,
             c_log_dt=c_log_dt, c_b_re=c_b_re, c_b_im=c_b_im, c_c_re=c_c_re, c_c_im=c_c_im,
             c_d=c_d, c_glu_w=c_glu_w, c_glu_b=c_glu_b, d_conv_w=d_conv_w, d_conv_b=d_conv_b,
             d_ln_g=d_ln_g, d_ln_b=d_ln_b)
    b = x_prompt.shape[0]
    dt = x_prompt.dtype
    (y_prompt, k_p, v_p, cb_p, hb_p, cre_p, cim_p, cd_p) = _run_group(
        x_prompt, None, None, None,
        jnp.zeros((N_EVEN, b, B_CONV - 1, B_W), dt), jnp.zeros((N_EVEN, b, B_W), dt),
        jnp.zeros((N_ODD, b, C_GROUPS, C_STATE), dt), jnp.zeros((N_ODD, b, C_GROUPS, C_STATE), dt),
        jnp.zeros((N_ODD, b, D_CONV - 1, D_W), dt), p)
    (y_sample, k_s, v_s, cb_s, hb_s, cre_s, cim_s, cd_s) = _run_group(
        x_sample, cache_k, cache_v, page_table, state_conv_b, state_h_b, state_c_re, state_c_im,
        state_conv_d, p)
    return (y_prompt, y_sample, k_p, v_p, cb_p, hb_p, cre_p, cim_p, cd_p,
            k_s, v_s, cb_s, hb_s, cre_s, cim_s, cd_s)
```

```cpp
#ifndef MK_N_LAUNCHES
#define MK_N_LAUNCHES 17
#endif
#include <hip/hip_runtime.h>
#include <cstdio>
#include <cstdint>
namespace pg8 {
#define PG8_LAS __attribute__((address_space(3)))
typedef unsigned short bf16_t;
typedef short bf16x8 __attribute__((ext_vector_type(8)));
typedef float f32x4 __attribute__((ext_vector_type(4)));
typedef unsigned u32x4 __attribute__((ext_vector_type(4)));
constexpr int BM = 256, BK = 64, HALF = 128, HTB = HALF * BK * 2  , STAGE_BYTES = 8 * HTB, NXCD = 8, WGM = 8;

__host__ __device__ __forceinline__ int lds_byte(int r, int c) { const int st = (r >> 4) * 2 + (c >> 5), rr = r & 15, cc = c & 31, ob = rr * 64 + cc * 2; return st * 1024 + (ob ^ (((ob >> 9) & 1) << 5)); }
__host__ __device__ __forceinline__ void stage_rc(int b, int& R, int& C) { const int st = b / 1024, sb = b % 1024, swz = sb ^ (((sb >> 9) & 1) << 5); R = (st >> 1) * 16 + swz / 64; C = (st & 1) * 32 + (swz % 64) / 2; }
__host__ __device__ __forceinline__ int perm32(int rho) { const int n = rho >> 4, i = rho & 15; return 8 * (i >> 2) + 4 * n + (i & 3); }

struct Unit { int pm, pn; };
struct Gemm { const bf16_t* A; const bf16_t* Bt; int M, N, K; };

struct StaticOrder {
    int nM, nN, nwg, G, c;
    __host__ __device__ void init(int M, int N, int G_, int c_) { nM = M / BM; nN = N / BM; nwg = nM * nN; G = G_; c = c_; }
    __host__ __device__ bool next(int i, Unit& u) const {
        const long L = (long)i * G + c; if (L >= nwg) return false;
        int wgid = (int)L; { const int q = nwg / NXCD, r = nwg % NXCD, xcd = wgid % NXCD, off = wgid / NXCD; wgid = (xcd < r ? xcd * (q + 1) : r * (q + 1) + (xcd - r) * q) + off; }
        const int nig = WGM * nN, gid = wgid / nig, fm = gid * WGM, gsz = (nM - fm) < WGM ? (nM - fm) : WGM;
        u.pm = fm + ((wgid % nig) % gsz); u.pn = (wgid % nig) / gsz; return true;
    }
    __device__ __forceinline__ void a_ready(const Unit&) const {}
    __device__ __forceinline__ void done(const Unit&) const {}
};

__device__ __forceinline__ unsigned cvt_pk_bf16(float lo, float hi) { unsigned r; asm volatile("v_cvt_pk_bf16_f32 %0, %1, %2" : "=v"(r) : "v"(lo), "v"(hi)); return r; }
typedef float f32x2 __attribute__((ext_vector_type(2)));
template <class Epi, class Sched, bool ALIGN_EPI = false, bool SP2 = false>
__device__ __forceinline__ void gemm_phase(PG8_LAS unsigned char* lds, const Gemm g, const Sched& S, const Epi& E) {
    int tid_ = threadIdx.x; asm volatile("" : "+v"(tid_));
    const int tid = tid_, wid = __builtin_amdgcn_readfirstlane(tid >> 6), lane = tid & 63, wr = wid >> 2, wc = wid & 3, fr = lane & 15, fq = lane >> 4;
    const int K = g.K, nt = K / BK;
    unsigned voffA[2], voffB[2];
#pragma unroll
    for (int i = 0; i < 2; ++i) { int R, C; stage_rc(tid * 16 + i * 8192, R, C); const int Rb = Epi::PERM ? ((R & ~31) + perm32(R & 31)) : R;
        voffA[i] = (unsigned)(R * K + C) * 2u; voffB[i] = (unsigned)(Rb * K + C) * 2u; }
    const size_t kstep = (size_t)(BK * 2);
    const size_t hstep = (size_t)HALF * K * 2;
    const size_t tstep = 2 * hstep;
    const unsigned ldsw = (unsigned)wid * 1024u;
    const int aoff = lds_byte(wr * 64 + fr, fq * 8), boff = lds_byte(wc * 32 + fr, fq * 8);
#define PG8_SA(b, h) (((b) * 2 + (h)) * HTB)
#define PG8_SB(b, h) ((4 + (b) * 2 + (h)) * HTB)
#define PG8_STAGE(bufoff, gbase, voff) do { _Pragma("unroll") for (int _i = 0; _i < 2; ++_i) \
        __builtin_amdgcn_global_load_lds((const unsigned*)((const char*)(gbase) + (voff)[_i]), (PG8_LAS unsigned*)(lds + (bufoff) + ldsw + _i * 8192), 16, 0, 0); } while (0)
#define PG8_LDA(dst, b, h) do { _Pragma("unroll") for (int m = 0; m < 4; ++m) _Pragma("unroll") for (int k = 0; k < 2; ++k) dst[m][k] = *(const PG8_LAS bf16x8*)(lds + PG8_SA(b, h) + aoff + m * 2048 + k * 1024); } while (0)
#define PG8_LDB(dst, b, h) do { _Pragma("unroll") for (int n = 0; n < 2; ++n) _Pragma("unroll") for (int k = 0; k < 2; ++k) dst[n][k] = *(const PG8_LAS bf16x8*)(lds + PG8_SB(b, h) + boff + n * 2048 + k * 1024); } while (0)
#define PG8_MMA(ai, bj, At, Bt) do { __builtin_amdgcn_s_setprio(1); _Pragma("unroll") for (int m = 0; m < 4; ++m) _Pragma("unroll") for (int n = 0; n < 2; ++n) _Pragma("unroll") for (int k = 0; k < 2; ++k) \
        acc[ai][bj][m][n] = __builtin_amdgcn_mfma_f32_16x16x32_bf16(Bt[n][k], At[m][k], acc[ai][bj][m][n], 0, 0, 0); __builtin_amdgcn_s_setprio(0); } while (0)
#define PG8_WAIT_V(n) asm volatile("s_waitcnt vmcnt(" #n ")" ::: "memory")
#define PG8_WAIT_L(n) asm volatile("s_waitcnt lgkmcnt(" #n ")" ::: "memory")
#define PG8_BAR __builtin_amdgcn_s_barrier()
#define PG8_SCHED __builtin_amdgcn_sched_barrier(0)
    Unit cur, nxt; int ui = 0;
    if (!S.next(0, cur)) return;
    f32x4 acc[2][2][4][2];
#pragma unroll
    for (int a = 0; a < 2; ++a)
#pragma unroll
        for (int b = 0; b < 2; ++b)
#pragma unroll
            for (int m = 0; m < 4; ++m)
#pragma unroll
                for (int n = 0; n < 2; ++n) acc[a][b][m][n] = (f32x4){0.f, 0.f, 0.f, 0.f};
    bf16x8 At[4][2], B0[2][2], B1[2][2];
    const char* cA = (const char*)g.A + (size_t)cur.pm * tstep; const char* cB = (const char*)g.Bt + (size_t)cur.pn * tstep;
    S.a_ready(cur);
    if constexpr (SP2) {
        PG8_STAGE(PG8_SB(0, 0), cB, voffB); PG8_STAGE(PG8_SB(0, 1), cB + hstep, voffB); PG8_STAGE(PG8_SA(0, 0), cA, voffA); PG8_STAGE(PG8_SA(0, 1), cA + hstep, voffA);
        if (wr == 1) PG8_BAR;
        PG8_WAIT_V(2); PG8_BAR;
        PG8_STAGE(PG8_SB(1, 0), cB + kstep, voffB); PG8_STAGE(PG8_SA(1, 0), cA + kstep, voffA); PG8_STAGE(PG8_SB(1, 1), cB + hstep + kstep, voffB);
        PG8_WAIT_V(6); PG8_BAR;
    } else {
        PG8_STAGE(PG8_SB(0, 0), cB, voffB); PG8_STAGE(PG8_SA(0, 0), cA, voffA); PG8_STAGE(PG8_SB(0, 1), cB + hstep, voffB); PG8_STAGE(PG8_SA(0, 1), cA + hstep, voffA);
        if (wr == 1) PG8_BAR;
        PG8_WAIT_V(4); PG8_BAR;
        PG8_STAGE(PG8_SB(1, 0), cB + kstep, voffB); PG8_STAGE(PG8_SA(1, 0), cA + kstep, voffA); PG8_STAGE(PG8_SB(1, 1), cB + hstep + kstep, voffB);
        PG8_WAIT_V(6); PG8_BAR;
    }
    for (;;) {
        const bool has_next = S.next(ui + 1, nxt);
        const char* nA = has_next ? (const char*)g.A + (size_t)nxt.pm * tstep : cA; const char* nB = has_next ? (const char*)g.Bt + (size_t)nxt.pn * tstep : cB;
        for (int t = 0; t < nt; t += 2) {
            const bool last = (t == nt - 2);
            const char* a1 = cA + (size_t)(t + 1) * kstep;
            const char* a2 = last ? nA : cA + (size_t)(t + 2) * kstep; const char* b2 = last ? nB : cB + (size_t)(t + 2) * kstep;
            const char* a3 = a2 + kstep; const char* b3 = b2 + kstep;
            if (last && has_next) S.a_ready(nxt);
            if constexpr (SP2) {
            PG8_LDB(B0, 0, 0); PG8_LDB(B1, 0, 1); PG8_SCHED; PG8_LDA(At, 0, 0); PG8_STAGE(PG8_SA(1, 1), a1 + hstep, voffA);
            PG8_WAIT_V(8); PG8_WAIT_L(0); PG8_BAR; PG8_MMA(0, 0, At, B0); PG8_MMA(0, 1, At, B1); PG8_BAR; PG8_SCHED;
            PG8_LDA(At, 0, 1); PG8_STAGE(PG8_SB(0, 0), b2, voffB); PG8_STAGE(PG8_SB(0, 1), b2 + hstep, voffB); PG8_STAGE(PG8_SA(0, 0), a2, voffA);
            PG8_WAIT_V(8); PG8_WAIT_L(0); PG8_BAR; PG8_MMA(1, 0, At, B0); PG8_MMA(1, 1, At, B1); PG8_BAR; PG8_SCHED;
            PG8_LDB(B0, 1, 0); PG8_LDB(B1, 1, 1); PG8_SCHED; PG8_LDA(At, 1, 0); PG8_STAGE(PG8_SA(0, 1), a2 + hstep, voffA);
            PG8_WAIT_V(8); PG8_WAIT_L(0); PG8_BAR; PG8_MMA(0, 0, At, B0); PG8_MMA(0, 1, At, B1); PG8_BAR; PG8_SCHED;
            PG8_LDA(At, 1, 1); PG8_STAGE(PG8_SB(1, 0), b3, voffB); PG8_STAGE(PG8_SB(1, 1), b3 + hstep, voffB); PG8_STAGE(PG8_SA(1, 0), a3, voffA);
            PG8_WAIT_V(8); PG8_WAIT_L(0); PG8_BAR; PG8_MMA(1, 0, At, B0); PG8_MMA(1, 1, At, B1); PG8_BAR; PG8_SCHED;
            } else {
            PG8_LDB(B0, 0, 0); PG8_SCHED; PG8_LDA(At, 0, 0); PG8_STAGE(PG8_SA(1, 1), a1 + hstep, voffA);
            PG8_WAIT_L(8); PG8_BAR; PG8_WAIT_L(0); PG8_MMA(0, 0, At, B0); PG8_BAR; PG8_SCHED;
            PG8_LDB(B1, 0, 1); PG8_STAGE(PG8_SB(0, 0), b2, voffB);
            PG8_BAR; PG8_WAIT_L(0); PG8_MMA(0, 1, At, B1); PG8_BAR;
            PG8_LDA(At, 0, 1); PG8_STAGE(PG8_SA(0, 0), a2, voffA);
            PG8_BAR; PG8_WAIT_L(0); PG8_MMA(1, 0, At, B0); PG8_BAR; PG8_SCHED;
            PG8_STAGE(PG8_SB(0, 1), b2 + hstep, voffB);
            PG8_WAIT_V(6); PG8_BAR; PG8_MMA(1, 1, At, B1); PG8_BAR;
            PG8_LDB(B0, 1, 0); PG8_SCHED; PG8_LDA(At, 1, 0); PG8_STAGE(PG8_SA(0, 1), a2 + hstep, voffA);
            PG8_WAIT_L(8); PG8_BAR; PG8_WAIT_L(0); PG8_MMA(0, 0, At, B0); PG8_BAR; PG8_SCHED;
            PG8_LDB(B1, 1, 1); PG8_STAGE(PG8_SB(1, 0), b3, voffB);
            PG8_BAR; PG8_WAIT_L(0); PG8_MMA(0, 1, At, B1); PG8_BAR;
            PG8_LDA(At, 1, 1); PG8_STAGE(PG8_SA(1, 0), a3, voffA);
            PG8_BAR; PG8_WAIT_L(0); PG8_MMA(1, 0, At, B0); PG8_BAR; PG8_SCHED;
            PG8_STAGE(PG8_SB(1, 1), b3 + hstep, voffB);
            PG8_WAIT_V(6); PG8_BAR; PG8_MMA(1, 1, At, B1); PG8_BAR;
            }
        }
        if constexpr (ALIGN_EPI) { if (wr == 0) PG8_BAR; }
        if constexpr (!Epi::AFTER_DRAIN) { E(acc, cur, wr, wc, fr, fq); S.done(cur); }
        if (!has_next) break;
#pragma unroll
        for (int a = 0; a < 2; ++a)
#pragma unroll
            for (int b = 0; b < 2; ++b)
#pragma unroll
                for (int m = 0; m < 4; ++m)
#pragma unroll
                    for (int n = 0; n < 2; ++n) acc[a][b][m][n] = (f32x4){0.f, 0.f, 0.f, 0.f};
        cur = nxt; cA = nA; cB = nB; ++ui;
        if constexpr (ALIGN_EPI) { if (wr == 1) PG8_BAR; }
    }
    PG8_WAIT_V(0);
    if constexpr (!ALIGN_EPI) { if (wr == 0) PG8_BAR; }
    PG8_BAR;
    if constexpr (Epi::AFTER_DRAIN) { E.fused(acc, cur, wr, wc, fr, fq, lds, wid, lane); S.done(cur); }
#undef PG8_SA
#undef PG8_SB
#undef PG8_STAGE
#undef PG8_LDA
#undef PG8_LDB
#undef PG8_MMA
#undef PG8_WAIT_V
#undef PG8_WAIT_L
#undef PG8_BAR
#undef PG8_SCHED
}
}
#include <hip/hip_bf16.h>
#include <cmath>
#include <hip/hip_bf16.h>
#include <cmath>
namespace attn_body {
using bf16=__hip_bfloat16;
using bf16x8=__attribute__((ext_vector_type(8)))short;
using s16x4=__attribute__((ext_vector_type(4)))short;
using f32x16=__attribute__((ext_vector_type(16)))float;
using u32x4=__attribute__((ext_vector_type(4)))unsigned;
constexpr int BATCH=4,NHEAD=16,SEQ=4096,D=64,PQK=512,PV=512,PO=1024;
constexpr int NW=8,QBLK=32,QB=QBLK*NW,KVBLK=64,NQB=SEQ/QB;
constexpr int ATTN_UNIT_ROWS=QB;
__device__ __forceinline__ int crow(int r,int hi){return (r&3)+8*(r>>2)+4*hi;}
#define SBAR() __builtin_amdgcn_sched_barrier(0)
__device__ __forceinline__ void cmask(f32x16&p0,f32x16&p1,int jb,int qrel,int hi){
  const float NEG=-INFINITY; int kb=64*jb+4*hi;
  #pragma unroll
  for(int r=0;r<16;++r){int kv=kb+(r&3)+8*(r>>2); if(kv>qrel)p0[r]=NEG; if(kv+32>qrel)p1[r]=NEG;}
}

constexpr int NSLOT=3, SLOTB=8192;
constexpr int LDS_K=0, LDS_V=NSLOT*SLOTB, LDS_WS=2*NSLOT*SLOTB, LDS_OST=LDS_WS+NW*64*4, LDS_BYTES=LDS_OST+NW*4096;
constexpr float C2=0.125f*1.4426950408889634f;
__device__ __forceinline__ void glds16(const void*gsrc,unsigned lds_dst){unsigned keep;
  asm volatile("s_mov_b32 %0, m0\n\ts_mov_b32 m0, %2\n\ts_nop 0\n\tglobal_load_lds_dwordx4 %1, off\n\ts_mov_b32 m0, %0":"=&s"(keep):"v"(gsrc),"s"(lds_dst):"memory");}
__device__ __forceinline__ float max3f(float a,float b,float c){float r;asm("v_max3_f32 %0, %1, %2, %3":"=v"(r):"v"(a),"v"(b),"v"(c));return r;}
__device__ __forceinline__ float max2f(float a,float b){float r;asm("v_max_f32_e32 %0, %1, %2":"=v"(r):"v"(a),"v"(b));return r;}
__device__ __forceinline__ float fadd_s(float a,float b){float r;asm("v_add_f32_e32 %0, %1, %2":"=v"(r):"v"(a),"v"(b));return r;}
__device__ __forceinline__ float fsub_s(float a,float b){float r;asm("v_sub_f32_e32 %0, %1, %2":"=v"(r):"v"(a),"v"(b));return r;}
typedef float f32x2_t __attribute__((ext_vector_type(2))); typedef __bf16 bf16x2_t __attribute__((ext_vector_type(2)));
__device__ __forceinline__ unsigned cvtpk_s(float lo,float hi){f32x2_t v={lo,hi};bf16x2_t b=__builtin_convertvector(v,bf16x2_t);return __builtin_bit_cast(unsigned,b);}
#define WAIT_BAR(N) asm volatile("s_waitcnt vmcnt(" #N ") lgkmcnt(0)\n\ts_barrier":::"memory")

__device__ __forceinline__ void qkt(f32x16&p0,f32x16&p1,const char*Kslot,const bf16x8*qr,const f32x16&negm,int r32,int hi){
  const char*kb=Kslot+hi*1024+r32*16;
  #pragma unroll
  for(int d0=0;d0<4;++d0){
    const bf16x8 b0=*reinterpret_cast<const bf16x8*>(kb+d0*2048);
    const bf16x8 b1=*reinterpret_cast<const bf16x8*>(kb+d0*2048+512);
    if(d0==0){p0=__builtin_amdgcn_mfma_f32_32x32x16_bf16(b0,qr[0],negm,0,0,0);p1=__builtin_amdgcn_mfma_f32_32x32x16_bf16(b1,qr[0],negm,0,0,0);}
    else{p0=__builtin_amdgcn_mfma_f32_32x32x16_bf16(b0,qr[d0],p0,0,0,0);p1=__builtin_amdgcn_mfma_f32_32x32x16_bf16(b1,qr[d0],p1,0,0,0);}}
}
typedef __attribute__((address_space(3))) const char* lds_cptr;
typedef short v4i16_t __attribute__((ext_vector_type(4)));
__device__ __forceinline__ void kload8(bf16x8*kf,lds_cptr kp){
  kf[0]=*(const __attribute__((address_space(3))) bf16x8*)(kp);      kf[1]=*(const __attribute__((address_space(3))) bf16x8*)(kp+512);
  kf[2]=*(const __attribute__((address_space(3))) bf16x8*)(kp+2048); kf[3]=*(const __attribute__((address_space(3))) bf16x8*)(kp+2560);
  kf[4]=*(const __attribute__((address_space(3))) bf16x8*)(kp+4096); kf[5]=*(const __attribute__((address_space(3))) bf16x8*)(kp+4608);
  kf[6]=*(const __attribute__((address_space(3))) bf16x8*)(kp+6144); kf[7]=*(const __attribute__((address_space(3))) bf16x8*)(kp+6656);
}
__device__ __forceinline__ void kload2(bf16x8*kf,lds_cptr kp,int j){ kf[2*j]=*(const __attribute__((address_space(3))) bf16x8*)(kp+j*2048); kf[2*j+1]=*(const __attribute__((address_space(3))) bf16x8*)(kp+j*2048+512); }
__device__ __forceinline__ s16x4 vtr(lds_cptr p){ return __builtin_bit_cast(s16x4,__builtin_amdgcn_ds_read_tr16_b64_v4i16((__attribute__((address_space(3))) v4i16_t*)p)); }
__device__ __forceinline__ float rowmax(const f32x16&p0,const f32x16&p1){
  float a=max3f(p0[0],p0[1],p1[0]),b=max3f(p0[2],p0[3],p1[1]);a=max3f(a,p1[2],p1[3]);
  #pragma unroll
  for(int r=4;r<16;r+=4){a=max3f(a,p0[r],p0[r+1]);b=max3f(b,p0[r+2],p0[r+3]);a=max3f(a,p1[r],p1[r+1]);b=max3f(b,p1[r+2],p1[r+3]);}
  const float m=max2f(a,b);
  auto rr=__builtin_amdgcn_permlane32_swap(__float_as_uint(m),__float_as_uint(m),false,false);
  return max2f(__uint_as_float(rr[0]),__uint_as_float(rr[1]));
}
__device__ __forceinline__ void pv(f32x16*o,int vb,bf16x8 pa0,bf16x8 pa1,bf16x8 pa2,bf16x8 pa3){
  #pragma unroll
  for(int d0=0;d0<2;++d0){s16x4 lo[4],hi[4];
    #pragma unroll
    for(int ks=0;ks<4;++ks){
      asm volatile("ds_read_b64_tr_b16 %0,%1 offset:%c2":"=&v"(lo[ks]):"v"(vb),"i"(d0*4096+ks*1024):"memory");
      asm volatile("ds_read_b64_tr_b16 %0,%1 offset:%c2":"=&v"(hi[ks]):"v"(vb),"i"(d0*4096+ks*1024+512):"memory");}
    asm volatile("s_waitcnt lgkmcnt(0)":::"memory");SBAR();
    #define PK(k) (bf16x8){lo[k][0],lo[k][1],lo[k][2],lo[k][3],hi[k][0],hi[k][1],hi[k][2],hi[k][3]}
    o[d0]=__builtin_amdgcn_mfma_f32_32x32x16_bf16(pa0,PK(0),o[d0],0,0,0);
    o[d0]=__builtin_amdgcn_mfma_f32_32x32x16_bf16(pa1,PK(1),o[d0],0,0,0);
    o[d0]=__builtin_amdgcn_mfma_f32_32x32x16_bf16(pa2,PK(2),o[d0],0,0,0);
    o[d0]=__builtin_amdgcn_mfma_f32_32x32x16_bf16(pa3,PK(3),o[d0],0,0,0);
    #undef PK
  }
}

#ifndef ATTN_STORE16
#define ATTN_STORE16(p,v) (*(u32x4*)(p)=(v))
#endif
template<int THRL> __device__ __forceinline__ void attn_unit(int b,int qk_off,int v_off,int o_off,int qb,const bf16*Q,const bf16*__restrict__ K,const bf16*__restrict__ V,bf16*O,char*shm){
  int tid_=threadIdx.x; asm volatile("":"+v"(tid_)); const int tid=tid_,lane=tid&63,r32=lane&31,hi=lane>>5; const int wid=__builtin_amdgcn_readfirstlane(tid>>6);
  const long rowbase=(long)b*SEQ; const int q0=qb*QB;
  const bf16*Qw=Q+(rowbase+q0+wid*QBLK)*PQK+qk_off;
  const bf16*Kh=K+rowbase*PQK+qk_off,*Vh=V+rowbase*PV+v_off;
  const unsigned lds0=(unsigned)(uintptr_t)shm;
  float*wsf=(float*)(shm+LDS_WS)+wid*64;
  const bf16*ksrc=Kh+(long)lane*PQK+wid*8;
  const bf16*vsrc=Vh+(long)(16*(wid&3)+(lane>>2))*PV+(wid>>2)*32+(lane&3)*8;
  const unsigned kdst=lds0+LDS_K+wid*1024, vdst=lds0+LDS_V+wid*1024;
  #define DMA_K(t,slot) glds16(ksrc+(long)(t)*KVBLK*PQK,(unsigned)__builtin_amdgcn_readfirstlane(kdst+(slot)))
  #define DMA_V(t,slot) glds16(vsrc+(long)(t)*KVBLK*PV,(unsigned)__builtin_amdgcn_readfirstlane(vdst+(slot)))
  const int vb0=(int)(lds0+LDS_V)+((lane>>4)&1)*32+(lane&3)*8+(4*hi+((lane&15)>>2))*64;
  const char*Kbase=shm+LDS_K; bf16x8 kf[8];
  const lds_cptr shm3=(lds_cptr)shm; const lds_cptr kp0=shm3+LDS_K+hi*1024+r32*16; const lds_cptr vp0=shm3+LDS_V+((lane>>4)&1)*32+(lane&3)*8+(4*hi+((lane&15)>>2))*64;
  const int NT=(q0+QB)/KVBLK;
  DMA_K(0,0);DMA_V(0,0);DMA_K(1,SLOTB);
  bf16x8 qr[4];
  #pragma unroll
  for(int d0=0;d0<4;++d0)qr[d0]=*reinterpret_cast<const bf16x8*>(&Qw[(long)r32*PQK+d0*16+hi*8]);
  float mhat=0.f,l_reg=0.f;f32x16 o[2];o[0]=f32x16{};o[1]=f32x16{};f32x16 negm=f32x16{};asm volatile("":"+v"(negm));
  const int qrel=wid*QBLK+r32;
  #define CMASK(P0,P1,t) do{int jb_=(t)-(NT-4); if(jb_>=0)cmask(P0,P1,jb_,qrel,hi);}while(0)
  bool resc=false;
  #define START(P0,P1) do{ const float rm=rowmax(P0,P1); resc=false; \
    { const float dl=rm; mhat=fadd_s(mhat,dl); \
      _Pragma("unroll") for(int r=0;r<16;++r){P0[r]=fsub_s(P0[r],dl);P1[r]=fsub_s(P1[r],dl);} \
      _Pragma("unroll") for(int r=0;r<16;++r)negm[r]=-mhat; asm volatile("":"+v"(negm)); } \
    _Pragma("unroll") for(int r=0;r<16;++r)P0[r]=__builtin_amdgcn_exp2f(P0[r]); }while(0)
  #define RESC() do{ if(resc){ asm volatile("s_waitcnt lgkmcnt(0)":::"memory"); \
      _Pragma("unroll") for(int d_=0;d_<2;++d_) _Pragma("unroll") for(int r=0;r<16;++r)o[d_][r]*=wsf[crow(r,hi)]; } }while(0)
  f32x16 pA0,pA1,pB0,pB1;
  int sl_prev=0,sl_cur=0,sl_next=SLOTB;
  #define ROT() do{sl_prev=sl_cur;sl_cur=sl_next;sl_next=(sl_next==(NSLOT-1)*SLOTB)?0:sl_next+SLOTB;}while(0)
  DMA_K(2,2*SLOTB);
  WAIT_BAR(3);
  qkt(pA0,pA1,Kbase,qr,negm,r32,hi);asm volatile("s_nop 15\n\ts_nop 7":"+v"(pA0),"+v"(pA1));CMASK(pA0,pA1,0);
  START(pA0,pA1);
  _Pragma("unroll") for(int r=0;r<16;++r)pA1[r]=__builtin_amdgcn_exp2f(pA1[r]);
  WAIT_BAR(0);
  DMA_K(3,0);DMA_V(1,SLOTB);
  ROT();
  kload8(kf,kp0+sl_cur);
  WAIT_BAR(2);
  s16x4 vlo[8],vhi[8]; u32x4 pw0,pw1,pw2,pw3;
  #define PKW(P,B) cvtpk_s(P[B],P[B+1])
  #define PAF(k) __builtin_bit_cast(bf16x8,pw##k)
  #define VFR(i) (bf16x8){vlo[i][0],vlo[i][1],vlo[i][2],vlo[i][3],vhi[i][0],vhi[i][1],vhi[i][2],vhi[i][3]}
  #define PIN(x) asm volatile("":"+v"(x))
  #define MX3(a,b,c) __builtin_fmaxf(__builtin_fmaxf((a),(b)),(c))
  #define GAPA(MF,A0,A1,A2,A3,W0,W1,PW) do{ MF; sacc+=A0; sacc+=A1; sacc+=A2; sacc+=A3; PIN(sacc); W0; W1; PIN(PW); SBAR(); }while(0)
  #define EX(v) __builtin_amdgcn_exp2f(v)
  #define GAPB(MF,X,B) do{ MF; X[B]=EX(X[B]); X[B+1]=EX(X[B+1]); X[B+2]=EX(X[B+2]); X[B+3]=EX(X[B+3]); PIN(X); SBAR(); }while(0)
  #define VRD(i) do{ vlo[i]=vtr(vp_+(((i)>>2)*4096+((i)&3)*1024)); vhi[i]=vtr(vp_+(((i)>>2)*4096+((i)&3)*1024+512)); }while(0)
  #define KRD(G,j) do{ if(G){ kload2(kf,kp0+sl_next,j); SBAR(); } }while(0)
  #define STEP(C0,C1,P0,P1,t,GK,GV,GL) do{ SBAR(); \
    const lds_cptr vp_=vp0+sl_prev; \
    VRD(0); SBAR(); float sacc=(P0[0]+P0[1]); \
    GAPA(C0=__builtin_amdgcn_mfma_f32_32x32x16_bf16(kf[0],qr[0],negm,0,0,0), P0[2],P0[3],P0[4],P0[5],     pw0[0]=PKW(P0,0), pw0[1]=PKW(P0,2), pw0); \
    VRD(4); SBAR(); GAPA(C1=__builtin_amdgcn_mfma_f32_32x32x16_bf16(kf[1],qr[0],negm,0,0,0), P0[6],P0[7],P0[8],P0[9],     pw0[2]=PKW(P0,4), pw0[3]=PKW(P0,6), pw0); \
    VRD(1); SBAR(); GAPA(C0=__builtin_amdgcn_mfma_f32_32x32x16_bf16(kf[2],qr[1],C0,0,0,0),   P0[10],P0[11],P0[12],P0[13], pw1[0]=PKW(P0,8), pw1[1]=PKW(P0,10), pw1); \
    VRD(5); SBAR(); GAPA(C1=__builtin_amdgcn_mfma_f32_32x32x16_bf16(kf[3],qr[1],C1,0,0,0),   P0[14],P0[15],P1[0],P1[1],   pw1[2]=PKW(P0,12),pw1[3]=PKW(P0,14), pw1); \
    VRD(2); SBAR(); GAPA(C0=__builtin_amdgcn_mfma_f32_32x32x16_bf16(kf[4],qr[2],C0,0,0,0),   P1[2],P1[3],P1[4],P1[5],     pw2[0]=PKW(P1,0), pw2[1]=PKW(P1,2), pw2); \
    VRD(6); SBAR(); GAPA(C1=__builtin_amdgcn_mfma_f32_32x32x16_bf16(kf[5],qr[2],C1,0,0,0),   P1[6],P1[7],P1[8],P1[9],     pw2[2]=PKW(P1,4), pw2[3]=PKW(P1,6), pw2); \
    VRD(3); SBAR(); GAPA(C0=__builtin_amdgcn_mfma_f32_32x32x16_bf16(kf[6],qr[3],C0,0,0,0),   P1[10],P1[11],P1[12],P1[13], pw3[0]=PKW(P1,8), pw3[1]=PKW(P1,10), pw3); \
    VRD(7); SBAR(); GAPA(C1=__builtin_amdgcn_mfma_f32_32x32x16_bf16(kf[7],qr[3],C1,0,0,0),   P1[14],P1[15],0.f,0.f,       pw3[2]=PKW(P1,12),pw3[3]=PKW(P1,14), pw3); \
    l_reg+=sacc; \
    if(GK){DMA_K((t)+3,sl_cur);} if(GV){DMA_V((t)+1,sl_next);} \
    CMASK(C0,C1,t); \
    { float a=MX3(C0[0],C0[1],C1[0]),b=MX3(C0[2],C0[3],C1[1]); a=MX3(a,C1[2],C1[3]); \
      _Pragma("unroll") for(int r=4;r<16;r+=4){a=MX3(a,C0[r],C0[r+1]);b=MX3(b,C0[r+2],C0[r+3]);a=MX3(a,C1[r],C1[r+1]);b=MX3(b,C1[r+2],C1[r+3]);} \
      float rm=__builtin_fmaxf(a,b); { auto rr=__builtin_amdgcn_permlane32_swap(__float_as_uint(rm),__float_as_uint(rm),false,false); rm=__builtin_fmaxf(__uint_as_float(rr[0]),__uint_as_float(rr[1])); } \
      resc=false; \
      if(__builtin_expect(__any(rm>(float)THRL),0)){ const float dl=__builtin_fmaxf(rm,0.f); mhat+=dl; \
        _Pragma("unroll") for(int r=0;r<16;++r){C0[r]-=dl;C1[r]-=dl;} \
        _Pragma("unroll") for(int r=0;r<16;++r)negm[r]=-mhat; asm volatile("":"+v"(negm)); \
        const float f=__builtin_amdgcn_exp2f(-dl); l_reg*=f; if(hi==0)wsf[r32]=f; resc=true; } } \
    SBAR(); \
    GAPB(o[0]=__builtin_amdgcn_mfma_f32_32x32x16_bf16(PAF(0),VFR(0),o[0],0,0,0), C0,0); \
    GAPB(o[1]=__builtin_amdgcn_mfma_f32_32x32x16_bf16(PAF(0),VFR(4),o[1],0,0,0), C0,4); \
    KRD(GL,0); GAPB(o[0]=__builtin_amdgcn_mfma_f32_32x32x16_bf16(PAF(1),VFR(1),o[0],0,0,0), C0,8); \
    KRD(GL,1); GAPB(o[1]=__builtin_amdgcn_mfma_f32_32x32x16_bf16(PAF(1),VFR(5),o[1],0,0,0), C0,12); \
    KRD(GL,2); GAPB(o[0]=__builtin_amdgcn_mfma_f32_32x32x16_bf16(PAF(2),VFR(2),o[0],0,0,0), C1,0); \
    KRD(GL,3); GAPB(o[1]=__builtin_amdgcn_mfma_f32_32x32x16_bf16(PAF(2),VFR(6),o[1],0,0,0), C1,4); \
    GAPB(o[0]=__builtin_amdgcn_mfma_f32_32x32x16_bf16(PAF(3),VFR(3),o[0],0,0,0), C1,8); \
    GAPB(o[1]=__builtin_amdgcn_mfma_f32_32x32x16_bf16(PAF(3),VFR(7),o[1],0,0,0), C1,12); \
    }while(0)
  int t=1;
  #undef CMASK
  #define CMASK(P0,P1,t) do{}while(0)
  for(;t+5<NT;t+=2){
    STEP(pB0,pB1,pA0,pA1,t,true,true,true);     WAIT_BAR(2); RESC(); ROT();
    STEP(pA0,pA1,pB0,pB1,t+1,true,true,true);   WAIT_BAR(2); RESC(); ROT();
  }
  #undef CMASK
  #define CMASK(P0,P1,t) do{int jb_=(t)-(NT-4); if(jb_>=0)cmask(P0,P1,jb_,qrel,hi);}while(0)
  #define ENDW(tt) do{ if((tt)+3<NT){WAIT_BAR(2);} else if((tt)+2<NT){WAIT_BAR(1);} else {WAIT_BAR(0);} }while(0)
  for(;t+1<NT;t+=2){
    STEP(pB0,pB1,pA0,pA1,t,(t+3<NT),(t+1<NT),(t+1<NT));       ENDW(t);   RESC(); ROT();
    STEP(pA0,pA1,pB0,pB1,t+1,(t+4<NT),(t+2<NT),(t+2<NT));     ENDW(t+1); RESC(); ROT();
  }
  STEP(pB0,pB1,pA0,pA1,NT-1,false,false,false); RESC();
  { float sacc=pB0[0]+pB0[1]; _Pragma("unroll") for(int r=2;r<16;++r)sacc+=pB0[r]; _Pragma("unroll") for(int r=0;r<16;++r)sacc+=pB1[r]; l_reg+=sacc;
    pw0=(u32x4){PKW(pB0,0),PKW(pB0,2),PKW(pB0,4),PKW(pB0,6)};pw1=(u32x4){PKW(pB0,8),PKW(pB0,10),PKW(pB0,12),PKW(pB0,14)};pw2=(u32x4){PKW(pB1,0),PKW(pB1,2),PKW(pB1,4),PKW(pB1,6)};pw3=(u32x4){PKW(pB1,8),PKW(pB1,10),PKW(pB1,12),PKW(pB1,14)};
    SBAR(); pv(o,vb0+sl_cur,PAF(0),PAF(1),PAF(2),PAF(3)); }
  #undef PKW
  #undef PAF
  #undef VFR
  #undef PIN
  #undef MX3
  #undef GAPA
  #undef GAPB
  #undef EX
  #undef VRD
  #undef KRD
  #undef STEP
  #undef ENDW
  {auto rr=__builtin_amdgcn_permlane32_swap(__float_as_uint(l_reg),__float_as_uint(l_reg),false,false);l_reg=__uint_as_float(rr[0])+__uint_as_float(rr[1]);}
  if(hi==0)wsf[32+r32]=l_reg;asm volatile("s_waitcnt lgkmcnt(0)":::"memory");
  float rli[16];
  #pragma unroll
  for(int r=0;r<16;++r)rli[r]=__builtin_amdgcn_rcpf(wsf[32+crow(r,hi)]);
  bf16*Ow=O+(rowbase+q0+wid*QBLK)*PO+o_off;
  { bf16*stg=(bf16*)(shm+LDS_OST)+wid*2048;
    #pragma unroll
    for(int r=0;r<16;++r){const int orow=crow(r,hi);
      #pragma unroll
      for(int d0=0;d0<2;++d0)stg[orow*64+d0*32+r32]=__float2bfloat16(o[d0][r]*rli[r]);}
    asm volatile("s_waitcnt lgkmcnt(0)":::"memory");
    #pragma unroll
    for(int i=0;i<4;++i){const int row=i*8+(lane>>3),ch=lane&7; const u32x4 v=*(const u32x4*)(stg+row*64+ch*8); ATTN_STORE16(Ow+(long)row*PO+ch*8,v);} }
  asm volatile("s_waitcnt lgkmcnt(0)\n\ts_barrier":::"memory");
  #undef DMA_K
  #undef DMA_V
  #undef CMASK
  #undef START
  #undef RESC
  #undef ROT
}
constexpr int ATTN_LDS_BYTES=LDS_BYTES;
#undef SBAR
#undef WAIT_BAR
}
#define GAS __attribute__((address_space(1)))
#define LAS __attribute__((address_space(3)))
typedef unsigned short bf16;
typedef unsigned v4u __attribute__((ext_vector_type(4)));
typedef float f32x4 __attribute__((ext_vector_type(4)));
typedef short bf16x8 __attribute__((ext_vector_type(8)));
typedef GAS unsigned gu32;
typedef GAS unsigned long long gu64;
#define RLX_AGENT __ATOMIC_RELAXED, __HIP_MEMORY_SCOPE_AGENT
#define LDS_WAIT() asm volatile("s_waitcnt lgkmcnt(0)" ::: "memory")
#define VM_WAIT() asm volatile("s_waitcnt vmcnt(0)" ::: "memory")
__device__ __forceinline__ unsigned long long rt() { return __builtin_amdgcn_s_memrealtime(); }
__device__ __forceinline__ unsigned f2bf(float f) { unsigned u = __builtin_bit_cast(unsigned, f); return (u + 0x7fffu + ((u >> 16) & 1u)) >> 16; }
__device__ __forceinline__ unsigned pk2(float lo, float hi) { return f2bf(lo) | (f2bf(hi) << 16); }

#define XB_TMO      128
#define XB_XCNT(j)  (256  + 64 * (j))
#define XB_XSUB(j)  (1280 + 64 * (j))
#define XB_XGEN(j)  (2304 + 64 * (j))
#define XB_TOP      3328
#define XB_TOPGEN   3392
#define XCD_BAR_WORDS 3456
#define XB_SPIN_CAP (1u << 18)

__device__ __forceinline__ unsigned xb_ld(unsigned* p)              { return __hip_atomic_load(p, __ATOMIC_RELAXED, __HIP_MEMORY_SCOPE_AGENT); }
__device__ __forceinline__ unsigned xb_add(unsigned* p, unsigned v) { return __hip_atomic_fetch_add(p, v, __ATOMIC_RELAXED, __HIP_MEMORY_SCOPE_AGENT); }
__device__ __forceinline__ unsigned xb_xcc_id() { return (unsigned)__builtin_amdgcn_s_getreg((3 << 11) | 20) & 0xFu; }
#define XB_SPIN(cond, bar) do { unsigned _sp = 0; while (cond) { __builtin_amdgcn_s_sleep(1); \
    if ((++_sp & 255u) == 0u) { if (xb_ld(&(bar)[XB_TMO])) break; if (_sp > XB_SPIN_CAP) { atomicAdd(&(bar)[XB_TMO], 1u); break; } } } } while (0)

struct XcdBarrier {
    unsigned* bar; unsigned x;
    volatile LAS unsigned* st;
};

__device__ __forceinline__ XcdBarrier xcd_barrier_post(unsigned* bar, volatile LAS unsigned* st) {
    XcdBarrier b; b.bar = bar; b.x = xb_xcc_id(); b.st = st;
    if (threadIdx.x == 0) (void)xb_add(&bar[XB_XCNT(b.x)], 1u);
    return b;
}
__device__ __forceinline__ void xcd_barrier_complete(unsigned* bar, unsigned x, unsigned& nloc, unsigned& nx) {
    const unsigned G = gridDim.x * gridDim.y * gridDim.z;
    unsigned sum, cnt, mine, sp = 0u;
    for (;;) {
        sum = 0u; cnt = 0u; mine = 0u;
#pragma unroll
        for (unsigned j = 0; j < 16; ++j) { const unsigned c = xb_ld(&bar[XB_XCNT(j)]); sum += c; cnt += (c > 0u) ? 1u : 0u; mine = (j == x) ? c : mine; }
        if (sum == G) break;
        __builtin_amdgcn_s_sleep(1);
        if ((++sp & 255u) == 0u) { if (xb_ld(&bar[XB_TMO])) break; if (sp > XB_SPIN_CAP) { atomicAdd(&bar[XB_TMO], 1u); break; } }
    }
    nloc = mine > 0u ? mine : 1u; nx = cnt > 0u ? cnt : 1u;
}

__device__ __forceinline__ void xcd_barrier(const XcdBarrier& b) {
    asm volatile("s_waitcnt vmcnt(0)" ::: "memory");
    __syncthreads();
    if (threadIdx.x == 0) {
        unsigned* bar = b.bar;
        __builtin_amdgcn_s_waitcnt(0);
        unsigned nloc = b.st[0], nx = b.st[1];
        if (nloc == 0u) { xcd_barrier_complete(bar, b.x, nloc, nx); b.st[0] = nloc; b.st[1] = nx; }
        const unsigned old = xb_add(&bar[XB_XSUB(b.x)], 1u);
        const unsigned gen = old / nloc;
        if (old + 1u == (gen + 1u) * nloc) {
            __builtin_amdgcn_fence(__ATOMIC_RELEASE, "agent");
            asm volatile("s_waitcnt vmcnt(0)" ::: "memory");
            const unsigned og = xb_add(&bar[XB_TOP], 1u);
            const unsigned tg = og / nx;
            if (og + 1u == (tg + 1u) * nx) xb_add(&bar[XB_TOPGEN], 1u);
            else XB_SPIN(xb_ld(&bar[XB_TOPGEN]) == tg, bar);
            __builtin_amdgcn_fence(__ATOMIC_ACQUIRE, "agent");
            xb_add(&bar[XB_XGEN(b.x)], 1u);
            asm volatile("s_waitcnt vmcnt(0)" ::: "memory");
        } else {
            XB_SPIN(xb_ld(&bar[XB_XGEN(b.x)]) == gen, bar);
            __builtin_amdgcn_fence(__ATOMIC_ACQUIRE, "agent");
            asm volatile("s_waitcnt vmcnt(0)" ::: "memory");
        }
    }
    __syncthreads();
}

constexpr int NWAVES = 8, NTHR = 512;
constexpr int DMODEL = 1024, SEQ = 4096, NB = 4, NS = 32, ST = 8, NPG = 64, PAGE = 128;
constexpr int MP = NB * SEQ, MS = NS * ST, MT = MP + MS;
constexpr int FF = 2752, FFP = 2816, NGU = 2 * FFP, NIE = 2560, NIO = 1536;
constexpr float EPS = 1e-6f;
constexpr float C2 = 0.125f * 1.4426950408889634f;
constexpr float LAM_INIT0 = 0.2f;
constexpr int NSPLIT = 16, PSTR = 132;

constexpr size_t O_Y = 0;
constexpr size_t O_KP = O_Y + (size_t)MT * 1024;
constexpr size_t O_VP = O_KP + (size_t)MP * 512;
constexpr size_t O_CBP = O_VP + (size_t)MP * 512;
constexpr size_t O_HBP = O_CBP + NB * 3 * 512;
constexpr size_t O_CREP = O_HBP + NB * 512;
constexpr size_t O_CIMP = O_CREP + NB * 32 * 64;
constexpr size_t O_CDP = O_CIMP + NB * 32 * 64;
constexpr size_t O_KS = O_CDP + NB * 30 * 512;
constexpr size_t O_VS = O_KS + (size_t)MS * 512;
constexpr size_t O_CBS = O_VS + (size_t)MS * 512;
constexpr size_t O_HBS = O_CBS + NS * 3 * 512;
constexpr size_t O_CRES = O_HBS + NS * 512;
constexpr size_t O_CIMS = O_CRES + NS * 32 * 64;
constexpr size_t O_CDS = O_CIMS + NS * 32 * 64;
constexpr size_t O_END = O_CDS + NS * 30 * 512;
static_assert(O_END == 34852864, "output size");

enum { I_XP = 0, I_XS, I_CK, I_CV, I_SCB, I_SHB, I_SCRE, I_SCIM, I_SCD, I_PT, I_F1G, I_F1GU, I_F1DN, I_MIXG, I_F2G, I_F2GU, I_F2DN, I_EWIN, I_EWOUT, I_AQG, I_AKG, I_ALAM, I_AHG,
       I_BCW, I_BCB, I_BGW, I_BGB, I_BLAM, I_OWIN, I_OWOUT, I_CARE, I_CAIM, I_CLDT, I_CBRE, I_CBIM, I_CCRE, I_CCIM, I_CD, I_CGLUW, I_CGLUB, I_DCW, I_DCB, I_DLNG, I_DLNB, N_IN };
static_assert(N_IN == 44, "inputs");

constexpr size_t MiB = 1u << 20;
constexpr size_t WS_CTL = 0, CTL_ZERO_BYTES = 1 * MiB;
constexpr size_t WS_WGU = 2 * MiB, WGU_BYTES = (size_t)NGU * 1024 * 2;
constexpr size_t WS_WDN = 46 * MiB, WDN_BYTES = (size_t)1024 * FFP * 2;
constexpr size_t WS_WIE = 68 * MiB, WS_WOE = 73 * MiB, WS_WIO = 75 * MiB, WS_WOO = 78 * MiB, WS_WGLU = 80 * MiB;
constexpr size_t WS_XB = 82 * MiB;
constexpr size_t WS_SS = 115 * MiB;
constexpr size_t WS_H = 118 * MiB;
constexpr size_t WS_Q = 208 * MiB, WS_K = 225 * MiB, WS_V = 242 * MiB;
constexpr size_t WS_XBF = 259 * MiB, WS_GBF = 292 * MiB;
constexpr size_t WS_O2 = 325 * MiB;
constexpr size_t WS_MIX = 357 * MiB;
constexpr size_t WS_U = 390 * MiB, WS_G = 423 * MiB;
constexpr size_t WS_Z = 456 * MiB;
constexpr size_t WS_PART = 473 * MiB;
constexpr size_t WS_END = 492 * MiB;
static_assert(WS_WGU + 4 * WGU_BYTES <= WS_WDN && WS_WDN + 4 * WDN_BYTES <= WS_WIE && WS_XB + (size_t)MT * 1024 * 2 <= WS_SS && WS_SS + (size_t)MT * 64 <= WS_H && WS_H + (size_t)MT * FFP * 2 <= WS_Q, "ws map 1");
static_assert(WS_Q + (size_t)MT * 1024 <= WS_K && WS_V + (size_t)MT * 1024 <= WS_XBF && WS_XBF + (size_t)MT * 2048 <= WS_GBF && WS_GBF + (size_t)MT * 2048 <= WS_O2 && WS_O2 + (size_t)MP * 2048 <= WS_MIX, "ws map 2");
static_assert(WS_MIX + (size_t)MT * 2048 <= WS_U && WS_U + (size_t)MT * 2048 <= WS_G && WS_G + (size_t)MT * 2048 <= WS_Z && WS_Z + (size_t)MT * 1024 <= WS_PART && WS_PART + (size_t)NS * 4 * NSPLIT * 16 * PSTR * 4 <= WS_END, "ws map 3");
constexpr int CW_TMO = 0, CW_CODE = 1;
constexpr int CW_BAR = 4096;
constexpr int CW_Q0 = 8192, CW_Q1 = 8192 + 256;

constexpr int RING_OFF = 0, RING_BYTES = 131072;
constexpr int LDSCTL_OFF = RING_BYTES, MISC_OFF = LDSCTL_OFF + 320;
constexpr int LDS_BYTES = 147456;

typedef float f32x2 __attribute__((ext_vector_type(2)));
typedef unsigned u32x2 __attribute__((ext_vector_type(2)));
__device__ __forceinline__ float wave_sum(float v) {
#pragma unroll
    for (int o = 1; o < 64; o <<= 1) v += __shfl_xor(v, o);
    return v;
}
__device__ __forceinline__ float bf2f(unsigned h) { return __uint_as_float(h << 16); }
__device__ __forceinline__ float sigmoid_f(float x) { return __builtin_amdgcn_rcpf(1.f + __expf(-x)); }
__device__ __forceinline__ float gelu_tanh_f(float x) { return x * sigmoid_f(1.5957691216057308f * (x + 0.044715f * x * x * x)); }
__device__ __forceinline__ v4u pack8(const f32x4 a, const f32x4 b) { v4u w; w.x = pk2(a[0], a[1]); w.y = pk2(a[2], a[3]); w.z = pk2(b[0], b[1]); w.w = pk2(b[2], b[3]); return w; }
__device__ __forceinline__ float row_rstd(const float* SS, int r) {
    const f32x4* p = (const f32x4*)(SS + (size_t)r * 16);
    const f32x4 a = p[0], b = p[1], c = p[2], d = p[3];
    const float s = ((a[0] + a[1]) + (a[2] + a[3])) + ((b[0] + b[1]) + (b[2] + b[3])) + ((c[0] + c[1]) + (c[2] + c[3])) + ((d[0] + d[1]) + (d[2] + d[3]));
    return rsqrtf(s * (1.f / 1024.f) + EPS);
}

using pg8::Unit;
struct EpiSwiGLU {
    static constexpr bool PERM = true, AFTER_DRAIN = false;
    bf16* H; const float* SS;
    __device__ __forceinline__ void operator()(const f32x4 (&acc)[2][2][4][2], const Unit& u, int wr, int wc, int fr, int fq) const {
        const int row0 = u.pm * 256 + wr * 64 + fr, col0 = u.pn * 128 + wc * 32 + 8 * fq;
#pragma unroll
        for (int ai = 0; ai < 2; ++ai)
#pragma unroll
            for (int m = 0; m < 4; ++m) {
                const int r = row0 + ai * 128 + m * 16; const float rs = row_rstd(SS, r);
                f32x4 hv[2];
#pragma unroll
                for (int n = 0; n < 2; ++n) { const f32x4 g = acc[ai][0][m][n] * rs, up = acc[ai][1][m][n] * rs;
#pragma unroll
                    for (int i = 0; i < 4; ++i) hv[n][i] = g[i] * sigmoid_f(g[i]) * up[i]; }
                *(v4u*)(H + (size_t)r * FFP + col0) = pack8(hv[0], hv[1]);
            }
    }
};
struct EpiResid {
    static constexpr bool PERM = false, AFTER_DRAIN = false;
    float* X; bf16* XB; float* SS; float s; int wxb;
    __device__ __forceinline__ void operator()(const f32x4 (&acc)[2][2][4][2], const Unit& u, int wr, int wc, int fr, int fq) const {
        const int row0 = u.pm * 256 + wr * 64 + fr, col0 = u.pn * 256 + wc * 32 + 4 * fq;
#pragma unroll
        for (int ai = 0; ai < 2; ++ai)
#pragma unroll
            for (int m = 0; m < 4; ++m) {
                const int r = row0 + ai * 128 + m * 16; float q = 0.f;
#pragma unroll
                for (int bj = 0; bj < 2; ++bj)
#pragma unroll
                    for (int n = 0; n < 2; ++n) { const size_t off = (size_t)r * 1024 + col0 + bj * 128 + n * 16;
                        f32x4 x = *(const f32x4*)(X + off); x = x + acc[ai][bj][m][n] * s; *(f32x4*)(X + off) = x;
                        q += (x[0] * x[0] + x[1] * x[1]) + (x[2] * x[2] + x[3] * x[3]);
                        if (wxb) { u32x2 w; w.x = pk2(x[0], x[1]); w.y = pk2(x[2], x[3]); *(u32x2*)(XB + off) = w; } }
                q += __shfl_xor(q, 16); q += __shfl_xor(q, 32);
                if (wxb && fq == 0) SS[(size_t)r * 16 + u.pn * 4 + wc] = q;
            }
    }
};
struct EpiInEven {
    static constexpr bool PERM = true, AFTER_DRAIN = false;
    bf16 *Q, *K, *V; float *XBF, *GBF, *okp, *ovp, *oks, *ovs; const float *SS, *qg, *kg;
    __device__ __forceinline__ void operator()(const f32x4 (&acc)[2][2][4][2], const Unit& u, int wr, int wc, int fr, int fq) const {
        const int row0 = u.pm * 256 + wr * 64 + fr; const int t = u.pn >> 1, chunk = (u.pn & 1) * 4 + wc, fc0 = chunk * 64 + 8 * fq;
        f32x4 gn[2][2];
        if (t < 2) { const float* gp = (t == 0 ? qg : kg) + 8 * fq; const float gs = (t == 0) ? C2 : 1.f;
#pragma unroll
            for (int bj = 0; bj < 2; ++bj)
#pragma unroll
                for (int n = 0; n < 2; ++n) gn[bj][n] = *(const f32x4*)(gp + 32 * bj + 4 * n) * gs; }
#pragma unroll
        for (int ai = 0; ai < 2; ++ai)
#pragma unroll
            for (int m = 0; m < 4; ++m) {
                const int r = row0 + ai * 128 + m * 16; const float rs = row_rstd(SS, r);
                f32x4 v[2][2];
#pragma unroll
                for (int bj = 0; bj < 2; ++bj)
#pragma unroll
                    for (int n = 0; n < 2; ++n) v[bj][n] = acc[ai][bj][m][n] * rs;
                if (t < 2) {
                    float q = 0.f;
#pragma unroll
                    for (int bj = 0; bj < 2; ++bj)
#pragma unroll
                        for (int n = 0; n < 2; ++n) q += (v[bj][n][0] * v[bj][n][0] + v[bj][n][1] * v[bj][n][1]) + (v[bj][n][2] * v[bj][n][2] + v[bj][n][3] * v[bj][n][3]);
                    q += __shfl_xor(q, 16); q += __shfl_xor(q, 32);
                    const float nr = rsqrtf(q * (1.f / 64.f) + EPS);
#pragma unroll
                    for (int bj = 0; bj < 2; ++bj)
#pragma unroll
                        for (int n = 0; n < 2; ++n) v[bj][n] = v[bj][n] * nr * gn[bj][n];
                }
                const size_t o5 = (size_t)r * 512 + fc0;
                if (t == 0) { *(v4u*)(Q + o5) = pack8(v[0][0], v[0][1]); *(v4u*)(Q + o5 + 32) = pack8(v[1][0], v[1][1]); }
                else if (t <= 2) {
                    bf16* B = (t == 1) ? K : V; *(v4u*)(B + o5) = pack8(v[0][0], v[0][1]); *(v4u*)(B + o5 + 32) = pack8(v[1][0], v[1][1]);
                    float* O = (r < MP) ? ((t == 1 ? okp : ovp) + o5) : ((t == 1 ? oks : ovs) + (o5 - (size_t)MP * 512));
                    *(f32x4*)(O) = v[0][0]; *(f32x4*)(O + 4) = v[0][1]; *(f32x4*)(O + 32) = v[1][0]; *(f32x4*)(O + 36) = v[1][1];
                } else {
                    float* O = ((t == 3) ? XBF : GBF) + o5;
                    *(f32x4*)(O) = v[0][0]; *(f32x4*)(O + 4) = v[0][1]; *(f32x4*)(O + 32) = v[1][0]; *(f32x4*)(O + 36) = v[1][1];
                }
            }
    }
};
struct EpiInOdd {
    static constexpr bool PERM = false, AFTER_DRAIN = false;
    float *U, *G; const float* SS;
    __device__ __forceinline__ void operator()(const f32x4 (&acc)[2][2][4][2], const Unit& u, int wr, int wc, int fr, int fq) const {
        const int row0 = u.pm * 256 + wr * 64 + fr, cw = wc * 32 + 4 * fq;
#pragma unroll
        for (int ai = 0; ai < 2; ++ai)
#pragma unroll
            for (int m = 0; m < 4; ++m) {
                const int r = row0 + ai * 128 + m * 16; const float rs = row_rstd(SS, r);
                if (u.pn < 2) {
#pragma unroll
                    for (int bj = 0; bj < 2; ++bj)
#pragma unroll
                        for (int n = 0; n < 2; ++n) *(f32x4*)(U + (size_t)r * 512 + u.pn * 256 + bj * 128 + cw + n * 16) = acc[ai][bj][m][n] * rs;
                } else {
#pragma unroll
                    for (int n = 0; n < 2; ++n) { const f32x4 val = acc[ai][0][m][n] * rs, gt = acc[ai][1][m][n] * rs; f32x4 o;
#pragma unroll
                        for (int i = 0; i < 4; ++i) o[i] = val[i] * sigmoid_f(gt[i]);
                        *(f32x4*)(G + (size_t)r * 512 + (u.pn - 2) * 128 + cw + n * 16) = o; }
                }
            }
    }
};
struct EpiGLU {
    static constexpr bool PERM = true, AFTER_DRAIN = false;
    const bf16* Z; bf16* MIX; const float* bias;
    __device__ __forceinline__ void operator()(const f32x4 (&acc)[2][2][4][2], const Unit& u, int wr, int wc, int fr, int fq) const {
        const int row0 = u.pm * 256 + wr * 64 + fr, col0 = u.pn * 256 + wc * 32 + 8 * fq;
#pragma unroll
        for (int ai = 0; ai < 2; ++ai)
#pragma unroll
            for (int m = 0; m < 4; ++m) {
                const int r = row0 + ai * 128 + m * 16;
#pragma unroll
                for (int bj = 0; bj < 2; ++bj) { const int c = col0 + bj * 128;
                    const v4u zz = *(const v4u*)(Z + (size_t)r * 512 + c); const f32x4 b0 = *(const f32x4*)(bias + c), b1 = *(const f32x4*)(bias + c + 4);
                    const float z[8] = {bf2f(zz.x & 0xffffu), bf2f(zz.x >> 16), bf2f(zz.y & 0xffffu), bf2f(zz.y >> 16), bf2f(zz.z & 0xffffu), bf2f(zz.z >> 16), bf2f(zz.w & 0xffffu), bf2f(zz.w >> 16)};
                    f32x4 o0, o1;
#pragma unroll
                    for (int i = 0; i < 4; ++i) { o0[i] = z[i] * sigmoid_f(acc[ai][bj][m][0][i] + b0[i]); o1[i] = z[4 + i] * sigmoid_f(acc[ai][bj][m][1][i] + b1[i]); }
                    *(v4u*)(MIX + (size_t)r * 1024 + c) = pack8(o0, o1); }
            }
    }
};

template <int K>
__device__ __forceinline__ void gemm_small_resid(const bf16* A, const bf16* Bt, float* X, bf16* XB, float* SS, float s, bool wxb, LAS unsigned char* lds, int G, int first, int tid) {
    const int wave = __builtin_amdgcn_readfirstlane(tid >> 6), lane = tid & 63, m16 = lane & 15, quad = lane >> 4;
    constexpr int KW = K / 8, STEPS = KW / 32; static_assert(K % 256 == 0, "K split");
    LAS float* part = (LAS float*)lds;
    for (int tile = first; tile < 256; tile += G) {
        const int rt = tile >> 4, ct = tile & 15;
        const bf16* ap = A + (size_t)(rt * 16 + m16) * K + wave * KW + quad * 8;
        const bf16* bp = Bt + (size_t)(ct * 64 + m16) * K + wave * KW + quad * 8;
        f32x4 acc[4];
#pragma unroll
        for (int nt = 0; nt < 4; ++nt) acc[nt] = (f32x4){0.f, 0.f, 0.f, 0.f};
#pragma unroll 1
        for (int s0 = 0; s0 < STEPS; s0 += 4) {
            bf16x8 af[4], bfr[4][4];
#pragma unroll
            for (int j = 0; j < 4; ++j) if (s0 + j < STEPS) { af[j] = *(const bf16x8*)(ap + (s0 + j) * 32);
#pragma unroll
                for (int nt = 0; nt < 4; ++nt) bfr[j][nt] = *(const bf16x8*)(bp + (size_t)nt * 16 * K + (s0 + j) * 32); }
#pragma unroll
            for (int j = 0; j < 4; ++j) if (s0 + j < STEPS) {
#pragma unroll
                for (int nt = 0; nt < 4; ++nt) acc[nt] = __builtin_amdgcn_mfma_f32_16x16x32_bf16(af[j], bfr[j][nt], acc[nt], 0, 0, 0); }
        }
#pragma unroll
        for (int nt = 0; nt < 4; ++nt)
#pragma unroll
            for (int i = 0; i < 4; ++i) part[(wave * 16 + quad * 4 + i) * 68 + nt * 16 + m16] = acc[nt][i];
        __syncthreads();
        const int row = tid >> 5, cp = tid & 31; float s0_ = 0.f, s1_ = 0.f;
#pragma unroll
        for (int w = 0; w < 8; ++w) { const f32x2 v = *(const LAS f32x2*)(part + (w * 16 + row) * 68 + cp * 2); s0_ += v.x; s1_ += v.y; }
        const size_t off = (size_t)(rt * 16 + row) * 1024 + ct * 64 + cp * 2;
        f32x2 x = *(const f32x2*)(X + off); x.x += s * s0_; x.y += s * s1_; *(f32x2*)(X + off) = x;
        float q = x.x * x.x + x.y * x.y;
        if (wxb) *(unsigned*)(XB + off) = pk2(x.x, x.y);
#pragma unroll
        for (int o = 1; o < 32; o <<= 1) q += __shfl_xor(q, o);
        if (wxb && cp == 0) SS[(size_t)(rt * 16 + row) * 16 + ct] = q;
        __syncthreads();
    }
}

struct Args { const void* in[44]; float* out; unsigned char* ws; int ph_lo, ph_hi; };
struct Ctx {
    LAS unsigned char* lds; volatile LAS unsigned* MISC; gu32* ctl;
    int tid, lane, wave, vcu, G;
    float* out; unsigned char* ws;
};
#define INF(i) ((const float*)A.in[i])
#define P_XB ((bf16*)(C.ws + WS_XB))
#define P_H ((bf16*)(C.ws + WS_H))
#define P_Q ((bf16*)(C.ws + WS_Q))
#define P_K ((bf16*)(C.ws + WS_K))
#define P_V ((bf16*)(C.ws + WS_V))
#define P_O2 ((bf16*)(C.ws + WS_O2))
#define P_MIX ((bf16*)(C.ws + WS_MIX))
#define P_Z ((bf16*)(C.ws + WS_Z))
#define P_SS ((float*)(C.ws + WS_SS))
#define P_XBF ((float*)(C.ws + WS_XBF))
#define P_GBF ((float*)(C.ws + WS_GBF))
#define P_U ((float*)(C.ws + WS_U))
#define P_GG ((float*)(C.ws + WS_G))
#define P_PART ((float*)(C.ws + WS_PART))

__device__ __forceinline__ void conv_item(const float* __restrict__ W, int ldw, int scol0, bool kvalid, const float* __restrict__ gain, int k0, bf16* WT, int Kdst, int drow0, LAS float* scr, int lane) {
    const int c = lane & 7;
    if (scol0 < 0 || !kvalid) {
#pragma unroll
        for (int j = 0; j < 4; ++j) { const int n = (lane >> 3) + 8 * j; *(GAS v4u*)(WT + (size_t)(drow0 + n) * Kdst + k0 + 8 * c) = (v4u){0u, 0u, 0u, 0u}; }
        return;
    }
#pragma unroll 8
    for (int i = 0; i < 32; ++i) { const int kk = 2 * i + (lane >> 5); const float g = gain ? gain[k0 + kk] : 1.f; scr[kk * 33 + (lane & 31)] = W[(size_t)(k0 + kk) * ldw + scol0 + (lane & 31)] * g; }
    LDS_WAIT(); asm volatile("" ::: "memory");
#pragma unroll
    for (int j = 0; j < 4; ++j) { const int n = (lane >> 3) + 8 * j; const LAS float* s = scr + (8 * c) * 33 + n;
        v4u o; o.x = pk2(s[0 * 33], s[1 * 33]); o.y = pk2(s[2 * 33], s[3 * 33]); o.z = pk2(s[4 * 33], s[5 * 33]); o.w = pk2(s[6 * 33], s[7 * 33]);
        *(GAS v4u*)(WT + (size_t)(drow0 + n) * Kdst + k0 + 8 * c) = o; }
    LDS_WAIT(); asm volatile("" ::: "memory");
}
enum { WT_GU = 0, WT_NAT = 1, WT_INE = 2, WT_INO = 3 };
__device__ __forceinline__ int src_col(int type, int n0) {
    const int pn = n0 >> 8, bj = (n0 >> 7) & 1;
    if (type == WT_GU) { const int j = pn * 128 + (n0 & 127); return j < FF ? bj * FF + j : -1; }
    if (type == WT_INE) { const int t = pn >> 1, wc = (n0 >> 5) & 3; return t * 512 + ((pn & 1) * 4 + wc) * 64 + bj * 32; }
    if (type == WT_INO) { return pn < 2 ? n0 : 512 + bj * 512 + (pn - 2) * 128 + (n0 & 127); }
    return n0;
}
__device__ __forceinline__ void conv_mat(int type, const float* W, int ldw, int Ksrc, const float* gain, bf16* WT, int Kdst, int Ndst, int item, LAS float* scr, int lane) {
    const int nblk = Ndst / 32, kb = item / nblk, nb = item % nblk, k0 = kb * 64, n0 = nb * 32;
    conv_item(W, ldw, src_col(type, n0), k0 < Ksrc, gain, k0, WT, Kdst, n0, scr, lane);
}
__device__ __forceinline__ void p0_prologue(const Args& A, Ctx& C) {
    LAS float* scr = (LAS float*)(C.lds + RING_OFF + C.wave * 16384);
    const int gw = C.vcu * NWAVES + C.wave, NGW = C.G * NWAVES;
    constexpr int I_GU = 16 * (NGU / 32), I_DN = (FFP / 64) * 32, I_IE = 16 * (NIE / 32), I_O = 16 * 32, I_IO = 16 * (NIO / 32), I_GL = 8 * 16;
    constexpr int NITEMS = 4 * I_GU + 4 * I_DN + I_IE + I_O + I_IO + I_O + I_GL;
    for (int it = gw; it < NITEMS; it += NGW) {
        int r = it;
        if (r < 4 * I_GU) { const int mi = r / I_GU, l = mi >> 1, f = mi & 1; r -= mi * I_GU;
            conv_mat(WT_GU, (f ? INF(I_F2GU) : INF(I_F1GU)) + (size_t)l * 1024 * 5504, 5504, 1024, (f ? INF(I_F2G) : INF(I_F1G)) + l * 1024, (bf16*)(C.ws + WS_WGU + mi * WGU_BYTES), 1024, NGU, r, scr, C.lane); continue; }
        r -= 4 * I_GU;
        if (r < 4 * I_DN) { const int mi = r / I_DN, l = mi >> 1, f = mi & 1; r -= mi * I_DN;
            conv_mat(WT_NAT, (f ? INF(I_F2DN) : INF(I_F1DN)) + (size_t)l * FF * 1024, 1024, FF, nullptr, (bf16*)(C.ws + WS_WDN + mi * WDN_BYTES), FFP, 1024, r, scr, C.lane); continue; }
        r -= 4 * I_DN;
        if (r < I_IE) { conv_mat(WT_INE, INF(I_EWIN), NIE, 1024, INF(I_MIXG), (bf16*)(C.ws + WS_WIE), 1024, NIE, r, scr, C.lane); continue; } r -= I_IE;
        if (r < I_O) { conv_mat(WT_NAT, INF(I_EWOUT), 1024, 1024, nullptr, (bf16*)(C.ws + WS_WOE), 1024, 1024, r, scr, C.lane); continue; } r -= I_O;
        if (r < I_IO) { conv_mat(WT_INO, INF(I_OWIN), NIO, 1024, INF(I_MIXG) + 1024, (bf16*)(C.ws + WS_WIO), 1024, NIO, r, scr, C.lane); continue; } r -= I_IO;
        if (r < I_O) { conv_mat(WT_NAT, INF(I_OWOUT), 1024, 1024, nullptr, (bf16*)(C.ws + WS_WOO), 1024, 1024, r, scr, C.lane); continue; } r -= I_O;
        conv_mat(WT_NAT, INF(I_CGLUW), 512, 512, nullptr, (bf16*)(C.ws + WS_WGLU), 512, 512, r, scr, C.lane);
    }
    for (int m = gw; m < MT; m += NGW) {
        const float* xrow = (m < MP) ? INF(I_XP) + (size_t)m * 1024 : INF(I_XS) + (size_t)(m - MP) * 1024;
        const GAS f32x4* xr = (const GAS f32x4*)xrow + C.lane; GAS f32x4* xo = (GAS f32x4*)(C.out + (size_t)m * 1024) + C.lane;
        GAS unsigned long long* o8 = (GAS unsigned long long*)(P_XB + (size_t)m * 1024) + C.lane;
        f32x4 v[4]; float s = 0.f;
#pragma unroll
        for (int j = 0; j < 4; ++j) { v[j] = xr[64 * j]; s += (v[j].x * v[j].x + v[j].y * v[j].y) + (v[j].z * v[j].z + v[j].w * v[j].w); }
        s = wave_sum(s);
#pragma unroll
        for (int j = 0; j < 4; ++j) { xo[64 * j] = v[j]; o8[64 * j] = (unsigned long long)pk2(v[j].x, v[j].y) | ((unsigned long long)pk2(v[j].z, v[j].w) << 32); }
        if (C.lane < 16) P_SS[(size_t)m * 16 + C.lane] = (C.lane == 0) ? s : 0.f;
    }
}

__device__ __forceinline__ int q_fetch(Ctx& C, int cw) {
    __syncthreads();
    if (C.tid == 0) C.MISC[16] = __hip_atomic_fetch_add(C.ctl + cw, 1u, RLX_AGENT);
    __syncthreads();
    return (int)__builtin_amdgcn_readfirstlane(C.MISC[16]);
}
__device__ __forceinline__ float lam_value(const float* lv, int lane) {
    const float a = wave_sum(lv[lane] * lv[64 + lane]), b = wave_sum(lv[128 + lane] * lv[192 + lane]);
    return expf(a) - expf(b) + LAM_INIT0;
}

template <bool SAMPLE>
__device__ __forceinline__ void rglru_item(const Args& A, Ctx& C, int bi, int blk) {
    LAS float* R0 = (LAS float*)(C.lds);
    LAS float* R1 = (LAS float*)(C.lds + 45056);
    LAS float* R2 = (LAS float*)(C.lds + 77824);
    LAS float* RP = (LAS float*)(C.lds + 110592);
    LAS float* RH = RP + 512;
    LAS float* RI = RH + 512;
    const int c = C.tid & 63, sub = C.wave, g = sub & 1, tq = sub >> 1, ch0 = blk * 64 + c;
    float W[64];
    { const float* wp = INF(I_BGW) + ((size_t)(g * 8 + blk) * 64) * 64 + c;
#pragma unroll
      for (int i = 0; i < 64; ++i) W[i] = wp[i * 64]; }
    const float gbias = INF(I_BGB)[g * 512 + ch0];
    const float sp8 = -8.f * log1pf(expf(-INF(I_BLAM)[ch0]));
    const float w0 = INF(I_BCW)[0 * 512 + ch0], w1 = INF(I_BCW)[1 * 512 + ch0], w2 = INF(I_BCW)[2 * 512 + ch0], w3 = INF(I_BCW)[3 * 512 + ch0], cb = INF(I_BCB)[ch0];
    if (!SAMPLE) { if (C.tid < 128) RI[C.tid] = 0.f; }
    const int NCH = SAMPLE ? 1 : 32;
    for (int ch = 0; ch < NCH; ++ch) {
        if (!SAMPLE) {
            const int t0 = ch * 128;
            for (int i = sub; i < 131; i += 8) { const int tk = t0 - 3 + i; float v = 0.f;
                if (tk >= 0) v = P_XBF[(size_t)(bi * SEQ + tk) * 512 + ch0];
                R0[i * 64 + c] = v;
                if (ch == 31 && i >= 128) C.out[O_CBP + (size_t)(bi * 3 + (i - 128)) * 512 + ch0] = v; }
        } else {
            for (int i = sub; i < 176; i += 8) { const int sl = i / 11, k = i % 11, n = bi * 16 + sl; float v;
                if (k < 3) v = INF(I_SCB)[(size_t)(n * 3 + k) * 512 + ch0]; else v = P_XBF[(size_t)(MP + n * 8 + (k - 3)) * 512 + ch0];
                R0[i * 64 + c] = v;
                if (k >= 8) C.out[O_CBS + (size_t)(n * 3 + (k - 8)) * 512 + ch0] = v; }
        }
        __syncthreads();
#pragma unroll 4
        for (int k = 0; k < 16; ++k) { const int lr = sub * 16 + k; const int base = SAMPLE ? ((lr >> 3) * 11 + (lr & 7)) : lr;
            R1[lr * 64 + c] = cb + w0 * R0[base * 64 + c] + w1 * R0[(base + 1) * 64 + c] + w2 * R0[(base + 2) * 64 + c] + w3 * R0[(base + 3) * 64 + c]; }
        __syncthreads();
#pragma unroll 2
        for (int k = 0; k < 32; ++k) { const int lr = tq * 32 + k; const LAS float* xr = R1 + lr * 64; float acc = 0.f;
#pragma unroll
            for (int i4 = 0; i4 < 16; ++i4) { const f32x4 x = *(const LAS f32x4*)(xr + 4 * i4); acc += x[0] * W[4 * i4] + x[1] * W[4 * i4 + 1] + x[2] * W[4 * i4 + 2] + x[3] * W[4 * i4 + 3]; }
            const float sg = sigmoid_f(acc + gbias);
            if (g == 0) R0[lr * 64 + c] = sp8 * sg; else R2[lr * 64 + c] = sg * xr[c]; }
        __syncthreads();
        if (!SAMPLE) {
            const int t0 = ch * 128; float P = 1.f, Hl = 0.f;
#pragma unroll 4
            for (int k = 0; k < 16; ++k) { const int lr = sub * 16 + k; const float la = R0[lr * 64 + c]; const float a = __expf(la), bb = sqrtf(-expm1f(2.f * la)) * R2[lr * 64 + c];
                R0[lr * 64 + c] = a; R2[lr * 64 + c] = bb; P *= a; Hl = a * Hl + bb; }
            RP[sub * 64 + c] = P; RH[sub * 64 + c] = Hl;
            __syncthreads();
            float h = RI[(ch & 1) * 64 + c];
            for (int k2 = 0; k2 < sub; ++k2) h = RP[k2 * 64 + c] * h + RH[k2 * 64 + c];
            const size_t row0 = (size_t)bi * SEQ + t0 + sub * 16;
#pragma unroll 4
            for (int k = 0; k < 16; ++k) { const int lr = sub * 16 + k; h = R0[lr * 64 + c] * h + R2[lr * 64 + c];
                const float gv = P_GBF[(row0 + k) * 512 + ch0];
                P_MIX[(row0 + k) * 1024 + 512 + ch0] = (bf16)f2bf(gelu_tanh_f(gv) * h); }
            if (sub == 7) { RI[((ch + 1) & 1) * 64 + c] = h; if (ch == 31) C.out[O_HBP + (size_t)bi * 512 + ch0] = h; }
        } else {
#pragma unroll
            for (int s2 = 0; s2 < 2; ++s2) { const int sl = sub * 2 + s2, n = bi * 16 + sl; float h = INF(I_SHB)[(size_t)n * 512 + ch0];
#pragma unroll
                for (int t = 0; t < 8; ++t) { const int lr = sl * 8 + t; const float la = R0[lr * 64 + c]; const float a = __expf(la), bb = sqrtf(-expm1f(2.f * la)) * R2[lr * 64 + c];
                    h = a * h + bb; const size_t row = (size_t)MP + n * 8 + t;
                    const float gv = P_GBF[row * 512 + ch0];
                    P_MIX[row * 1024 + 512 + ch0] = (bf16)f2bf(gelu_tanh_f(gv) * h); }
                C.out[O_HBS + (size_t)n * 512 + ch0] = h; }
        }
        __syncthreads();
    }
}

__device__ __forceinline__ bf16x8 cvt8(const f32x4 a, const f32x4 b) { const v4u w = pack8(a, b); return __builtin_bit_cast(bf16x8, w); }
__device__ __forceinline__ void sattn_wave(const Args& A, Ctx& C, int n, int h, int s) {
    const int lane = C.lane, m16 = lane & 15, quad = lane >> 4, j = m16 >> 3, q = m16 & 7;
    bf16x8 bq[4];
#pragma unroll
    for (int kk = 0; kk < 4; ++kk) { bq[kk] = (bf16x8){0, 0, 0, 0, 0, 0, 0, 0};
        if (j == (kk >> 1)) bq[kk] = *(const bf16x8*)(P_Q + (size_t)(MP + n * 8 + q) * 512 + (h * 2 + j) * 64 + (kk & 1) * 32 + quad * 8); }
    float mrow = -1e30f, l = 0.f; f32x4 o[8];
#pragma unroll
    for (int dg = 0; dg < 8; ++dg) o[dg] = (f32x4){0.f, 0.f, 0.f, 0.f};
    const float* ck = INF(I_CK); const float* cv = INF(I_CV);
    for (int pg = s * (NPG / NSPLIT); pg < (s + 1) * (NPG / NSPLIT); ++pg) {
        const int phys = ((const int*)A.in[I_PT])[n * NPG + pg];
        const float* kp = ck + ((size_t)phys * PAGE) * 512 + h * 128;
        const float* vp = cv + ((size_t)phys * PAGE) * 512 + h * 128;
#pragma unroll 1
        for (int ks = 0; ks < 4; ++ks) {
            const int kb = ks * 32;
            f32x4 st[2];
#pragma unroll
            for (int tt = 0; tt < 2; ++tt) { const float* kr = kp + (size_t)(kb + tt * 16 + m16) * 512 + quad * 8; f32x4 acc = (f32x4){0.f, 0.f, 0.f, 0.f};
#pragma unroll
                for (int kk = 0; kk < 4; ++kk) { const f32x4 x0 = *(const f32x4*)(kr + kk * 32), x1 = *(const f32x4*)(kr + kk * 32 + 4);
                    acc = __builtin_amdgcn_mfma_f32_16x16x32_bf16(cvt8(x0, x1), bq[kk], acc, 0, 0, 0); }
                st[tt] = acc; }
            float mx = fmaxf(fmaxf(fmaxf(st[0][0], st[0][1]), fmaxf(st[0][2], st[0][3])), fmaxf(fmaxf(st[1][0], st[1][1]), fmaxf(st[1][2], st[1][3])));
            mx = fmaxf(mx, __shfl_xor(mx, 16)); mx = fmaxf(mx, __shfl_xor(mx, 32));
            const float mn = fmaxf(mrow, mx), sc = exp2f(mrow - mn); mrow = mn;
            f32x4 p0, p1; float ps = 0.f;
#pragma unroll
            for (int i = 0; i < 4; ++i) { p0[i] = exp2f(st[0][i] - mn); p1[i] = exp2f(st[1][i] - mn); ps += p0[i] + p1[i]; }
            l = l * sc + ps;
            const bf16x8 pb = cvt8(p0, p1);
#pragma unroll
            for (int dg = 0; dg < 8; ++dg) { const float* vr = vp + (size_t)(kb + quad * 4) * 512 + dg * 16 + m16;
                f32x4 v0, v1;
#pragma unroll
                for (int i = 0; i < 4; ++i) { v0[i] = vr[(size_t)i * 512]; v1[i] = vr[(size_t)(16 + i) * 512]; }
                o[dg] = o[dg] * sc; o[dg] = __builtin_amdgcn_mfma_f32_16x16x32_bf16(cvt8(v0, v1), pb, o[dg], 0, 0, 0); }
        }
    }
    l += __shfl_xor(l, 16); l += __shfl_xor(l, 32);
    float* pr = P_PART + ((size_t)((n * 4 + h) * NSPLIT + s) * 16 + m16) * PSTR;
#pragma unroll
    for (int dg = 0; dg < 8; ++dg) *(f32x4*)(pr + dg * 16 + quad * 4) = o[dg];
    if (quad == 0) { pr[128] = mrow; pr[129] = l; }
}

__device__ __forceinline__ void p5_combine(const Args& A, Ctx& C) {
    const int gw = C.vcu * NWAVES + C.wave, NGW = C.G * NWAVES, lane = C.lane;
    const float lam = lam_value(INF(I_ALAM), lane);
    const float osc = 1.f - LAM_INIT0;
    {
        const int hh = lane >> 4, e0 = (lane & 15) * 8;
        const f32x4 g0 = *(const f32x4*)(INF(I_AHG) + e0), g1 = *(const f32x4*)(INF(I_AHG) + e0 + 4);
        for (int r = gw; r < MP; r += NGW) {
            const v4u a = *(const v4u*)(P_O2 + (size_t)r * 1024 + hh * 128 + e0), b = *(const v4u*)(P_O2 + (size_t)r * 1024 + 512 + hh * 128 + e0);
            const unsigned aw[4] = {a.x, a.y, a.z, a.w}, bw[4] = {b.x, b.y, b.z, b.w}; float d[8]; float q = 0.f;
#pragma unroll
            for (int i = 0; i < 4; ++i) { d[2 * i] = bf2f(aw[i] & 0xffffu) - lam * bf2f(bw[i] & 0xffffu); d[2 * i + 1] = bf2f(aw[i] >> 16) - lam * bf2f(bw[i] >> 16); q += d[2 * i] * d[2 * i] + d[2 * i + 1] * d[2 * i + 1]; }
            q += __shfl_xor(q, 1); q += __shfl_xor(q, 2); q += __shfl_xor(q, 4); q += __shfl_xor(q, 8);
            const float rs = rsqrtf(q * (1.f / 128.f) + EPS) * osc;
            f32x4 o0, o1;
#pragma unroll
            for (int i = 0; i < 4; ++i) { o0[i] = d[i] * rs * g0[i]; o1[i] = d[4 + i] * rs * g1[i]; }
            *(v4u*)(P_MIX + (size_t)r * 1024 + hh * 128 + e0) = pack8(o0, o1);
        }
    }
    {
        const int jh = lane >> 5, el = lane & 31, e0 = el * 4;
        const f32x4 hg = *(const f32x4*)(INF(I_AHG) + e0);
        for (int it = gw; it < NS * 4; it += NGW) {
            const int n = it >> 2, h = it & 3;
            const float* pbase = P_PART + ((size_t)(n * 4 + h) * NSPLIT * 16) * PSTR;
#pragma unroll 1
            for (int q = 0; q < 8; ++q) {
                const int row = jh * 8 + q;
                float ms[NSPLIT], ls[NSPLIT]; float M = -1e30f;
#pragma unroll
                for (int s = 0; s < NSPLIT; ++s) { const float* pr = pbase + ((size_t)s * 16 + row) * PSTR; ms[s] = pr[128]; ls[s] = pr[129]; M = fmaxf(M, ms[s]); }
                const unsigned qw = *(const unsigned*)(P_Q + (size_t)(MP + n * 8 + q) * 512 + (h * 2 + jh) * 64 + el * 2);
                const float q0 = bf2f(qw & 0xffffu), q1 = bf2f(qw >> 16);
                float sc[8];
#pragma unroll
                for (int t = 0; t < 8; ++t) { const f32x2 kv = *(const f32x2*)(C.out + O_KS + (size_t)(n * 8 + t) * 512 + (h * 2 + jh) * 64 + el * 2);
                    float d = q0 * kv.x + q1 * kv.y;
#pragma unroll
                    for (int o = 1; o < 32; o <<= 1) d += __shfl_xor(d, o);
                    sc[t] = (t <= q) ? d : -1e30f; M = fmaxf(M, sc[t]); }
                float L = 0.f; f32x4 O = (f32x4){0.f, 0.f, 0.f, 0.f};
#pragma unroll
                for (int s = 0; s < NSPLIT; ++s) { const float w = exp2f(ms[s] - M); L += ls[s] * w; O = O + *(const f32x4*)(pbase + ((size_t)s * 16 + row) * PSTR + e0) * w; }
#pragma unroll
                for (int t = 0; t < 8; ++t) { const float p = (t <= q) ? exp2f(sc[t] - M) : 0.f; L += p; O = O + *(const f32x4*)(C.out + O_VS + (size_t)(n * 8 + t) * 512 + h * 128 + e0) * p; }
                O = O * (1.f / L);
                f32x4 other;
#pragma unroll
                for (int i = 0; i < 4; ++i) other[i] = __shfl_xor(O[i], 32);
                f32x4 att = (jh == 0) ? (O - other * lam) : (other - O * lam);
                float qq = (att[0] * att[0] + att[1] * att[1]) + (att[2] * att[2] + att[3] * att[3]);
#pragma unroll
                for (int o = 1; o < 32; o <<= 1) qq += __shfl_xor(qq, o);
                const float rs = rsqrtf(qq * (1.f / 128.f) + EPS) * osc;
                if (jh == 0) { u32x2 w; w.x = pk2(att[0] * rs * hg[0], att[1] * rs * hg[1]); w.y = pk2(att[2] * rs * hg[2], att[3] * rs * hg[3]);
                    *(u32x2*)(P_MIX + (size_t)(MP + n * 8 + q) * 1024 + h * 128 + e0) = w; }
            }
        }
    }
}

__device__ __forceinline__ void sincos_f(float x, float& sn, float& cs) {
    const float k = rintf(x * 0.63661977236758134f);
    float r = fmaf(-k, 1.5707963705062866f, x); r = fmaf(-k, -4.3711388286737929e-8f, r);
    const float r2 = r * r;
    const float s = r + r * r2 * (-1.6666654611e-1f + r2 * (8.3321608736e-3f + r2 * (-1.9515295891e-4f)));
    const float c = 1.f - 0.5f * r2 + r2 * r2 * (4.166664568298827e-2f + r2 * (-1.388731625493765e-3f + r2 * 2.443315711809948e-5f));
    const int qd = ((int)k) & 3;
    sn = (qd == 0) ? s : (qd == 1) ? c : (qd == 2) ? -s : -c;
    cs = (qd == 0) ? c : (qd == 1) ? -s : (qd == 2) ? -c : s;
}
template <bool SAMPLE>
__device__ __forceinline__ void s5_item(const Args& A, Ctx& C, int bi, int g) {
    LAS float* Uc = (LAS float*)(C.lds);
    LAS float* Sre = (LAS float*)(C.lds + 8192);
    LAS float* Sim = (LAS float*)(C.lds + 8192 + 33280);
    LAS float* Cre = (LAS float*)(C.lds + 74752);
    LAS float* Cim = Cre + 1024;
    LAS float* Lre = Cim + 1024;
    LAS float* Lim = Lre + 512;
    LAS float* Ire = Lim + 512;
    LAS float* Iim = Ire + 128;
    const int p = C.tid & 63, sub = C.wave;
    float Bre[16], Bim[16];
    { const f32x4* b1 = (const f32x4*)(INF(I_CBRE) + ((size_t)g * 64 + p) * 16); const f32x4* b2 = (const f32x4*)(INF(I_CBIM) + ((size_t)g * 64 + p) * 16);
#pragma unroll
      for (int i = 0; i < 4; ++i) { const f32x4 x = b1[i], y = b2[i];
#pragma unroll
          for (int k = 0; k < 4; ++k) { Bre[4 * i + k] = x[k]; Bim[4 * i + k] = y[k]; } } }
    float ar, ai, cr, ci, a16r, a16i;
    { const float dt = expf(INF(I_CLDT)[g]), are = INF(I_CARE)[g * 64 + p], aim = INF(I_CAIM)[g * 64 + p];
      const float mag = expf(dt * are); float sn, cs; sincos_f(dt * aim, sn, cs);
      ar = mag * cs; ai = mag * sn;
      const float den = are * are + aim * aim, nr = ar - 1.f;
      cr = (nr * are + ai * aim) / den; ci = (ai * are - nr * aim) / den;
      a16r = ar; a16i = ai;
#pragma unroll
      for (int k = 0; k < 4; ++k) { const float t = a16r * a16r - a16i * a16i; a16i = 2.f * a16r * a16i; a16r = t; } }
    for (int i = C.tid; i < 1024; i += NTHR) { Cre[i] = INF(I_CCRE)[(size_t)g * 1024 + i]; Cim[i] = INF(I_CCIM)[(size_t)g * 1024 + i]; }
    if (!SAMPLE) { if (C.tid < 128) { Ire[C.tid] = 0.f; Iim[C.tid] = 0.f; } }
    const f32x4 dv = *(const f32x4*)(INF(I_CD) + g * 16 + (C.tid >> 7) * 4);
    const int NCH = SAMPLE ? 1 : 32;
    for (int ch = 0; ch < NCH; ++ch) {
        const size_t grow0 = SAMPLE ? (size_t)MP + bi * 128 : (size_t)bi * SEQ + ch * 128;
        { const int row = C.tid >> 2, qd = C.tid & 3; *(LAS f32x4*)(Uc + row * 16 + qd * 4) = *(const f32x4*)(P_U + (grow0 + row) * 512 + g * 16 + qd * 4); }
        __syncthreads();
#pragma unroll 2
        for (int k = 0; k < 16; ++k) { const int t = sub * 16 + k; float br = 0.f, bi2 = 0.f;
#pragma unroll
            for (int i4 = 0; i4 < 4; ++i4) { const f32x4 x = *(const LAS f32x4*)(Uc + t * 16 + 4 * i4);
#pragma unroll
                for (int e = 0; e < 4; ++e) { br += x[e] * Bre[4 * i4 + e]; bi2 += x[e] * Bim[4 * i4 + e]; } }
            Sre[t * 65 + p] = cr * br - ci * bi2; Sim[t * 65 + p] = cr * bi2 + ci * br; }
        if (!SAMPLE) {
            float sr = 0.f, si = 0.f;
#pragma unroll 4
            for (int k = 0; k < 16; ++k) { const int t = sub * 16 + k; const float nr_ = ar * sr - ai * si + Sre[t * 65 + p], ni_ = ar * si + ai * sr + Sim[t * 65 + p]; sr = nr_; si = ni_; }
            Lre[sub * 64 + p] = sr; Lim[sub * 64 + p] = si;
            __syncthreads();
            sr = Ire[(ch & 1) * 64 + p]; si = Iim[(ch & 1) * 64 + p];
            for (int k2 = 0; k2 < sub; ++k2) { const float nr_ = a16r * sr - a16i * si + Lre[k2 * 64 + p], ni_ = a16r * si + a16i * sr + Lim[k2 * 64 + p]; sr = nr_; si = ni_; }
#pragma unroll 4
            for (int k = 0; k < 16; ++k) { const int t = sub * 16 + k; const float nr_ = ar * sr - ai * si + Sre[t * 65 + p], ni_ = ar * si + ai * sr + Sim[t * 65 + p]; sr = nr_; si = ni_; Sre[t * 65 + p] = sr; Sim[t * 65 + p] = si; }
            if (sub == 7) { Ire[((ch + 1) & 1) * 64 + p] = sr; Iim[((ch + 1) & 1) * 64 + p] = si;
                if (ch == 31) { C.out[O_CREP + (size_t)(bi * 32 + g) * 64 + p] = sr; C.out[O_CIMP + (size_t)(bi * 32 + g) * 64 + p] = si; } }
        } else {
#pragma unroll
            for (int s2 = 0; s2 < 2; ++s2) { const int sl = sub * 2 + s2, n = bi * 16 + sl;
                float sr = INF(I_SCRE)[(size_t)(n * 32 + g) * 64 + p], si = INF(I_SCIM)[(size_t)(n * 32 + g) * 64 + p];
#pragma unroll
                for (int t8 = 0; t8 < 8; ++t8) { const int t = sl * 8 + t8; const float nr_ = ar * sr - ai * si + Sre[t * 65 + p], ni_ = ar * si + ai * sr + Sim[t * 65 + p]; sr = nr_; si = ni_; Sre[t * 65 + p] = sr; Sim[t * 65 + p] = si; }
                C.out[O_CRES + (size_t)(n * 32 + g) * 64 + p] = sr; C.out[O_CIMS + (size_t)(n * 32 + g) * 64 + p] = si; }
        }
        __syncthreads();
        { const int t = C.tid & 127, cq = C.tid >> 7; float y[4] = {0.f, 0.f, 0.f, 0.f};
#pragma unroll 4
          for (int p4 = 0; p4 < 16; ++p4) { float xr[4], xi[4];
#pragma unroll
              for (int e = 0; e < 4; ++e) { xr[e] = Sre[t * 65 + 4 * p4 + e]; xi[e] = Sim[t * 65 + 4 * p4 + e]; }
#pragma unroll
              for (int k = 0; k < 4; ++k) { const f32x4 c1 = *(const LAS f32x4*)(Cre + (cq * 4 + k) * 64 + 4 * p4), c2 = *(const LAS f32x4*)(Cim + (cq * 4 + k) * 64 + 4 * p4);
#pragma unroll
                  for (int e = 0; e < 4; ++e) y[k] += xr[e] * c1[e] - xi[e] * c2[e]; } }
          const f32x4 uu = *(const LAS f32x4*)(Uc + t * 16 + cq * 4);
          u32x2 w; w.x = pk2(gelu_tanh_f(y[0] + dv[0] * uu[0]), gelu_tanh_f(y[1] + dv[1] * uu[1])); w.y = pk2(gelu_tanh_f(y[2] + dv[2] * uu[2]), gelu_tanh_f(y[3] + dv[3] * uu[3]));
          *(u32x2*)(P_Z + (grow0 + t) * 512 + g * 16 + cq * 4) = w; }
        __syncthreads();
    }
}

template <bool SAMPLE>
__device__ __forceinline__ void conf_item(const Args& A, Ctx& C, int bi, int tb) {
    constexpr int NT = SAMPLE ? 8 : 32, NI = NT + 30;
    LAS float* Cc = (LAS float*)(C.lds);
    const int c = C.tid;
    float w[31];
#pragma unroll
    for (int k = 0; k < 31; ++k) w[k] = INF(I_DCW)[k * 512 + c];
    const float cb = INF(I_DCB)[c];
    float inp[NI];
    if (!SAMPLE) {
        const int t0 = tb * 32;
#pragma unroll
        for (int i = 0; i < NI; ++i) { const int tk = t0 - 30 + i; inp[i] = (tk >= 0) ? P_GG[(size_t)(bi * SEQ + tk) * 512 + c] : 0.f; }
        if (tb == SEQ / 32 - 1) {
#pragma unroll
            for (int i = 32; i < NI; ++i) C.out[O_CDP + (size_t)(bi * 30 + (i - 32)) * 512 + c] = inp[i]; }
    } else {
#pragma unroll
        for (int i = 0; i < NI; ++i) inp[i] = (i < 30) ? INF(I_SCD)[(size_t)(bi * 30 + i) * 512 + c] : P_GG[(size_t)(MP + bi * 8 + (i - 30)) * 512 + c];
#pragma unroll
        for (int i = 8; i < NI; ++i) C.out[O_CDS + (size_t)(bi * 30 + (i - 8)) * 512 + c] = inp[i];
    }
#pragma unroll
    for (int t = 0; t < NT; ++t) { float acc = cb;
#pragma unroll
        for (int k = 0; k < 31; ++k) acc += w[k] * inp[t + k];
        Cc[t * 512 + c] = acc; }
    __syncthreads();
    { const int lane = C.lane; const f32x4 g0 = *(const f32x4*)(INF(I_DLNG) + lane * 8), g1 = *(const f32x4*)(INF(I_DLNG) + lane * 8 + 4), b0 = *(const f32x4*)(INF(I_DLNB) + lane * 8), b1 = *(const f32x4*)(INF(I_DLNB) + lane * 8 + 4);
      constexpr int TPW = NT / 8;
#pragma unroll 1
      for (int k = 0; k < TPW; ++k) { const int t = C.wave * TPW + k;
          f32x4 x0 = *(const LAS f32x4*)(Cc + t * 512 + lane * 8), x1 = *(const LAS f32x4*)(Cc + t * 512 + lane * 8 + 4);
          const float mean = wave_sum((x0[0] + x0[1]) + (x0[2] + x0[3]) + (x1[0] + x1[1]) + (x1[2] + x1[3])) * (1.f / 512.f);
          x0 = x0 - mean; x1 = x1 - mean;
          const float var = wave_sum((x0[0] * x0[0] + x0[1] * x0[1]) + (x0[2] * x0[2] + x0[3] * x0[3]) + (x1[0] * x1[0] + x1[1] * x1[1]) + (x1[2] * x1[2] + x1[3] * x1[3])) * (1.f / 512.f);
          const float rs = rsqrtf(var + EPS); f32x4 o0, o1;
#pragma unroll
          for (int i = 0; i < 4; ++i) { const float y0 = x0[i] * rs * g0[i] + b0[i], y1 = x1[i] * rs * g1[i] + b1[i]; o0[i] = y0 * sigmoid_f(y0); o1[i] = y1 * sigmoid_f(y1); }
          const size_t row = SAMPLE ? (size_t)MP + bi * 8 + t : (size_t)bi * SEQ + tb * 32 + t;
          *(v4u*)(P_MIX + row * 1024 + 512 + lane * 8) = pack8(o0, o1); } }
    __syncthreads();
}

#ifndef MK_N_LAUNCHES
#define MK_N_LAUNCHES 1
#endif
#ifndef MK_DISABLE
#define MK_DISABLE 0
#endif
#define DIS(m) ((MK_DISABLE & (m)) != 0)
constexpr int N_PHASES = 17;
constexpr int N_LAUNCHES = MK_N_LAUNCHES;
static_assert(N_LAUNCHES == 1 || N_LAUNCHES == N_PHASES, "MK_N_LAUNCHES is 1 or 17");

template <int LO, int HI> __global__ void __launch_bounds__(NTHR, 2) mega_fwd(Args args) {
    extern __shared__ __attribute__((aligned(16))) unsigned char lds[];
    const Args& A = args;
    Ctx C;
    C.lds = (LAS unsigned char*)lds; C.MISC = (volatile LAS unsigned*)(C.lds + MISC_OFF);
    C.tid = threadIdx.x; C.lane = C.tid & 63; C.wave = __builtin_amdgcn_readfirstlane(C.tid >> 6);
    C.G = gridDim.x; { const int bx = blockIdx.x; C.vcu = (C.G % 8 == 0) ? (bx % 8) * (C.G / 8) + bx / 8 : bx; }
    unsigned char* ws = args.ws; C.ws = ws; C.out = args.out; C.ctl = (gu32*)(ws + WS_CTL);
    for (int u = C.tid; u < (LDS_BYTES - LDSCTL_OFF) / 4; u += NTHR) ((LAS unsigned*)(C.lds + LDSCTL_OFF))[u] = 0u;
    __syncthreads();
    XcdBarrier bar; bar.bar = (unsigned*)(C.ctl + CW_BAR); bar.x = 0; bar.st = nullptr;
    if (HI - LO > 1) bar = xcd_barrier_post((unsigned*)(C.ctl + CW_BAR), C.MISC + 8);
#define GRID_BAR() do { if (HI - LO > 1) { xcd_barrier(bar); } } while (0)
    constexpr int lo = LO, hi = HI;
#define IN(k) (lo <= (k) && (k) < hi)
#define BOTH(k) (IN(k) && IN((k) + 1))
    LAS unsigned char* ring = C.lds + RING_OFF;
    float* X = C.out;

#define PHASE_BEGIN() do { int t_ = threadIdx.x; asm volatile("" : "+v"(t_)); C.tid = t_; C.lane = t_ & 63; C.wave = __builtin_amdgcn_readfirstlane(t_ >> 6); \
        unsigned char* w_ = args.ws; asm volatile("" : "+s"(w_)); C.ws = w_; ws = w_; C.ctl = (gu32*)w_; float* o_ = args.out; asm volatile("" : "+s"(o_)); C.out = o_; X = o_; } while (0)
    if (IN(0)) { PHASE_BEGIN(); if (!DIS(64)) p0_prologue(args, C); if (BOTH(0)) GRID_BAR(); }

#define FFN_UP(ph, mi) if (IN(ph)) { PHASE_BEGIN(); pg8::Gemm g{P_XB, (const bf16*)(ws + WS_WGU + (mi) * WGU_BYTES), MT, NGU, 1024}; pg8::StaticOrder S; S.init(MT, NGU, C.G, (int)blockIdx.x); \
        EpiSwiGLU E{P_H, P_SS}; pg8::gemm_phase<EpiSwiGLU, pg8::StaticOrder, true, true>(ring, g, S, E); if (BOTH(ph)) GRID_BAR(); }
#define GEMM_RESID(ph, Aptr, KK, Wptr, scale, wxb) if (IN(ph)) { PHASE_BEGIN(); pg8::Gemm g{Aptr, Wptr, MP, 1024, KK}; pg8::StaticOrder S; S.init(MP, 1024, C.G, (int)blockIdx.x); \
        EpiResid E{X, P_XB, P_SS, scale, wxb}; pg8::gemm_phase<EpiResid, pg8::StaticOrder, true, true>(ring, g, S, E); \
        gemm_small_resid<KK>((Aptr) + (size_t)MP * (KK), Wptr, X + (size_t)MP * 1024, P_XB + (size_t)MP * 1024, P_SS + (size_t)MP * 16, scale, (wxb) != 0, ring, C.G, (int)blockIdx.x, C.tid); \
        if (BOTH(ph)) GRID_BAR(); }

    FFN_UP(1, 0)
    GEMM_RESID(2, P_H, FFP, (const bf16*)(ws + WS_WDN + 0 * WDN_BYTES), 0.5f, 1)
    if (IN(3)) { PHASE_BEGIN(); pg8::Gemm g{P_XB, (const bf16*)(ws + WS_WIE), MT, NIE, 1024}; pg8::StaticOrder S; S.init(MT, NIE, C.G, (int)blockIdx.x);
        EpiInEven E{P_Q, P_K, P_V, P_XBF, P_GBF, C.out + O_KP, C.out + O_VP, C.out + O_KS, C.out + O_VS, P_SS, INF(I_AQG), INF(I_AKG)};
        pg8::gemm_phase<EpiInEven, pg8::StaticOrder, true, true>(ring, g, S, E); if (BOTH(3)) GRID_BAR(); }
    if (IN(4)) { PHASE_BEGIN();
        for (;;) { const int it = q_fetch(C, CW_Q0); if (it >= 32) break; if (!DIS(1)) rglru_item<false>(args, C, it >> 3, it & 7); }
        PHASE_BEGIN();
        for (;;) { const int a = q_fetch(C, CW_Q0 + 64); if (a >= 1024) break;
            const int qb = 15 - (a >> 6), b = (a & 63) >> 4, vh = a & 15, h = vh >> 2, j = (vh >> 1) & 1, half = vh & 1;
            if (!DIS(2)) attn_body::attn_unit<8>(b, (h * 2 + j) * 64, h * 128 + half * 64, j * 512 + h * 128 + half * 64, qb, (const attn_body::bf16*)P_Q, (const attn_body::bf16*)P_K, (const attn_body::bf16*)P_V, (attn_body::bf16*)P_O2, (char*)lds + RING_OFF); }
        PHASE_BEGIN();
        for (;;) { const int a = q_fetch(C, CW_Q0 + 128); if (a >= 256) break; if (!DIS(4)) sattn_wave(args, C, a >> 3, (a >> 1) & 3, (a & 1) * 8 + C.wave); }
        PHASE_BEGIN();
        for (;;) { const int a = q_fetch(C, CW_Q0 + 192); if (a >= 16) break; if (!DIS(1)) rglru_item<true>(args, C, a & 1, a >> 1); }
        if (BOTH(4)) GRID_BAR();
    }
    if (IN(5)) { PHASE_BEGIN(); if (!DIS(32)) p5_combine(args, C); if (BOTH(5)) GRID_BAR(); }
    GEMM_RESID(6, P_MIX, 1024, (const bf16*)(ws + WS_WOE), 1.0f, 1)
    FFN_UP(7, 1)
    GEMM_RESID(8, P_H, FFP, (const bf16*)(ws + WS_WDN + 1 * WDN_BYTES), 0.5f, 1)

    FFN_UP(9, 2)
    GEMM_RESID(10, P_H, FFP, (const bf16*)(ws + WS_WDN + 2 * WDN_BYTES), 0.5f, 1)
    if (IN(11)) { PHASE_BEGIN(); pg8::Gemm g{P_XB, (const bf16*)(ws + WS_WIO), MT, NIO, 1024}; pg8::StaticOrder S; S.init(MT, NIO, C.G, (int)blockIdx.x);
        EpiInOdd E{P_U, P_GG, P_SS}; pg8::gemm_phase<EpiInOdd, pg8::StaticOrder, true, true>(ring, g, S, E); if (BOTH(11)) GRID_BAR(); }
    if (IN(12)) { PHASE_BEGIN();
        for (;;) { const int it = q_fetch(C, CW_Q1); if (it >= 128) break; if (!DIS(8)) s5_item<false>(args, C, it >> 5, it & 31); }
        PHASE_BEGIN();
        for (;;) { const int a = q_fetch(C, CW_Q1 + 64); if (a >= 64) break; if (!DIS(8)) s5_item<true>(args, C, a & 1, a >> 1); }
        PHASE_BEGIN();
        for (;;) { const int a = q_fetch(C, CW_Q1 + 128); if (a >= 512) break; if (!DIS(16)) conf_item<false>(args, C, a >> 7, a & 127); }
        PHASE_BEGIN();
        for (;;) { const int a = q_fetch(C, CW_Q1 + 192); if (a >= 32) break; if (!DIS(16)) conf_item<true>(args, C, a, 0); }
        if (BOTH(12)) GRID_BAR();
    }
    if (IN(13)) { PHASE_BEGIN(); pg8::Gemm g{P_Z, (const bf16*)(ws + WS_WGLU), MT, 512, 512}; pg8::StaticOrder S; S.init(MT, 512, C.G, (int)blockIdx.x);
        EpiGLU E{P_Z, P_MIX, INF(I_CGLUB)}; pg8::gemm_phase<EpiGLU, pg8::StaticOrder, true, true>(ring, g, S, E); if (BOTH(13)) GRID_BAR(); }
    GEMM_RESID(14, P_MIX, 1024, (const bf16*)(ws + WS_WOO), 1.0f, 1)
    FFN_UP(15, 3)
    GEMM_RESID(16, P_H, FFP, (const bf16*)(ws + WS_WDN + 3 * WDN_BYTES), 0.5f, 0)
#undef IN
#undef BOTH
}


template <int K> static bool setup_one() {
    int per_cu = 0;
    if (hipFuncSetAttribute((const void*)mega_fwd<K, (N_LAUNCHES == 1 ? N_PHASES : K + 1)>, hipFuncAttributeMaxDynamicSharedMemorySize, LDS_BYTES) != hipSuccess) { fprintf(stderr, "kernel_launch: hipFuncSetAttribute failed\n"); return false; }
    if (hipOccupancyMaxActiveBlocksPerMultiprocessor(&per_cu, (const void*)mega_fwd<K, (N_LAUNCHES == 1 ? N_PHASES : K + 1)>, NTHR, LDS_BYTES) != hipSuccess || per_cu < 1) fprintf(stderr, "kernel_launch: occupancy query reports %d workgroups per CU\n", per_cu);
    return true;
}
template <int K> static void launch_one(int grid, const Args& a, hipStream_t stream) {
    hipLaunchKernelGGL((mega_fwd<K, (N_LAUNCHES == 1 ? N_PHASES : K + 1)>), dim3(grid), dim3(NTHR), LDS_BYTES, stream, a);
    const hipError_t le = hipPeekAtLastError();
    if (le != hipSuccess) fprintf(stderr, "kernel_launch: launch %d failed: %s\n", K, hipGetErrorName(le));
}
template <int K> struct Seq {
    static bool setup() { if (!setup_one<K>()) return false; if (N_LAUNCHES == 1) return true; return Seq<K + 1>::setup(); }
    static void launch(int grid, const Args& a, hipStream_t stream) { launch_one<K>(grid, a, stream); if (N_LAUNCHES != 1) Seq<K + 1>::launch(grid, a, stream); }
};
template <> struct Seq<(N_LAUNCHES == 1 ? 1 : N_PHASES)> { static bool setup() { return true; } static void launch(int, const Args&, hipStream_t) {} };
static bool setup_all() { return Seq<0>::setup(); }
static void launch_all(int grid, const Args& a, hipStream_t stream) { Seq<0>::launch(grid, a, stream); }
extern "C" void kernel_launch(void* const* d_in, const int* in_sizes, int n_in, void* d_out, int out_size, void* d_ws, size_t ws_size, hipStream_t stream) {
    static int grid = 0;
    if (grid == 0) {
        if (n_in != 44 || out_size != (int)O_END || ws_size < WS_END) { fprintf(stderr, "kernel_launch: unexpected shapes: n_in %d out %d ws %zu; nothing launched\n", n_in, out_size, ws_size); grid = -1; return; }
        int dev = 0, cus = 0, per_cu = 0;
        if (hipGetDevice(&dev) != hipSuccess || hipDeviceGetAttribute(&cus, hipDeviceAttributeMultiprocessorCount, dev) != hipSuccess) { fprintf(stderr, "kernel_launch: device query failed\n"); grid = -1; return; }
        if (!setup_all()) { grid = -1; return; }
        (void)hipGetLastError();
        grid = cus;
    }
    if (grid < 0) return;
    if (hipMemsetAsync((char*)d_ws + WS_CTL, 0, CTL_ZERO_BYTES, stream) != hipSuccess) { fprintf(stderr, "kernel_launch: memset failed\n"); return; }
    Args a{};
    for (int i = 0; i < 44; ++i) a.in[i] = d_in[i];
    a.out = (float*)d_out; a.ws = (unsigned char*)d_ws;
    launch_all(grid, a, stream);
}
```

```cpp
#ifndef MK_N_LAUNCHES
#define MK_N_LAUNCHES 1
#endif
#include <hip/hip_runtime.h>
#include <cstdio>
#include <cstdint>
namespace pg8 {
#define PG8_LAS __attribute__((address_space(3)))
typedef unsigned short bf16_t;
typedef short bf16x8 __attribute__((ext_vector_type(8)));
typedef float f32x4 __attribute__((ext_vector_type(4)));
typedef unsigned u32x4 __attribute__((ext_vector_type(4)));
constexpr int BM = 256, BK = 64, HALF = 128, HTB = HALF * BK * 2  , STAGE_BYTES = 8 * HTB, NXCD = 8, WGM = 8;

__host__ __device__ __forceinline__ int lds_byte(int r, int c) { const int st = (r >> 4) * 2 + (c >> 5), rr = r & 15, cc = c & 31, ob = rr * 64 + cc * 2; return st * 1024 + (ob ^ (((ob >> 9) & 1) << 5)); }
__host__ __device__ __forceinline__ void stage_rc(int b, int& R, int& C) { const int st = b / 1024, sb = b % 1024, swz = sb ^ (((sb >> 9) & 1) << 5); R = (st >> 1) * 16 + swz / 64; C = (st & 1) * 32 + (swz % 64) / 2; }
__host__ __device__ __forceinline__ int perm32(int rho) { const int n = rho >> 4, i = rho & 15; return 8 * (i >> 2) + 4 * n + (i & 3); }

struct Unit { int pm, pn; };
struct Gemm { const bf16_t* A; const bf16_t* Bt; int M, N, K; };

struct StaticOrder {
    int nM, nN, nwg, G, c;
    __host__ __device__ void init(int M, int N, int G_, int c_) { nM = M / BM; nN = N / BM; nwg = nM * nN; G = G_; c = c_; }
    __host__ __device__ bool next(int i, Unit& u) const {
        const long L = (long)i * G + c; if (L >= nwg) return false;
        int wgid = (int)L; { const int q = nwg / NXCD, r = nwg % NXCD, xcd = wgid % NXCD, off = wgid / NXCD; wgid = (xcd < r ? xcd * (q + 1) : r * (q + 1) + (xcd - r) * q) + off; }
        const int nig = WGM * nN, gid = wgid / nig, fm = gid * WGM, gsz = (nM - fm) < WGM ? (nM - fm) : WGM;
        u.pm = fm + ((wgid % nig) % gsz); u.pn = (wgid % nig) / gsz; return true;
    }
    __device__ __forceinline__ void a_ready(const Unit&) const {}
    __device__ __forceinline__ void done(const Unit&) const {}
};

__device__ __forceinline__ unsigned cvt_pk_bf16(float lo, float hi) { unsigned r; asm volatile("v_cvt_pk_bf16_f32 %0, %1, %2" : "=v"(r) : "v"(lo), "v"(hi)); return r; }
typedef float f32x2 __attribute__((ext_vector_type(2)));
template <class Epi, class Sched, bool ALIGN_EPI = false, bool SP2 = false>
__device__ __forceinline__ void gemm_phase(PG8_LAS unsigned char* lds, const Gemm g, const Sched& S, const Epi& E) {
    int tid_ = threadIdx.x; asm volatile("" : "+v"(tid_));
    const int tid = tid_, wid = __builtin_amdgcn_readfirstlane(tid >> 6), lane = tid & 63, wr = wid >> 2, wc = wid & 3, fr = lane & 15, fq = lane >> 4;
    const int K = g.K, nt = K / BK;
    unsigned voffA[2], voffB[2];
#pragma unroll
    for (int i = 0; i < 2; ++i) { int R, C; stage_rc(tid * 16 + i * 8192, R, C); const int Rb = Epi::PERM ? ((R & ~31) + perm32(R & 31)) : R;
        voffA[i] = (unsigned)(R * K + C) * 2u; voffB[i] = (unsigned)(Rb * K + C) * 2u; }
    const size_t kstep = (size_t)(BK * 2);
    const size_t hstep = (size_t)HALF * K * 2;
    const size_t tstep = 2 * hstep;
    const unsigned ldsw = (unsigned)wid * 1024u;
    const int aoff = lds_byte(wr * 64 + fr, fq * 8), boff = lds_byte(wc * 32 + fr, fq * 8);
#define PG8_SA(b, h) (((b) * 2 + (h)) * HTB)
#define PG8_SB(b, h) ((4 + (b) * 2 + (h)) * HTB)
#define PG8_STAGE(bufoff, gbase, voff) do { _Pragma("unroll") for (int _i = 0; _i < 2; ++_i) \
        __builtin_amdgcn_global_load_lds((const unsigned*)((const char*)(gbase) + (voff)[_i]), (PG8_LAS unsigned*)(lds + (bufoff) + ldsw + _i * 8192), 16, 0, 0); } while (0)
#define PG8_LDA(dst, b, h) do { _Pragma("unroll") for (int m = 0; m < 4; ++m) _Pragma("unroll") for (int k = 0; k < 2; ++k) dst[m][k] = *(const PG8_LAS bf16x8*)(lds + PG8_SA(b, h) + aoff + m * 2048 + k * 1024); } while (0)
#define PG8_LDB(dst, b, h) do { _Pragma("unroll") for (int n = 0; n < 2; ++n) _Pragma("unroll") for (int k = 0; k < 2; ++k) dst[n][k] = *(const PG8_LAS bf16x8*)(lds + PG8_SB(b, h) + boff + n * 2048 + k * 1024); } while (0)
#define PG8_MMA(ai, bj, At, Bt) do { __builtin_amdgcn_s_setprio(1); _Pragma("unroll") for (int m = 0; m < 4; ++m) _Pragma("unroll") for (int n = 0; n < 2; ++n) _Pragma("unroll") for (int k = 0; k < 2; ++k) \
        acc[ai][bj][m][n] = __builtin_amdgcn_mfma_f32_16x16x32_bf16(Bt[n][k], At[m][k], acc[ai][bj][m][n], 0, 0, 0); __builtin_amdgcn_s_setprio(0); } while (0)
#define PG8_WAIT_V(n) asm volatile("s_waitcnt vmcnt(" #n ")" ::: "memory")
#define PG8_WAIT_L(n) asm volatile("s_waitcnt lgkmcnt(" #n ")" ::: "memory")
#define PG8_BAR __builtin_amdgcn_s_barrier()
#define PG8_SCHED __builtin_amdgcn_sched_barrier(0)
    Unit cur, nxt; int ui = 0;
    if (!S.next(0, cur)) return;
    f32x4 acc[2][2][4][2];
#pragma unroll
    for (int a = 0; a < 2; ++a)
#pragma unroll
        for (int b = 0; b < 2; ++b)
#pragma unroll
            for (int m = 0; m < 4; ++m)
#pragma unroll
                for (int n = 0; n < 2; ++n) acc[a][b][m][n] = (f32x4){0.f, 0.f, 0.f, 0.f};
    if constexpr (Epi::INIT_ACC) E.init(acc, cur, wr, wc, fr, fq);
    bf16x8 At[4][2], B0[2][2], B1[2][2];
    const char* cA = (const char*)g.A + (size_t)cur.pm * tstep; const char* cB = (const char*)g.Bt + (size_t)cur.pn * tstep;
    S.a_ready(cur);
    if constexpr (SP2) {
        PG8_STAGE(PG8_SB(0, 0), cB, voffB); PG8_STAGE(PG8_SB(0, 1), cB + hstep, voffB); PG8_STAGE(PG8_SA(0, 0), cA, voffA); PG8_STAGE(PG8_SA(0, 1), cA + hstep, voffA);
        if (wr == 1) PG8_BAR;
        PG8_WAIT_V(2); PG8_BAR;
        PG8_STAGE(PG8_SB(1, 0), cB + kstep, voffB); PG8_STAGE(PG8_SA(1, 0), cA + kstep, voffA); PG8_STAGE(PG8_SB(1, 1), cB + hstep + kstep, voffB);
        PG8_WAIT_V(6); PG8_BAR;
    } else {
        PG8_STAGE(PG8_SB(0, 0), cB, voffB); PG8_STAGE(PG8_SA(0, 0), cA, voffA); PG8_STAGE(PG8_SB(0, 1), cB + hstep, voffB); PG8_STAGE(PG8_SA(0, 1), cA + hstep, voffA);
        if (wr == 1) PG8_BAR;
        PG8_WAIT_V(4); PG8_BAR;
        PG8_STAGE(PG8_SB(1, 0), cB + kstep, voffB); PG8_STAGE(PG8_SA(1, 0), cA + kstep, voffA); PG8_STAGE(PG8_SB(1, 1), cB + hstep + kstep, voffB);
        PG8_WAIT_V(6); PG8_BAR;
    }
    for (;;) {
        const bool has_next = S.next(ui + 1, nxt);
        const char* nA = has_next ? (const char*)g.A + (size_t)nxt.pm * tstep : cA; const char* nB = has_next ? (const char*)g.Bt + (size_t)nxt.pn * tstep : cB;
        for (int t = 0; t < nt; t += 2) {
            const bool last = (t == nt - 2);
            const char* a1 = cA + (size_t)(t + 1) * kstep;
            const char* a2 = last ? nA : cA + (size_t)(t + 2) * kstep; const char* b2 = last ? nB : cB + (size_t)(t + 2) * kstep;
            const char* a3 = a2 + kstep; const char* b3 = b2 + kstep;
            if (last && has_next) S.a_ready(nxt);
            if constexpr (SP2) {
            PG8_LDB(B0, 0, 0); PG8_LDB(B1, 0, 1); PG8_SCHED; PG8_LDA(At, 0, 0); PG8_STAGE(PG8_SA(1, 1), a1 + hstep, voffA);
            PG8_WAIT_V(8); PG8_WAIT_L(0); PG8_BAR; PG8_MMA(0, 0, At, B0); PG8_MMA(0, 1, At, B1); PG8_BAR; PG8_SCHED;
            PG8_LDA(At, 0, 1); PG8_STAGE(PG8_SB(0, 0), b2, voffB); PG8_STAGE(PG8_SB(0, 1), b2 + hstep, voffB); PG8_STAGE(PG8_SA(0, 0), a2, voffA);
            PG8_WAIT_V(8); PG8_WAIT_L(0); PG8_BAR; PG8_MMA(1, 0, At, B0); PG8_MMA(1, 1, At, B1); PG8_BAR; PG8_SCHED;
            PG8_LDB(B0, 1, 0); PG8_LDB(B1, 1, 1); PG8_SCHED; PG8_LDA(At, 1, 0); PG8_STAGE(PG8_SA(0, 1), a2 + hstep, voffA);
            PG8_WAIT_V(8); PG8_WAIT_L(0); PG8_BAR; PG8_MMA(0, 0, At, B0); PG8_MMA(0, 1, At, B1); PG8_BAR; PG8_SCHED;
            PG8_LDA(At, 1, 1); PG8_STAGE(PG8_SB(1, 0), b3, voffB); PG8_STAGE(PG8_SB(1, 1), b3 + hstep, voffB); PG8_STAGE(PG8_SA(1, 0), a3, voffA);
            PG8_WAIT_V(8); PG8_WAIT_L(0); PG8_BAR; PG8_MMA(1, 0, At, B0); PG8_MMA(1, 1, At, B1); PG8_BAR; PG8_SCHED;
            } else {
            PG8_LDB(B0, 0, 0); PG8_SCHED; PG8_LDA(At, 0, 0); PG8_STAGE(PG8_SA(1, 1), a1 + hstep, voffA);
            PG8_WAIT_L(8); PG8_BAR; PG8_WAIT_L(0); PG8_MMA(0, 0, At, B0); PG8_BAR; PG8_SCHED;
            PG8_LDB(B1, 0, 1); PG8_STAGE(PG8_SB(0, 0), b2, voffB);
            PG8_BAR; PG8_WAIT_L(0); PG8_MMA(0, 1, At, B1); PG8_BAR;
            PG8_LDA(At, 0, 1); PG8_STAGE(PG8_SA(0, 0), a2, voffA);
            PG8_BAR; PG8_WAIT_L(0); PG8_MMA(1, 0, At, B0); PG8_BAR; PG8_SCHED;
            PG8_STAGE(PG8_SB(0, 1), b2 + hstep, voffB);
            PG8_WAIT_V(6); PG8_BAR; PG8_MMA(1, 1, At, B1); PG8_BAR;
            PG8_LDB(B0, 1, 0); PG8_SCHED; PG8_LDA(At, 1, 0); PG8_STAGE(PG8_SA(0, 1), a2 + hstep, voffA);
            PG8_WAIT_L(8); PG8_BAR; PG8_WAIT_L(0); PG8_MMA(0, 0, At, B0); PG8_BAR; PG8_SCHED;
            PG8_LDB(B1, 1, 1); PG8_STAGE(PG8_SB(1, 0), b3, voffB);
            PG8_BAR; PG8_WAIT_L(0); PG8_MMA(0, 1, At, B1); PG8_BAR;
            PG8_LDA(At, 1, 1); PG8_STAGE(PG8_SA(1, 0), a3, voffA);
            PG8_BAR; PG8_WAIT_L(0); PG8_MMA(1, 0, At, B0); PG8_BAR; PG8_SCHED;
            PG8_STAGE(PG8_SB(1, 1), b3 + hstep, voffB);
            PG8_WAIT_V(6); PG8_BAR; PG8_MMA(1, 1, At, B1); PG8_BAR;
            }
        }
        if constexpr (ALIGN_EPI) { if (wr == 0) PG8_BAR; }
        if constexpr (!Epi::AFTER_DRAIN) { E(acc, cur, wr, wc, fr, fq, ui); S.done(cur); }
        if (!has_next) break;
#pragma unroll
        for (int a = 0; a < 2; ++a)
#pragma unroll
            for (int b = 0; b < 2; ++b)
#pragma unroll
                for (int m = 0; m < 4; ++m)
#pragma unroll
                    for (int n = 0; n < 2; ++n) acc[a][b][m][n] = (f32x4){0.f, 0.f, 0.f, 0.f};
        if constexpr (Epi::INIT_ACC) E.init(acc, nxt, wr, wc, fr, fq);
        cur = nxt; cA = nA; cB = nB; ++ui;
        if constexpr (ALIGN_EPI) { if (wr == 1) PG8_BAR; }
    }
    PG8_WAIT_V(0);
    if constexpr (!ALIGN_EPI) { if (wr == 0) PG8_BAR; }
    PG8_BAR;
    if constexpr (Epi::AFTER_DRAIN) { E.fused(acc, cur, wr, wc, fr, fq, lds, wid, lane); S.done(cur); }
#undef PG8_SA
#undef PG8_SB
#undef PG8_STAGE
#undef PG8_LDA
#undef PG8_LDB
#undef PG8_MMA
#undef PG8_WAIT_V
#undef PG8_WAIT_L
#undef PG8_BAR
#undef PG8_SCHED
}
}
#include <hip/hip_bf16.h>
#include <cmath>
#include <hip/hip_bf16.h>
#include <cmath>
namespace attn_body {
using bf16=__hip_bfloat16;
using bf16x8=__attribute__((ext_vector_type(8)))short;
using s16x4=__attribute__((ext_vector_type(4)))short;
using f32x16=__attribute__((ext_vector_type(16)))float;
using u32x4=__attribute__((ext_vector_type(4)))unsigned;
constexpr int BATCH=4,NHEAD=16,SEQ=4096,D=64,PQK=512,PV=512,PO=1024;
constexpr int NW=8,QBLK=32,QB=QBLK*NW,KVBLK=64,NQB=SEQ/QB;
constexpr int ATTN_UNIT_ROWS=QB;
__device__ __forceinline__ int crow(int r,int hi){return (r&3)+8*(r>>2)+4*hi;}
#define SBAR() __builtin_amdgcn_sched_barrier(0)
__device__ __forceinline__ void cmask(f32x16&p0,f32x16&p1,int jb,int qrel,int hi){
  const float NEG=-INFINITY; int kb=64*jb+4*hi;
  #pragma unroll
  for(int r=0;r<16;++r){int kv=kb+(r&3)+8*(r>>2); if(kv>qrel)p0[r]=NEG; if(kv+32>qrel)p1[r]=NEG;}
}

constexpr int NSLOT=3, SLOTB=8192;
constexpr int LDS_K=0, LDS_V=NSLOT*SLOTB, LDS_WS=2*NSLOT*SLOTB, LDS_OST=LDS_WS+NW*64*4, LDS_BYTES=LDS_OST+NW*4096;
constexpr float C2=0.125f*1.4426950408889634f;
__device__ __forceinline__ void glds16(const void*gsrc,unsigned lds_dst){unsigned keep;
  asm volatile("s_mov_b32 %0, m0\n\ts_mov_b32 m0, %2\n\ts_nop 0\n\tglobal_load_lds_dwordx4 %1, off\n\ts_mov_b32 m0, %0":"=&s"(keep):"v"(gsrc),"s"(lds_dst):"memory");}
__device__ __forceinline__ float max3f(float a,float b,float c){float r;asm("v_max3_f32 %0, %1, %2, %3":"=v"(r):"v"(a),"v"(b),"v"(c));return r;}
__device__ __forceinline__ float max2f(float a,float b){float r;asm("v_max_f32_e32 %0, %1, %2":"=v"(r):"v"(a),"v"(b));return r;}
__device__ __forceinline__ float fadd_s(float a,float b){float r;asm("v_add_f32_e32 %0, %1, %2":"=v"(r):"v"(a),"v"(b));return r;}
__device__ __forceinline__ float fsub_s(float a,float b){float r;asm("v_sub_f32_e32 %0, %1, %2":"=v"(r):"v"(a),"v"(b));return r;}
typedef float f32x2_t __attribute__((ext_vector_type(2))); typedef __bf16 bf16x2_t __attribute__((ext_vector_type(2)));
__device__ __forceinline__ unsigned cvtpk_s(float lo,float hi){f32x2_t v={lo,hi};bf16x2_t b=__builtin_convertvector(v,bf16x2_t);return __builtin_bit_cast(unsigned,b);}
#define WAIT_BAR(N) asm volatile("s_waitcnt vmcnt(" #N ") lgkmcnt(0)\n\ts_barrier":::"memory")

__device__ __forceinline__ void qkt(f32x16&p0,f32x16&p1,const char*Kslot,const bf16x8*qr,const f32x16&negm,int r32,int hi){
  const char*kb=Kslot+hi*1024+r32*16;
  #pragma unroll
  for(int d0=0;d0<4;++d0){
    const bf16x8 b0=*reinterpret_cast<const bf16x8*>(kb+d0*2048);
    const bf16x8 b1=*reinterpret_cast<const bf16x8*>(kb+d0*2048+512);
    if(d0==0){p0=__builtin_amdgcn_mfma_f32_32x32x16_bf16(b0,qr[0],negm,0,0,0);p1=__builtin_amdgcn_mfma_f32_32x32x16_bf16(b1,qr[0],negm,0,0,0);}
    else{p0=__builtin_amdgcn_mfma_f32_32x32x16_bf16(b0,qr[d0],p0,0,0,0);p1=__builtin_amdgcn_mfma_f32_32x32x16_bf16(b1,qr[d0],p1,0,0,0);}}
}
typedef __attribute__((address_space(3))) const char* lds_cptr;
typedef short v4i16_t __attribute__((ext_vector_type(4)));
__device__ __forceinline__ void kload8(bf16x8*kf,lds_cptr kp){
  kf[0]=*(const __attribute__((address_space(3))) bf16x8*)(kp);      kf[1]=*(const __attribute__((address_space(3))) bf16x8*)(kp+512);
  kf[2]=*(const __attribute__((address_space(3))) bf16x8*)(kp+2048); kf[3]=*(const __attribute__((address_space(3))) bf16x8*)(kp+2560);
  kf[4]=*(const __attribute__((address_space(3))) bf16x8*)(kp+4096); kf[5]=*(const __attribute__((address_space(3))) bf16x8*)(kp+4608);
  kf[6]=*(const __attribute__((address_space(3))) bf16x8*)(kp+6144); kf[7]=*(const __attribute__((address_space(3))) bf16x8*)(kp+6656);
}
__device__ __forceinline__ void kload2(bf16x8*kf,lds_cptr kp,int j){ kf[2*j]=*(const __attribute__((address_space(3))) bf16x8*)(kp+j*2048); kf[2*j+1]=*(const __attribute__((address_space(3))) bf16x8*)(kp+j*2048+512); }
__device__ __forceinline__ s16x4 vtr(lds_cptr p){ return __builtin_bit_cast(s16x4,__builtin_amdgcn_ds_read_tr16_b64_v4i16((__attribute__((address_space(3))) v4i16_t*)p)); }
__device__ __forceinline__ float rowmax(const f32x16&p0,const f32x16&p1){
  float a=max3f(p0[0],p0[1],p1[0]),b=max3f(p0[2],p0[3],p1[1]);a=max3f(a,p1[2],p1[3]);
  #pragma unroll
  for(int r=4;r<16;r+=4){a=max3f(a,p0[r],p0[r+1]);b=max3f(b,p0[r+2],p0[r+3]);a=max3f(a,p1[r],p1[r+1]);b=max3f(b,p1[r+2],p1[r+3]);}
  const float m=max2f(a,b);
  auto rr=__builtin_amdgcn_permlane32_swap(__float_as_uint(m),__float_as_uint(m),false,false);
  return max2f(__uint_as_float(rr[0]),__uint_as_float(rr[1]));
}
__device__ __forceinline__ void pv(f32x16*o,int vb,bf16x8 pa0,bf16x8 pa1,bf16x8 pa2,bf16x8 pa3){
  #pragma unroll
  for(int d0=0;d0<2;++d0){s16x4 lo[4],hi[4];
    #pragma unroll
    for(int ks=0;ks<4;++ks){
      asm volatile("ds_read_b64_tr_b16 %0,%1 offset:%c2":"=&v"(lo[ks]):"v"(vb),"i"(d0*4096+ks*1024):"memory");
      asm volatile("ds_read_b64_tr_b16 %0,%1 offset:%c2":"=&v"(hi[ks]):"v"(vb),"i"(d0*4096+ks*1024+512):"memory");}
    asm volatile("s_waitcnt lgkmcnt(0)":::"memory");SBAR();
    #define PK(k) (bf16x8){lo[k][0],lo[k][1],lo[k][2],lo[k][3],hi[k][0],hi[k][1],hi[k][2],hi[k][3]}
    o[d0]=__builtin_amdgcn_mfma_f32_32x32x16_bf16(pa0,PK(0),o[d0],0,0,0);
    o[d0]=__builtin_amdgcn_mfma_f32_32x32x16_bf16(pa1,PK(1),o[d0],0,0,0);
    o[d0]=__builtin_amdgcn_mfma_f32_32x32x16_bf16(pa2,PK(2),o[d0],0,0,0);
    o[d0]=__builtin_amdgcn_mfma_f32_32x32x16_bf16(pa3,PK(3),o[d0],0,0,0);
    #undef PK
  }
}

#ifndef ATTN_STORE16
#define ATTN_STORE16(p,v) (*(u32x4*)(p)=(v))
#endif
template<int THRL> __device__ __forceinline__ void attn_unit(int b,int qk_off,int v_off,int o_off,int qb,const bf16*Q,const bf16*__restrict__ K,const bf16*__restrict__ V,bf16*O,char*shm){
  int tid_=threadIdx.x; asm volatile("":"+v"(tid_)); const int tid=tid_,lane=tid&63,r32=lane&31,hi=lane>>5; const int wid=__builtin_amdgcn_readfirstlane(tid>>6);
  const long rowbase=(long)b*SEQ; const int q0=qb*QB;
  const bf16*Qw=Q+(rowbase+q0+wid*QBLK)*PQK+qk_off;
  const bf16*Kh=K+rowbase*PQK+qk_off,*Vh=V+rowbase*PV+v_off;
  const unsigned lds0=(unsigned)(uintptr_t)shm;
  float*wsf=(float*)(shm+LDS_WS)+wid*64;
  const bf16*ksrc=Kh+(long)lane*PQK+wid*8;
  const bf16*vsrc=Vh+(long)(16*(wid&3)+(lane>>2))*PV+(wid>>2)*32+(lane&3)*8;
  const unsigned kdst=lds0+LDS_K+wid*1024, vdst=lds0+LDS_V+wid*1024;
  #define DMA_K(t,slot) glds16(ksrc+(long)(t)*KVBLK*PQK,(unsigned)__builtin_amdgcn_readfirstlane(kdst+(slot)))
  #define DMA_V(t,slot) glds16(vsrc+(long)(t)*KVBLK*PV,(unsigned)__builtin_amdgcn_readfirstlane(vdst+(slot)))
  const int vb0=(int)(lds0+LDS_V)+((lane>>4)&1)*32+(lane&3)*8+(4*hi+((lane&15)>>2))*64;
  const char*Kbase=shm+LDS_K; bf16x8 kf[8];
  const lds_cptr shm3=(lds_cptr)shm; const lds_cptr kp0=shm3+LDS_K+hi*1024+r32*16; const lds_cptr vp0=shm3+LDS_V+((lane>>4)&1)*32+(lane&3)*8+(4*hi+((lane&15)>>2))*64;
  const int NT=(q0+QB)/KVBLK;
  DMA_K(0,0);DMA_V(0,0);DMA_K(1,SLOTB);
  bf16x8 qr[4];
  #pragma unroll
  for(int d0=0;d0<4;++d0)qr[d0]=*reinterpret_cast<const bf16x8*>(&Qw[(long)r32*PQK+d0*16+hi*8]);
  float mhat=0.f,l_reg=0.f;f32x16 o[2];o[0]=f32x16{};o[1]=f32x16{};f32x16 negm=f32x16{};asm volatile("":"+v"(negm));
  const int qrel=wid*QBLK+r32;
  #define CMASK(P0,P1,t) do{int jb_=(t)-(NT-4); if(jb_>=0)cmask(P0,P1,jb_,qrel,hi);}while(0)
  bool resc=false;
  #define START(P0,P1) do{ const float rm=rowmax(P0,P1); resc=false; \
    { const float dl=rm; mhat=fadd_s(mhat,dl); \
      _Pragma("unroll") for(int r=0;r<16;++r){P0[r]=fsub_s(P0[r],dl);P1[r]=fsub_s(P1[r],dl);} \
      _Pragma("unroll") for(int r=0;r<16;++r)negm[r]=-mhat; asm volatile("":"+v"(negm)); } \
    _Pragma("unroll") for(int r=0;r<16;++r)P0[r]=__builtin_amdgcn_exp2f(P0[r]); }while(0)
  #define RESC() do{ if(resc){ asm volatile("s_waitcnt lgkmcnt(0)":::"memory"); \
      _Pragma("unroll") for(int d_=0;d_<2;++d_) _Pragma("unroll") for(int r=0;r<16;++r)o[d_][r]*=wsf[crow(r,hi)]; } }while(0)
  f32x16 pA0,pA1,pB0,pB1;
  int sl_prev=0,sl_cur=0,sl_next=SLOTB;
  #define ROT() do{sl_prev=sl_cur;sl_cur=sl_next;sl_next=(sl_next==(NSLOT-1)*SLOTB)?0:sl_next+SLOTB;}while(0)
  DMA_K(2,2*SLOTB);
  WAIT_BAR(3);
  qkt(pA0,pA1,Kbase,qr,negm,r32,hi);asm volatile("s_nop 15\n\ts_nop 7":"+v"(pA0),"+v"(pA1));CMASK(pA0,pA1,0);
  START(pA0,pA1);
  _Pragma("unroll") for(int r=0;r<16;++r)pA1[r]=__builtin_amdgcn_exp2f(pA1[r]);
  WAIT_BAR(0);
  DMA_K(3,0);DMA_V(1,SLOTB);
  ROT();
  kload8(kf,kp0+sl_cur);
  WAIT_BAR(2);
  s16x4 vlo[8],vhi[8]; u32x4 pw0,pw1,pw2,pw3;
  #define PKW(P,B) cvtpk_s(P[B],P[B+1])
  #define PAF(k) __builtin_bit_cast(bf16x8,pw##k)
  #define VFR(i) (bf16x8){vlo[i][0],vlo[i][1],vlo[i][2],vlo[i][3],vhi[i][0],vhi[i][1],vhi[i][2],vhi[i][3]}
  #define PIN(x) asm volatile("":"+v"(x))
  #define MX3(a,b,c) __builtin_fmaxf(__builtin_fmaxf((a),(b)),(c))
  #define GAPA(MF,A0,A1,A2,A3,W0,W1,PW) do{ MF; sacc+=A0; sacc+=A1; sacc+=A2; sacc+=A3; PIN(sacc); W0; W1; PIN(PW); SBAR(); }while(0)
  #define EX(v) __builtin_amdgcn_exp2f(v)
  #define GAPB(MF,X,B) do{ MF; X[B]=EX(X[B]); X[B+1]=EX(X[B+1]); X[B+2]=EX(X[B+2]); X[B+3]=EX(X[B+3]); PIN(X); SBAR(); }while(0)
  #define VRD(i) do{ vlo[i]=vtr(vp_+(((i)>>2)*4096+((i)&3)*1024)); vhi[i]=vtr(vp_+(((i)>>2)*4096+((i)&3)*1024+512)); }while(0)
  #define KRD(G,j) do{ if(G){ kload2(kf,kp0+sl_next,j); SBAR(); } }while(0)
  #define STEP(C0,C1,P0,P1,t,GK,GV,GL) do{ SBAR(); \
    const lds_cptr vp_=vp0+sl_prev; \
    VRD(0); SBAR(); float sacc=(P0[0]+P0[1]); \
    GAPA(C0=__builtin_amdgcn_mfma_f32_32x32x16_bf16(kf[0],qr[0],negm,0,0,0), P0[2],P0[3],P0[4],P0[5],     pw0[0]=PKW(P0,0), pw0[1]=PKW(P0,2), pw0); \
    VRD(4); SBAR(); GAPA(C1=__builtin_amdgcn_mfma_f32_32x32x16_bf16(kf[1],qr[0],negm,0,0,0), P0[6],P0[7],P0[8],P0[9],     pw0[2]=PKW(P0,4), pw0[3]=PKW(P0,6), pw0); \
    VRD(1); SBAR(); GAPA(C0=__builtin_amdgcn_mfma_f32_32x32x16_bf16(kf[2],qr[1],C0,0,0,0),   P0[10],P0[11],P0[12],P0[13], pw1[0]=PKW(P0,8), pw1[1]=PKW(P0,10), pw1); \
    VRD(5); SBAR(); GAPA(C1=__builtin_amdgcn_mfma_f32_32x32x16_bf16(kf[3],qr[1],C1,0,0,0),   P0[14],P0[15],P1[0],P1[1],   pw1[2]=PKW(P0,12),pw1[3]=PKW(P0,14), pw1); \
    VRD(2); SBAR(); GAPA(C0=__builtin_amdgcn_mfma_f32_32x32x16_bf16(kf[4],qr[2],C0,0,0,0),   P1[2],P1[3],P1[4],P1[5],     pw2[0]=PKW(P1,0), pw2[1]=PKW(P1,2), pw2); \
    VRD(6); SBAR(); GAPA(C1=__builtin_amdgcn_mfma_f32_32x32x16_bf16(kf[5],qr[2],C1,0,0,0),   P1[6],P1[7],P1[8],P1[9],     pw2[2]=PKW(P1,4), pw2[3]=PKW(P1,6), pw2); \
    VRD(3); SBAR(); GAPA(C0=__builtin_amdgcn_mfma_f32_32x32x16_bf16(kf[6],qr[3],C0,0,0,0),   P1[10],P1[11],P1[12],P1[13], pw3[0]=PKW(P1,8), pw3[1]=PKW(P1,10), pw3); \
    VRD(7); SBAR(); GAPA(C1=__builtin_amdgcn_mfma_f32_32x32x16_bf16(kf[7],qr[3],C1,0,0,0),   P1[14],P1[15],0.f,0.f,       pw3[2]=PKW(P1,12),pw3[3]=PKW(P1,14), pw3); \
    l_reg+=sacc; \
    if(GK){DMA_K((t)+3,sl_cur);} if(GV){DMA_V((t)+1,sl_next);} \
    CMASK(C0,C1,t); \
    { float a=MX3(C0[0],C0[1],C1[0]),b=MX3(C0[2],C0[3],C1[1]); a=MX3(a,C1[2],C1[3]); \
      _Pragma("unroll") for(int r=4;r<16;r+=4){a=MX3(a,C0[r],C0[r+1]);b=MX3(b,C0[r+2],C0[r+3]);a=MX3(a,C1[r],C1[r+1]);b=MX3(b,C1[r+2],C1[r+3]);} \
      float rm=__builtin_fmaxf(a,b); { auto rr=__builtin_amdgcn_permlane32_swap(__float_as_uint(rm),__float_as_uint(rm),false,false); rm=__builtin_fmaxf(__uint_as_float(rr[0]),__uint_as_float(rr[1])); } \
      resc=false; \
      if(__builtin_expect(__any(rm>(float)THRL),0)){ const float dl=__builtin_fmaxf(rm,0.f); mhat+=dl; \
        _Pragma("unroll") for(int r=0;r<16;++r){C0[r]-=dl;C1[r]-=dl;} \
        _Pragma("unroll") for(int r=0;r<16;++r)negm[r]=-mhat; asm volatile("":"+v"(negm)); \
        const float f=__builtin_amdgcn_exp2f(-dl); l_reg*=f; if(hi==0)wsf[r32]=f; resc=true; } } \
    SBAR(); \
    GAPB(o[0]=__builtin_amdgcn_mfma_f32_32x32x16_bf16(PAF(0),VFR(0),o[0],0,0,0), C0,0); \
    GAPB(o[1]=__builtin_amdgcn_mfma_f32_32x32x16_bf16(PAF(0),VFR(4),o[1],0,0,0), C0,4); \
    KRD(GL,0); GAPB(o[0]=__builtin_amdgcn_mfma_f32_32x32x16_bf16(PAF(1),VFR(1),o[0],0,0,0), C0,8); \
    KRD(GL,1); GAPB(o[1]=__builtin_amdgcn_mfma_f32_32x32x16_bf16(PAF(1),VFR(5),o[1],0,0,0), C0,12); \
    KRD(GL,2); GAPB(o[0]=__builtin_amdgcn_mfma_f32_32x32x16_bf16(PAF(2),VFR(2),o[0],0,0,0), C1,0); \
    KRD(GL,3); GAPB(o[1]=__builtin_amdgcn_mfma_f32_32x32x16_bf16(PAF(2),VFR(6),o[1],0,0,0), C1,4); \
    GAPB(o[0]=__builtin_amdgcn_mfma_f32_32x32x16_bf16(PAF(3),VFR(3),o[0],0,0,0), C1,8); \
    GAPB(o[1]=__builtin_amdgcn_mfma_f32_32x32x16_bf16(PAF(3),VFR(7),o[1],0,0,0), C1,12); \
    }while(0)
  int t=1;
  #undef CMASK
  #define CMASK(P0,P1,t) do{}while(0)
  for(;t+5<NT;t+=2){
    STEP(pB0,pB1,pA0,pA1,t,true,true,true);     WAIT_BAR(2); RESC(); ROT();
    STEP(pA0,pA1,pB0,pB1,t+1,true,true,true);   WAIT_BAR(2); RESC(); ROT();
  }
  #undef CMASK
  #define CMASK(P0,P1,t) do{int jb_=(t)-(NT-4); if(jb_>=0)cmask(P0,P1,jb_,qrel,hi);}while(0)
  #define ENDW(tt) do{ if((tt)+3<NT){WAIT_BAR(2);} else if((tt)+2<NT){WAIT_BAR(1);} else {WAIT_BAR(0);} }while(0)
  for(;t+1<NT;t+=2){
    STEP(pB0,pB1,pA0,pA1,t,(t+3<NT),(t+1<NT),(t+1<NT));       ENDW(t);   RESC(); ROT();
    STEP(pA0,pA1,pB0,pB1,t+1,(t+4<NT),(t+2<NT),(t+2<NT));     ENDW(t+1); RESC(); ROT();
  }
  STEP(pB0,pB1,pA0,pA1,NT-1,false,false,false); RESC();
  { float sacc=pB0[0]+pB0[1]; _Pragma("unroll") for(int r=2;r<16;++r)sacc+=pB0[r]; _Pragma("unroll") for(int r=0;r<16;++r)sacc+=pB1[r]; l_reg+=sacc;
    pw0=(u32x4){PKW(pB0,0),PKW(pB0,2),PKW(pB0,4),PKW(pB0,6)};pw1=(u32x4){PKW(pB0,8),PKW(pB0,10),PKW(pB0,12),PKW(pB0,14)};pw2=(u32x4){PKW(pB1,0),PKW(pB1,2),PKW(pB1,4),PKW(pB1,6)};pw3=(u32x4){PKW(pB1,8),PKW(pB1,10),PKW(pB1,12),PKW(pB1,14)};
    SBAR(); pv(o,vb0+sl_cur,PAF(0),PAF(1),PAF(2),PAF(3)); }
  #undef PKW
  #undef PAF
  #undef VFR
  #undef PIN
  #undef MX3
  #undef GAPA
  #undef GAPB
  #undef EX
  #undef VRD
  #undef KRD
  #undef STEP
  #undef ENDW
  {auto rr=__builtin_amdgcn_permlane32_swap(__float_as_uint(l_reg),__float_as_uint(l_reg),false,false);l_reg=__uint_as_float(rr[0])+__uint_as_float(rr[1]);}
  if(hi==0)wsf[32+r32]=l_reg;asm volatile("s_waitcnt lgkmcnt(0)":::"memory");
  float rli[16];
  #pragma unroll
  for(int r=0;r<16;++r)rli[r]=__builtin_amdgcn_rcpf(wsf[32+crow(r,hi)]);
  bf16*Ow=O+(rowbase+q0+wid*QBLK)*PO+o_off;
  { bf16*stg=(bf16*)(shm+LDS_OST)+wid*2048;
    #pragma unroll
    for(int r=0;r<16;++r){const int orow=crow(r,hi);
      #pragma unroll
      for(int d0=0;d0<2;++d0)stg[orow*64+d0*32+r32]=__float2bfloat16(o[d0][r]*rli[r]);}
    asm volatile("s_waitcnt lgkmcnt(0)":::"memory");
    #pragma unroll
    for(int i=0;i<4;++i){const int row=i*8+(lane>>3),ch=lane&7; const u32x4 v=*(const u32x4*)(stg+row*64+ch*8); ATTN_STORE16(Ow+(long)row*PO+ch*8,v);} }
  asm volatile("s_waitcnt lgkmcnt(0)\n\ts_barrier":::"memory");
  #undef DMA_K
  #undef DMA_V
  #undef CMASK
  #undef START
  #undef RESC
  #undef ROT
}
constexpr int ATTN_LDS_BYTES=LDS_BYTES;
#undef SBAR
#undef WAIT_BAR
}
#define GAS __attribute__((address_space(1)))
#define LAS __attribute__((address_space(3)))
typedef unsigned short bf16;
typedef unsigned v4u __attribute__((ext_vector_type(4)));
typedef float f32x4 __attribute__((ext_vector_type(4)));
typedef short bf16x8 __attribute__((ext_vector_type(8)));
typedef short bf16x4 __attribute__((ext_vector_type(4)));
typedef GAS unsigned gu32;
typedef GAS unsigned long long gu64;
#define RLX_AGENT __ATOMIC_RELAXED, __HIP_MEMORY_SCOPE_AGENT
#define LDS_WAIT() asm volatile("s_waitcnt lgkmcnt(0)" ::: "memory")
#define VM_WAIT() asm volatile("s_waitcnt vmcnt(0)" ::: "memory")
__device__ __forceinline__ unsigned long long rt() { return __builtin_amdgcn_s_memrealtime(); }
__device__ __forceinline__ unsigned f2bf(float f) { unsigned u = __builtin_bit_cast(unsigned, f); return (u + 0x7fffu + ((u >> 16) & 1u)) >> 16; }
typedef float pk_f32x2 __attribute__((ext_vector_type(2))); typedef __bf16 pk_bf16x2 __attribute__((ext_vector_type(2)));
__device__ __forceinline__ unsigned pk2(float lo, float hi) { const pk_f32x2 v = {lo, hi}; return __builtin_bit_cast(unsigned, __builtin_convertvector(v, pk_bf16x2)); }

#define XB_TMO      128
#define XB_XCNT(j)  (256  + 64 * (j))
#define XB_XSUB(j)  (1280 + 64 * (j))
#define XB_XGEN(j)  (2304 + 64 * (j))
#define XB_TOP      3328
#define XB_TOPGEN   3392
#define XCD_BAR_WORDS 3456
#define XB_SPIN_CAP (1u << 18)

__device__ __forceinline__ unsigned xb_ld(unsigned* p)              { return __hip_atomic_load(p, __ATOMIC_RELAXED, __HIP_MEMORY_SCOPE_AGENT); }
__device__ __forceinline__ unsigned xb_add(unsigned* p, unsigned v) { return __hip_atomic_fetch_add(p, v, __ATOMIC_RELAXED, __HIP_MEMORY_SCOPE_AGENT); }
__device__ __forceinline__ unsigned xb_xcc_id() { return (unsigned)__builtin_amdgcn_s_getreg((3 << 11) | 20) & 0xFu; }
#define XB_SPIN(cond, bar) do { unsigned _sp = 0; while (cond) { __builtin_amdgcn_s_sleep(1); \
    if ((++_sp & 255u) == 0u) { if (xb_ld(&(bar)[XB_TMO])) break; if (_sp > XB_SPIN_CAP) { atomicAdd(&(bar)[XB_TMO], 1u); break; } } } } while (0)

struct XcdBarrier {
    unsigned* bar; unsigned x;
    volatile LAS unsigned* st;
};

__device__ __forceinline__ XcdBarrier xcd_barrier_post(unsigned* bar, volatile LAS unsigned* st) {
    XcdBarrier b; b.bar = bar; b.x = xb_xcc_id(); b.st = st;
    if (threadIdx.x == 0) (void)xb_add(&bar[XB_XCNT(b.x)], 1u);
    return b;
}
__device__ __forceinline__ void xcd_barrier_complete(unsigned* bar, unsigned x, unsigned& nloc, unsigned& nx) {
    const unsigned G = gridDim.x * gridDim.y * gridDim.z;
    unsigned sum, cnt, mine, sp = 0u;
    for (;;) {
        sum = 0u; cnt = 0u; mine = 0u;
#pragma unroll
        for (unsigned j = 0; j < 16; ++j) { const unsigned c = xb_ld(&bar[XB_XCNT(j)]); sum += c; cnt += (c > 0u) ? 1u : 0u; mine = (j == x) ? c : mine; }
        if (sum == G) break;
        __builtin_amdgcn_s_sleep(1);
        if ((++sp & 255u) == 0u) { if (xb_ld(&bar[XB_TMO])) break; if (sp > XB_SPIN_CAP) { atomicAdd(&bar[XB_TMO], 1u); break; } }
    }
    nloc = mine > 0u ? mine : 1u; nx = cnt > 0u ? cnt : 1u;
}

__device__ __forceinline__ void xcd_barrier(const XcdBarrier& b) {
    asm volatile("s_waitcnt vmcnt(0)" ::: "memory");
    __syncthreads();
    if (threadIdx.x == 0) {
        unsigned* bar = b.bar;
        __builtin_amdgcn_s_waitcnt(0);
        unsigned nloc = b.st[0], nx = b.st[1];
        if (nloc == 0u) { xcd_barrier_complete(bar, b.x, nloc, nx); b.st[0] = nloc; b.st[1] = nx; }
        const unsigned old = xb_add(&bar[XB_XSUB(b.x)], 1u);
        const unsigned gen = old / nloc;
        if (old + 1u == (gen + 1u) * nloc) {
            __builtin_amdgcn_fence(__ATOMIC_RELEASE, "agent");
            asm volatile("s_waitcnt vmcnt(0)" ::: "memory");
            const unsigned og = xb_add(&bar[XB_TOP], 1u);
            const unsigned tg = og / nx;
            if (og + 1u == (tg + 1u) * nx) xb_add(&bar[XB_TOPGEN], 1u);
            else XB_SPIN(xb_ld(&bar[XB_TOPGEN]) == tg, bar);
            __builtin_amdgcn_fence(__ATOMIC_ACQUIRE, "agent");
            xb_add(&bar[XB_XGEN(b.x)], 1u);
            asm volatile("s_waitcnt vmcnt(0)" ::: "memory");
        } else {
            XB_SPIN(xb_ld(&bar[XB_XGEN(b.x)]) == gen, bar);
            __builtin_amdgcn_fence(__ATOMIC_ACQUIRE, "agent");
            asm volatile("s_waitcnt vmcnt(0)" ::: "memory");
        }
    }
    __syncthreads();
}

constexpr int NWAVES = 8, NTHR = 512;
constexpr int DMODEL = 1024, SEQ = 4096, NB = 4, NS = 32, ST = 8, NPG = 64, PAGE = 128;
constexpr int MP = NB * SEQ, MS = NS * ST, MT = MP + MS;
constexpr int FF = 2752, FFP = 2816, NGU = 2 * FFP, NIE = 2560, NIO = 1536;
constexpr float EPS = 1e-6f;
constexpr float C2 = 0.125f * 1.4426950408889634f;
constexpr float LAM_INIT0 = 0.2f;
constexpr int NSPLIT = 16, PSTR = 132;

constexpr size_t O_Y = 0;
constexpr size_t O_KP = O_Y + (size_t)MT * 1024;
constexpr size_t O_VP = O_KP + (size_t)MP * 512;
constexpr size_t O_CBP = O_VP + (size_t)MP * 512;
constexpr size_t O_HBP = O_CBP + NB * 3 * 512;
constexpr size_t O_CREP = O_HBP + NB * 512;
constexpr size_t O_CIMP = O_CREP + NB * 32 * 64;
constexpr size_t O_CDP = O_CIMP + NB * 32 * 64;
constexpr size_t O_KS = O_CDP + NB * 30 * 512;
constexpr size_t O_VS = O_KS + (size_t)MS * 512;
constexpr size_t O_CBS = O_VS + (size_t)MS * 512;
constexpr size_t O_HBS = O_CBS + NS * 3 * 512;
constexpr size_t O_CRES = O_HBS + NS * 512;
constexpr size_t O_CIMS = O_CRES + NS * 32 * 64;
constexpr size_t O_CDS = O_CIMS + NS * 32 * 64;
constexpr size_t O_END = O_CDS + NS * 30 * 512;
static_assert(O_END == 34852864, "output size");

enum { I_XP = 0, I_XS, I_CK, I_CV, I_SCB, I_SHB, I_SCRE, I_SCIM, I_SCD, I_PT, I_F1G, I_F1GU, I_F1DN, I_MIXG, I_F2G, I_F2GU, I_F2DN, I_EWIN, I_EWOUT, I_AQG, I_AKG, I_ALAM, I_AHG,
       I_BCW, I_BCB, I_BGW, I_BGB, I_BLAM, I_OWIN, I_OWOUT, I_CARE, I_CAIM, I_CLDT, I_CBRE, I_CBIM, I_CCRE, I_CCIM, I_CD, I_CGLUW, I_CGLUB, I_DCW, I_DCB, I_DLNG, I_DLNB, N_IN };
static_assert(N_IN == 44, "inputs");

constexpr size_t MiB = 1u << 20;
constexpr size_t WS_CTL = 0, CTL_ZERO_BYTES = 1 * MiB;
constexpr size_t WS_WGU = 2 * MiB, WGU_BYTES = (size_t)NGU * 1024 * 2;
constexpr size_t WS_WDN = 46 * MiB, WDN_BYTES = (size_t)1024 * FFP * 2;
constexpr size_t WS_WIE = 68 * MiB, WS_WOE = 73 * MiB, WS_WIO = 75 * MiB, WS_WOO = 78 * MiB, WS_WGLU = 80 * MiB;
constexpr size_t WS_XB = 82 * MiB;
constexpr size_t WS_SS = 115 * MiB;
constexpr size_t WS_H = 118 * MiB;
constexpr size_t WS_Q = 208 * MiB, WS_K = 225 * MiB, WS_V = 242 * MiB;
constexpr size_t WS_XBF = 259 * MiB, WS_GBF = 292 * MiB;
constexpr size_t WS_O2 = 325 * MiB;
constexpr size_t WS_MIX = 357 * MiB;
constexpr size_t WS_U = 390 * MiB, WS_G = 423 * MiB;
constexpr size_t WS_Z = 456 * MiB;
constexpr size_t WS_PART = 473 * MiB;
constexpr size_t WS_HL = 492 * MiB, WS_CPD = 525 * MiB;
constexpr size_t WS_TOT = 558 * MiB;
constexpr size_t WS_END = 560 * MiB;
static_assert(WS_WGU + 4 * WGU_BYTES <= WS_WDN && WS_WDN + 4 * WDN_BYTES <= WS_WIE && WS_XB + (size_t)MT * 1024 * 2 <= WS_SS && WS_SS + (size_t)MT * 64 <= WS_H && WS_H + (size_t)MT * FFP * 2 <= WS_Q, "ws map 1");
static_assert(WS_Q + (size_t)MT * 1024 <= WS_K && WS_V + (size_t)MT * 1024 <= WS_XBF && WS_XBF + (size_t)MT * 2048 <= WS_GBF && WS_GBF + (size_t)MT * 2048 <= WS_O2 && WS_O2 + (size_t)MP * 2048 <= WS_MIX, "ws map 2");
static_assert(WS_MIX + (size_t)MT * 2048 <= WS_U && WS_U + (size_t)MT * 2048 <= WS_G && WS_G + (size_t)MT * 2048 <= WS_Z && WS_Z + (size_t)MT * 1024 <= WS_PART && WS_PART + (size_t)NS * 4 * NSPLIT * 16 * PSTR * 4 <= WS_END, "ws map 3");
constexpr int CW_TMO = 0, CW_CODE = 1;
constexpr int CW_BAR = 4096;
constexpr int CW_Q0 = 8192, CW_Q1 = 8192 + 256;

constexpr int RING_OFF = 0, RING_BYTES = 131072;
constexpr int LDSCTL_OFF = RING_BYTES, MISC_OFF = LDSCTL_OFF + 320;
constexpr int RSTAB_OFF = LDSCTL_OFF + 1024, RSTAB_SLOTS = 8;
constexpr int LDS_BYTES = 147456;
static_assert(RSTAB_OFF + RSTAB_SLOTS * 1024 <= LDS_BYTES, "LDS map");

typedef float f32x2 __attribute__((ext_vector_type(2)));
typedef unsigned u32x2 __attribute__((ext_vector_type(2)));
__device__ __forceinline__ float wave_sum(float v) {
#pragma unroll
    for (int o = 1; o < 64; o <<= 1) v += __shfl_xor(v, o);
    return v;
}
__device__ __forceinline__ float bf2f(unsigned h) { return __uint_as_float(h << 16); }
__device__ __forceinline__ float sigmoid_f(float x) { return __builtin_amdgcn_rcpf(1.f + __expf(-x)); }
__device__ __forceinline__ float gelu_tanh_f(float x) { return x * sigmoid_f(1.5957691216057308f * (x + 0.044715f * x * x * x)); }
__device__ __forceinline__ v4u pack8(const f32x4 a, const f32x4 b) { v4u w; w.x = pk2(a[0], a[1]); w.y = pk2(a[2], a[3]); w.z = pk2(b[0], b[1]); w.w = pk2(b[2], b[3]); return w; }

template <class Sched> __device__ __forceinline__ void rstd_table_fill(LAS float* tab, const float* SS, const Sched& S, int tid) {
    const int row = tid & 255;
#pragma unroll
    for (int i0 = 0; i0 < RSTAB_SLOTS; i0 += 2) { const int i = i0 + (tid >> 8); pg8::Unit u; const bool ok = S.next(i, u);
        const f32x4* q = (const f32x4*)(SS + (size_t)((ok ? u.pm : 0) * 256 + row) * 16);
        const f32x4 a = q[0], b = q[1], c = q[2], d = q[3];
        const float t = ((a[0] + a[1]) + (a[2] + a[3])) + ((b[0] + b[1]) + (b[2] + b[3])) + ((c[0] + c[1]) + (c[2] + c[3])) + ((d[0] + d[1]) + (d[2] + d[3]));
        if (ok) tab[i * 256 + row] = rsqrtf(t * (1.f / 1024.f) + EPS); }
    __syncthreads();
}
__device__ __forceinline__ void rows_rstd(const LAS float* tab, int ui, int prow0, float (&rs)[2][4]) {
#pragma unroll
    for (int ai = 0; ai < 2; ++ai)
#pragma unroll
        for (int m = 0; m < 4; ++m) rs[ai][m] = tab[ui * 256 + prow0 + ai * 128 + m * 16];
}
using pg8::Unit;
struct EpiSwiGLU {
    static constexpr bool PERM = true, AFTER_DRAIN = false, INIT_ACC = false;
    bf16* H; const LAS float* TAB;
    __device__ __forceinline__ void operator()(const f32x4 (&acc)[2][2][4][2], const Unit& u, int wr, int wc, int fr, int fq, int ui) const {
        const int row0 = u.pm * 256 + wr * 64 + fr, col0 = u.pn * 128 + wc * 32 + 8 * fq;
        float rsv[2][4]; rows_rstd(TAB, ui, wr * 64 + fr, rsv);
#pragma unroll
        for (int ai = 0; ai < 2; ++ai)
#pragma unroll
            for (int m = 0; m < 4; ++m) {
                const int r = row0 + ai * 128 + m * 16; const float rs = rsv[ai][m];
                f32x4 hv[2];
#pragma unroll
                for (int n = 0; n < 2; ++n) { const f32x4 g = acc[ai][0][m][n] * rs, up = acc[ai][1][m][n] * rs;
#pragma unroll
                    for (int i = 0; i < 4; ++i) hv[n][i] = g[i] * sigmoid_f(g[i]) * up[i]; }
                *(v4u*)(H + (size_t)r * FFP + col0) = pack8(hv[0], hv[1]);
            }
    }
};
struct EpiResid {
    static constexpr bool PERM = false, AFTER_DRAIN = false, INIT_ACC = true;
    const GAS float* Xin; GAS float* X; bf16* XB; float* SS; float s, sinv; int wxb;
    __device__ __forceinline__ void init(f32x4 (&acc)[2][2][4][2], const Unit& u, int wr, int wc, int fr, int fq) const {
        const int row0 = u.pm * 256 + wr * 64 + fr, col0 = u.pn * 256 + wc * 32 + 4 * fq;
#pragma unroll
        for (int ai = 0; ai < 2; ++ai)
#pragma unroll
            for (int m = 0; m < 4; ++m)
#pragma unroll
                for (int bj = 0; bj < 2; ++bj)
#pragma unroll
                    for (int n = 0; n < 2; ++n) acc[ai][bj][m][n] = *(const GAS f32x4*)(Xin + (size_t)(row0 + ai * 128 + m * 16) * 1024 + col0 + bj * 128 + n * 16) * sinv;
    }
    __device__ __forceinline__ void operator()(const f32x4 (&acc)[2][2][4][2], const Unit& u, int wr, int wc, int fr, int fq, int ui) const {
        const int row0 = u.pm * 256 + wr * 64 + fr, col0 = u.pn * 256 + wc * 32 + 4 * fq;
#pragma unroll
        for (int ai = 0; ai < 2; ++ai)
#pragma unroll
            for (int m = 0; m < 4; ++m) {
                const int r = row0 + ai * 128 + m * 16; float q = 0.f;
#pragma unroll
                for (int bj = 0; bj < 2; ++bj)
#pragma unroll
                    for (int n = 0; n < 2; ++n) { const size_t off = (size_t)r * 1024 + col0 + bj * 128 + n * 16;
                        const f32x4 x = acc[ai][bj][m][n] * s; *(GAS f32x4*)(X + off) = x;
                        q += (x[0] * x[0] + x[1] * x[1]) + (x[2] * x[2] + x[3] * x[3]);
                        if (wxb) { u32x2 w; w.x = pk2(x[0], x[1]); w.y = pk2(x[2], x[3]); *(u32x2*)(XB + off) = w; } }
                q += __shfl_xor(q, 16); q += __shfl_xor(q, 32);
                if (wxb && fq == 0) SS[(size_t)r * 16 + u.pn * 4 + wc] = q;
            }
    }
};
struct EpiInEven {
    static constexpr bool PERM = true, AFTER_DRAIN = false, INIT_ACC = false;
    bf16 *Q, *K, *V; float* XBF; bf16* GBF; float *okp, *ovp, *oks, *ovs; const LAS float* TAB; const float *qg, *kg;
    __device__ __forceinline__ void operator()(const f32x4 (&acc)[2][2][4][2], const Unit& u, int wr, int wc, int fr, int fq, int ui) const {
        const int row0 = u.pm * 256 + wr * 64 + fr; const int t = u.pn >> 1, chunk = (u.pn & 1) * 4 + wc, fc0 = chunk * 64 + 8 * fq;
        float rsv[2][4]; rows_rstd(TAB, ui, wr * 64 + fr, rsv);
        f32x4 gn[2][2];
        if (t < 2) { const float* gp = (t == 0 ? qg : kg) + 8 * fq; const float gs = (t == 0) ? C2 : 1.f;
#pragma unroll
            for (int bj = 0; bj < 2; ++bj)
#pragma unroll
                for (int n = 0; n < 2; ++n) gn[bj][n] = *(const f32x4*)(gp + 32 * bj + 4 * n) * gs; }
#pragma unroll
        for (int ai = 0; ai < 2; ++ai)
#pragma unroll
            for (int m = 0; m < 4; ++m) {
                const int r = row0 + ai * 128 + m * 16; const float rs = rsv[ai][m];
                f32x4 v[2][2];
#pragma unroll
                for (int bj = 0; bj < 2; ++bj)
#pragma unroll
                    for (int n = 0; n < 2; ++n) v[bj][n] = acc[ai][bj][m][n] * rs;
                if (t < 2) {
                    float q = 0.f;
#pragma unroll
                    for (int bj = 0; bj < 2; ++bj)
#pragma unroll
                        for (int n = 0; n < 2; ++n) q += (v[bj][n][0] * v[bj][n][0] + v[bj][n][1] * v[bj][n][1]) + (v[bj][n][2] * v[bj][n][2] + v[bj][n][3] * v[bj][n][3]);
                    q += __shfl_xor(q, 16); q += __shfl_xor(q, 32);
                    const float nr = rsqrtf(q * (1.f / 64.f) + EPS);
#pragma unroll
                    for (int bj = 0; bj < 2; ++bj)
#pragma unroll
                        for (int n = 0; n < 2; ++n) v[bj][n] = v[bj][n] * nr * gn[bj][n];
                }
                const size_t o5 = (size_t)r * 512 + fc0;
                if (t == 0) { *(v4u*)(Q + o5) = pack8(v[0][0], v[0][1]); *(v4u*)(Q + o5 + 32) = pack8(v[1][0], v[1][1]); }
                else if (t <= 2) {
                    bf16* B = (t == 1) ? K : V; *(v4u*)(B + o5) = pack8(v[0][0], v[0][1]); *(v4u*)(B + o5 + 32) = pack8(v[1][0], v[1][1]);
                    float* O = (r < MP) ? ((t == 1 ? okp : ovp) + o5) : ((t == 1 ? oks : ovs) + (o5 - (size_t)MP * 512));
                    *(f32x4*)(O) = v[0][0]; *(f32x4*)(O + 4) = v[0][1]; *(f32x4*)(O + 32) = v[1][0]; *(f32x4*)(O + 36) = v[1][1];
                } else if (t == 3) {
                    float* O = XBF + o5;
                    *(f32x4*)(O) = v[0][0]; *(f32x4*)(O + 4) = v[0][1]; *(f32x4*)(O + 32) = v[1][0]; *(f32x4*)(O + 36) = v[1][1];
                } else { *(v4u*)(GBF + o5) = pack8(v[0][0], v[0][1]); *(v4u*)(GBF + o5 + 32) = pack8(v[1][0], v[1][1]); }
            }
    }
};
struct EpiInOdd {
    static constexpr bool PERM = false, AFTER_DRAIN = false, INIT_ACC = false;
    bf16 *U, *G; const LAS float* TAB; float *ocdp, *ocds;
    __device__ __forceinline__ void operator()(const f32x4 (&acc)[2][2][4][2], const Unit& u, int wr, int wc, int fr, int fq, int ui) const {
        const int row0 = u.pm * 256 + wr * 64 + fr, cw = wc * 32 + 4 * fq;
        float rsv[2][4]; rows_rstd(TAB, ui, wr * 64 + fr, rsv);
        const bool smp = u.pm * 256 >= MP, tailp = !smp && (u.pm & (SEQ / 256 - 1)) == SEQ / 256 - 1;
#pragma unroll
        for (int ai = 0; ai < 2; ++ai)
#pragma unroll
            for (int m = 0; m < 4; ++m) {
                const int r = row0 + ai * 128 + m * 16; const float rs = rsv[ai][m];
                if (u.pn < 2) {
#pragma unroll
                    for (int bj = 0; bj < 2; ++bj)
#pragma unroll
                        for (int n = 0; n < 2; ++n) { const f32x4 o = acc[ai][bj][m][n] * rs; u32x2 w; w.x = pk2(o[0], o[1]); w.y = pk2(o[2], o[3]); *(u32x2*)(U + (size_t)r * 512 + u.pn * 256 + bj * 128 + cw + n * 16) = w; }
                } else {
#pragma unroll
                    for (int n = 0; n < 2; ++n) { const f32x4 val = acc[ai][0][m][n] * rs, gt = acc[ai][1][m][n] * rs; f32x4 o;
#pragma unroll
                        for (int i = 0; i < 4; ++i) o[i] = val[i] * sigmoid_f(gt[i]);
                        const int col = (u.pn - 2) * 128 + cw + n * 16; u32x2 w; w.x = pk2(o[0], o[1]); w.y = pk2(o[2], o[3]);
                        *(u32x2*)(G + (size_t)r * 512 + col) = w;
                        if (smp) { const int rr = r - MP; *(f32x4*)(ocds + (size_t)((rr >> 3) * 30 + 22 + (rr & 7)) * 512 + col) = o; }
                        else if (tailp) { const int t = r & (SEQ - 1); if (t >= SEQ - 30) *(f32x4*)(ocdp + (size_t)((r / SEQ) * 30 + t - (SEQ - 30)) * 512 + col) = o; } }
                }
            }
    }
};
struct EpiGLU {
    static constexpr bool PERM = true, AFTER_DRAIN = false, INIT_ACC = false;
    const bf16* Z; bf16* MIX; const float* bias;
    __device__ __forceinline__ void operator()(const f32x4 (&acc)[2][2][4][2], const Unit& u, int wr, int wc, int fr, int fq, int ui) const {
        const int row0 = u.pm * 256 + wr * 64 + fr, col0 = u.pn * 256 + wc * 32 + 8 * fq;
        f32x4 bb[2][2];
#pragma unroll
        for (int bj = 0; bj < 2; ++bj) { bb[bj][0] = *(const f32x4*)(bias + col0 + bj * 128); bb[bj][1] = *(const f32x4*)(bias + col0 + bj * 128 + 4); }
        v4u zz[2][4][2];
#pragma unroll
        for (int ai = 0; ai < 2; ++ai)
#pragma unroll
            for (int m = 0; m < 4; ++m)
#pragma unroll
                for (int bj = 0; bj < 2; ++bj) zz[ai][m][bj] = *(const v4u*)(Z + (size_t)(row0 + ai * 128 + m * 16) * 512 + col0 + bj * 128);
#pragma unroll
        for (int ai = 0; ai < 2; ++ai)
#pragma unroll
            for (int m = 0; m < 4; ++m) {
                const int r = row0 + ai * 128 + m * 16;
#pragma unroll
                for (int bj = 0; bj < 2; ++bj) { const int c = col0 + bj * 128; const v4u z4 = zz[ai][m][bj];
                    const float z[8] = {bf2f(z4.x & 0xffffu), bf2f(z4.x >> 16), bf2f(z4.y & 0xffffu), bf2f(z4.y >> 16), bf2f(z4.z & 0xffffu), bf2f(z4.z >> 16), bf2f(z4.w & 0xffffu), bf2f(z4.w >> 16)};
                    f32x4 o0, o1;
#pragma unroll
                    for (int i = 0; i < 4; ++i) { o0[i] = z[i] * sigmoid_f(acc[ai][bj][m][0][i] + bb[bj][0][i]); o1[i] = z[4 + i] * sigmoid_f(acc[ai][bj][m][1][i] + bb[bj][1][i]); }
                    *(v4u*)(MIX + (size_t)r * 1024 + c) = pack8(o0, o1); }
            }
    }
};

template <int K>
__device__ __forceinline__ void gemm_small_resid(const bf16* A, const bf16* Bt, const GAS float* Xin, GAS float* X, bf16* XB, float* SS, float s, bool wxb, LAS unsigned char* lds, int G, int first, int tid) {
    const int wave = __builtin_amdgcn_readfirstlane(tid >> 6), lane = tid & 63, m16 = lane & 15, quad = lane >> 4;
    constexpr int KW = K / 8, STEPS = KW / 32, GRP = (STEPS + 1) / 2 > 6 ? 6 : (STEPS <= 6 ? STEPS : (STEPS + 1) / 2); static_assert(K % 256 == 0 && STEPS <= 12, "K split");
    LAS float* part = (LAS float*)lds;
    for (int tile = first; tile < 256; tile += G) {
        const int rt = tile >> 4, ct = tile & 15;
        const int row = tid >> 5, cp = tid & 31;
        const size_t off = (size_t)(rt * 16 + row) * 1024 + ct * 64 + cp * 2;
        const f32x2 xin = *(const GAS f32x2*)(Xin + off);
        const bf16* ap = A + (size_t)(rt * 16 + m16) * K + wave * KW + quad * 8;
        const bf16* bp = Bt + (size_t)(ct * 64 + m16) * K + wave * KW + quad * 8;
        f32x4 acc[4];
#pragma unroll
        for (int nt = 0; nt < 4; ++nt) acc[nt] = (f32x4){0.f, 0.f, 0.f, 0.f};
#pragma unroll 1
        for (int s0 = 0; s0 < STEPS; s0 += GRP) {
            bf16x8 af[GRP], bfr[GRP][4];
#pragma unroll
            for (int j = 0; j < GRP; ++j) if (s0 + j < STEPS) { af[j] = *(const bf16x8*)(ap + (s0 + j) * 32);
#pragma unroll
                for (int nt = 0; nt < 4; ++nt) bfr[j][nt] = *(const bf16x8*)(bp + (size_t)nt * 16 * K + (s0 + j) * 32); }
#pragma unroll
            for (int j = 0; j < GRP; ++j) if (s0 + j < STEPS) {
#pragma unroll
                for (int nt = 0; nt < 4; ++nt) acc[nt] = __builtin_amdgcn_mfma_f32_16x16x32_bf16(af[j], bfr[j][nt], acc[nt], 0, 0, 0); }
        }
#pragma unroll
        for (int nt = 0; nt < 4; ++nt)
#pragma unroll
            for (int i = 0; i < 4; ++i) part[(wave * 16 + quad * 4 + i) * 68 + nt * 16 + m16] = acc[nt][i];
        __syncthreads();
        float s0_ = 0.f, s1_ = 0.f;
#pragma unroll
        for (int w = 0; w < 8; ++w) { const f32x2 v = *(const LAS f32x2*)(part + (w * 16 + row) * 68 + cp * 2); s0_ += v.x; s1_ += v.y; }
        f32x2 x = xin; x.x += s * s0_; x.y += s * s1_; *(GAS f32x2*)(X + off) = x;
        float q = x.x * x.x + x.y * x.y;
        if (wxb) *(unsigned*)(XB + off) = pk2(x.x, x.y);
#pragma unroll
        for (int o = 1; o < 32; o <<= 1) q += __shfl_xor(q, o);
        if (wxb && cp == 0) SS[(size_t)(rt * 16 + row) * 16 + ct] = q;
        __syncthreads();
    }
}

struct Args { const void* in[44]; float* out; unsigned char* ws; int ph_lo, ph_hi; };
struct Ctx {
    LAS unsigned char* lds; volatile LAS unsigned* MISC; gu32* ctl;
    int tid, lane, wave, vcu, G;
    GAS float* out; GAS unsigned char* ws;
};
#define INF(i) ((const float*)(const GAS float*)A.in[i])
#define P_XB ((bf16*)(GAS bf16*)(C.ws + WS_XB))
#define P_H ((bf16*)(GAS bf16*)(C.ws + WS_H))
#define P_Q ((bf16*)(GAS bf16*)(C.ws + WS_Q))
#define P_K ((bf16*)(GAS bf16*)(C.ws + WS_K))
#define P_V ((bf16*)(GAS bf16*)(C.ws + WS_V))
#define P_O2 ((bf16*)(GAS bf16*)(C.ws + WS_O2))
#define P_MIX ((bf16*)(GAS bf16*)(C.ws + WS_MIX))
#define P_Z ((bf16*)(GAS bf16*)(C.ws + WS_Z))
#define P_SS ((float*)(GAS float*)(C.ws + WS_SS))
#define P_XBF ((float*)(GAS float*)(C.ws + WS_XBF))
#define P_GBF ((bf16*)(GAS bf16*)(C.ws + WS_GBF))
#define P_U ((bf16*)(GAS bf16*)(C.ws + WS_U))
#define P_GG ((bf16*)(GAS bf16*)(C.ws + WS_G))
#define P_PART ((float*)(GAS float*)(C.ws + WS_PART))
#define P_HC ((unsigned*)(GAS unsigned*)(C.ws + WS_HL))
#define P_TOT ((float*)(GAS float*)(C.ws + WS_TOT))

struct ConvD { const float* W; const float* gain; bf16* WT; int ldw, scol0, k0, Kdst, drow0; bool valid; };
enum { WT_GU = 0, WT_NAT = 1, WT_INE = 2, WT_INO = 3 };
__device__ __forceinline__ int src_col(int type, int n0) {
    const int pn = n0 >> 8, bj = (n0 >> 7) & 1;
    if (type == WT_GU) { const int j = pn * 128 + (n0 & 127); return j < FF ? bj * FF + j : -1; }
    if (type == WT_INE) { const int t = pn >> 1, wc = (n0 >> 5) & 3; return t * 512 + ((pn & 1) * 4 + wc) * 64 + bj * 32; }
    if (type == WT_INO) { return pn < 2 ? n0 : 512 + bj * 512 + (pn - 2) * 128 + (n0 & 127); }
    return n0;
}
__device__ __forceinline__ ConvD conv_mat(int type, const float* W, int ldw, int Ksrc, const float* gain, bf16* WT, int Kdst, int Ndst, int item) {
    const int nblk = Ndst / 32, kb = item / nblk, nb = item % nblk, k0 = kb * 64, n0 = nb * 32; const int sc = src_col(type, n0);
    ConvD d; d.W = W; d.gain = gain; d.WT = WT; d.ldw = ldw; d.scol0 = sc; d.k0 = k0; d.Kdst = Kdst; d.drow0 = n0; d.valid = (sc >= 0) && (k0 < Ksrc); return d;
}
__device__ __forceinline__ ConvD conv_decode(const Args& A, Ctx& C, int it) {
    constexpr int I_GU = 16 * (NGU / 32), I_DN = (FFP / 64) * 32, I_IE = 16 * (NIE / 32), I_O = 16 * 32, I_IO = 16 * (NIO / 32);
    int r = it;
    if (r < 4 * I_GU) { const int mi = r / I_GU, l = mi >> 1, f = mi & 1; r -= mi * I_GU;
        return conv_mat(WT_GU, (f ? INF(I_F2GU) : INF(I_F1GU)) + (size_t)l * 1024 * 5504, 5504, 1024, (f ? INF(I_F2G) : INF(I_F1G)) + l * 1024, (bf16*)(GAS bf16*)(C.ws + WS_WGU + mi * WGU_BYTES), 1024, NGU, r); }
    r -= 4 * I_GU;
    if (r < 4 * I_DN) { const int mi = r / I_DN, l = mi >> 1, f = mi & 1; r -= mi * I_DN;
        return conv_mat(WT_NAT, (f ? INF(I_F2DN) : INF(I_F1DN)) + (size_t)l * FF * 1024, 1024, FF, nullptr, (bf16*)(GAS bf16*)(C.ws + WS_WDN + mi * WDN_BYTES), FFP, 1024, r); }
    r -= 4 * I_DN;
    if (r < I_IE) return conv_mat(WT_INE, INF(I_EWIN), NIE, 1024, INF(I_MIXG), (bf16*)(GAS bf16*)(C.ws + WS_WIE), 1024, NIE, r);
    r -= I_IE;
    if (r < I_O) return conv_mat(WT_NAT, INF(I_EWOUT), 1024, 1024, nullptr, (bf16*)(GAS bf16*)(C.ws + WS_WOE), 1024, 1024, r);
    r -= I_O;
    if (r < I_IO) return conv_mat(WT_INO, INF(I_OWIN), NIO, 1024, INF(I_MIXG) + 1024, (bf16*)(GAS bf16*)(C.ws + WS_WIO), 1024, NIO, r);
    r -= I_IO;
    if (r < I_O) return conv_mat(WT_NAT, INF(I_OWOUT), 1024, 1024, nullptr, (bf16*)(GAS bf16*)(C.ws + WS_WOO), 1024, 1024, r);
    r -= I_O;
    return conv_mat(WT_NAT, INF(I_CGLUW), 512, 512, nullptr, (bf16*)(GAS bf16*)(C.ws + WS_WGLU), 512, 512, r);
}
__device__ __forceinline__ void conv_load(const ConvD& d, float (&wv)[32], float& g0, int lane) {
    const int sc = d.valid ? d.scol0 : 0, kq = d.valid ? d.k0 : 0;
#pragma unroll
    for (int i = 0; i < 32; ++i) { const int kk = 2 * i + (lane >> 5); wv[i] = d.W[(size_t)(kq + kk) * d.ldw + sc + (lane & 31)]; }
    g0 = d.gain ? d.gain[kq + lane] : 1.f;
}
__device__ __forceinline__ void conv_store(const ConvD& d, const float (&wv)[32], float g0, LAS float* scr, int lane) {
    const int c = lane & 7;
#pragma unroll
    for (int i = 0; i < 32; ++i) { const int kk = 2 * i + (lane >> 5); scr[kk * 33 + (lane & 31)] = d.valid ? wv[i] * __shfl(g0, kk) : 0.f; }
    LDS_WAIT(); asm volatile("" ::: "memory");
#pragma unroll
    for (int j = 0; j < 4; ++j) { const int n = (lane >> 3) + 8 * j; const LAS float* s = scr + (8 * c) * 33 + n;
        v4u o; o.x = pk2(s[0 * 33], s[1 * 33]); o.y = pk2(s[2 * 33], s[3 * 33]); o.z = pk2(s[4 * 33], s[5 * 33]); o.w = pk2(s[6 * 33], s[7 * 33]);
        *(GAS v4u*)(d.WT + (size_t)(d.drow0 + n) * d.Kdst + d.k0 + 8 * c) = o; }
    LDS_WAIT(); asm volatile("" ::: "memory");
}
struct ConvSeg { int start, n; };
template <int R> __device__ __forceinline__ int conv_range_item(int v) {
    constexpr int I_GU = 16 * (NGU / 32), I_DN = (FFP / 64) * 32, I_IE = 16 * (NIE / 32), I_O = 16 * 32, I_IO = 16 * (NIO / 32), I_GL = 8 * 16;
    constexpr int B_DN = 4 * I_GU, B_IE = B_DN + 4 * I_DN, B_OE = B_IE + I_IE, B_IO = B_OE + I_O, B_OO = B_IO + I_IO, B_GL = B_OO + I_O;
    constexpr ConvSeg segs[4][4] = { { {0, I_GU}, {B_DN, I_DN}, {B_IE, I_IE}, {0, 0} },
                                     { {B_OE, I_O}, {I_GU, I_GU}, {B_DN + I_DN, I_DN}, {0, 0} },
                                     { {2 * I_GU, I_GU}, {B_DN + 2 * I_DN, I_DN}, {B_IO, I_IO}, {0, 0} },
                                     { {B_GL, I_GL}, {B_OO, I_O}, {3 * I_GU, I_GU}, {B_DN + 3 * I_DN, I_DN} } };
#pragma unroll
    for (int k = 0; k < 4; ++k) { if (v < segs[R][k].n) return segs[R][k].start + v; v -= segs[R][k].n; }
    return -1;
}
template <int R> __device__ __forceinline__ void conv_run(const Args& A, Ctx& C, int gw, int NGW) {
    LAS float* scr = (LAS float*)(C.lds + RING_OFF + C.wave * 16384);
    for (int v = gw; ; v += 2 * NGW) {
        const int it0 = conv_range_item<R>(v); if (it0 < 0) break;
        const int it1 = conv_range_item<R>(v + NGW); const bool two = it1 >= 0;
        const ConvD d0 = conv_decode(A, C, it0), d1 = conv_decode(A, C, two ? it1 : it0);
        float w0[32], w1[32], g0, g1;
        conv_load(d0, w0, g0, C.lane); conv_load(d1, w1, g1, C.lane);
        conv_store(d0, w0, g0, scr, C.lane);
        if (two) conv_store(d1, w1, g1, scr, C.lane);
    }
}
__device__ __forceinline__ void p0_prologue(const Args& A, Ctx& C) {
    const int gw = C.vcu * NWAVES + C.wave, NGW = C.G * NWAVES;
    conv_run<0>(A, C, gw, NGW);
    for (int m0 = gw; m0 < MT; m0 += 2 * NGW) {
        f32x4 v[2][4]; float sq[2];
#pragma unroll
        for (int u = 0; u < 2; ++u) { const int m = m0 + u * NGW; const int mc = m < MT ? m : m0;
            const float* xrow = (mc < MP) ? INF(I_XP) + (size_t)mc * 1024 : INF(I_XS) + (size_t)(mc - MP) * 1024;
            const GAS f32x4* xr = (const GAS f32x4*)xrow + C.lane; float s = 0.f;
#pragma unroll
            for (int j = 0; j < 4; ++j) { v[u][j] = xr[64 * j]; s += (v[u][j].x * v[u][j].x + v[u][j].y * v[u][j].y) + (v[u][j].z * v[u][j].z + v[u][j].w * v[u][j].w); }
            sq[u] = s; }
#pragma unroll
        for (int u = 0; u < 2; ++u) { const int m = m0 + u * NGW; if (m >= MT) break;
            const float s = wave_sum(sq[u]);
            GAS unsigned long long* o8 = (GAS unsigned long long*)(P_XB + (size_t)m * 1024) + C.lane;
#pragma unroll
            for (int j = 0; j < 4; ++j) o8[64 * j] = (unsigned long long)pk2(v[u][j].x, v[u][j].y) | ((unsigned long long)pk2(v[u][j].z, v[u][j].w) << 32);
            if (C.lane < 16) P_SS[(size_t)m * 16 + C.lane] = (C.lane == 0) ? s : 0.f; }
    }
}

#define LDS_BAR() do { asm volatile("s_waitcnt lgkmcnt(0)" ::: "memory"); __builtin_amdgcn_s_barrier(); asm volatile("" ::: "memory"); } while (0)
__device__ __forceinline__ float lam_value(const float* lv, int lane) {
    const float a = wave_sum(lv[lane] * lv[64 + lane]), b = wave_sum(lv[128 + lane] * lv[192 + lane]);
    return expf(a) - expf(b) + LAM_INIT0;
}

__device__ __forceinline__ void split_hi_lo(const f32x4 a, const f32x4 b, v4u& hi, v4u& lo) {
    hi = pack8(a, b);
    f32x4 ra, rb;
    ra[0] = a[0] - __uint_as_float(hi.x << 16); ra[1] = a[1] - __uint_as_float(hi.x & 0xffff0000u); ra[2] = a[2] - __uint_as_float(hi.y << 16); ra[3] = a[3] - __uint_as_float(hi.y & 0xffff0000u);
    rb[0] = b[0] - __uint_as_float(hi.z << 16); rb[1] = b[1] - __uint_as_float(hi.z & 0xffff0000u); rb[2] = b[2] - __uint_as_float(hi.w << 16); rb[3] = b[3] - __uint_as_float(hi.w & 0xffff0000u);
    lo = pack8(ra, rb);
}
template <bool SAMPLE>
__device__ __forceinline__ void rglru_item(const Args& A, Ctx& C, int bi, int ch, int blk) {
    LAS float* R0 = (LAS float*)(C.lds);
    LAS bf16* XH = (LAS bf16*)(C.lds);
    LAS bf16* XL = (LAS bf16*)(C.lds + 18432);
    LAS float* R1 = (LAS float*)(C.lds + 45056);
    LAS float* R2 = (LAS float*)(C.lds + 45056 + 32768);
    LAS float* RP = (LAS float*)(C.lds + 45056 + 65536);
    LAS float* RH = RP + 512;
    const int c = C.tid & 63, sub = C.wave, ch0 = blk * 64 + c, lane = C.lane, m16 = lane & 15, quad = lane >> 4;
    const int g = sub >> 2, j0 = (sub & 3) * 16;
    v4u wh[2], wl[2];
    { const float* wp = INF(I_BGW) + ((size_t)(g * 8 + blk) * 64 + quad * 8) * 64 + j0 + m16;
#pragma unroll
      for (int ks = 0; ks < 2; ++ks) { f32x4 x0, x1;
#pragma unroll
          for (int i = 0; i < 4; ++i) { x0[i] = wp[(size_t)(ks * 32 + i) * 64]; x1[i] = wp[(size_t)(ks * 32 + 4 + i) * 64]; }
          split_hi_lo(x0, x1, wh[ks], wl[ks]); } }
    const float gbias = INF(I_BGB)[g * 512 + blk * 64 + j0 + m16];
    f32x4 kw[4][4], kb[4];
    { const int cq0 = (C.tid & 3) * 16;
#pragma unroll
      for (int q = 0; q < 4; ++q) { const int cc = blk * 64 + cq0 + q * 4; kb[q] = *(const f32x4*)(INF(I_BCB) + cc);
#pragma unroll
          for (int k = 0; k < 4; ++k) kw[k][q] = *(const f32x4*)(INF(I_BCW) + k * 512 + cc); } }
    const float sp8 = -8.f * log1pf(expf(-INF(I_BLAM)[blk * 64 + j0 + m16]));
    if (!SAMPLE) {
        const int t0 = ch * 128;
#pragma unroll
        for (int e0 = 0; e0 < 131 * 16; e0 += NTHR) { const int e = e0 + C.tid; if (e >= 131 * 16) break; const int i = e >> 4, q4 = (e & 15) * 4, tk = t0 - 3 + i;
            f32x4 v = *(const f32x4*)(P_XBF + (size_t)(bi * SEQ + (tk < 0 ? 0 : tk)) * 512 + blk * 64 + q4);
            if (tk < 0) v = (f32x4){0.f, 0.f, 0.f, 0.f};
            *(LAS f32x4*)(R0 + i * 64 + q4) = v;
            if (ch == 31 && i >= 128) *(f32x4*)(C.out + O_CBP + (size_t)(bi * 3 + (i - 128)) * 512 + blk * 64 + q4) = v; }
    } else {
#pragma unroll
        for (int e0 = 0; e0 < 176 * 16; e0 += NTHR) { const int e = e0 + C.tid; if (e >= 176 * 16) break; const int i = e >> 4, q4 = (e & 15) * 4, sl = i / 11, k = i % 11, n = bi * 16 + sl;
            const float* src = (k < 3) ? INF(I_SCB) + (size_t)(n * 3 + k) * 512 : P_XBF + (size_t)(MP + n * 8 + (k - 3)) * 512;
            const f32x4 v = *(const f32x4*)(src + blk * 64 + q4);
            *(LAS f32x4*)(R0 + i * 64 + q4) = v;
            if (k >= 8) *(f32x4*)(C.out + O_CBS + (size_t)(n * 3 + (k - 8)) * 512 + blk * 64 + q4) = v; }
    }
    LDS_BAR();
    { const int lr = C.tid >> 2, cq = (C.tid & 3) * 16; const int base = SAMPLE ? ((lr >> 3) * 11 + (lr & 7)) : lr;
      f32x4 xo[4];
#pragma unroll
      for (int q = 0; q < 4; ++q) { const int cc = cq + q * 4;
          xo[q] = kb[q] + kw[0][q] * *(const LAS f32x4*)(R0 + base * 64 + cc) + kw[1][q] * *(const LAS f32x4*)(R0 + (base + 1) * 64 + cc) + kw[2][q] * *(const LAS f32x4*)(R0 + (base + 2) * 64 + cc) + kw[3][q] * *(const LAS f32x4*)(R0 + (base + 3) * 64 + cc);
          *(LAS f32x4*)(R1 + lr * 64 + cc) = xo[q]; }
      LDS_BAR();
      v4u h0, l0, h1, l1; split_hi_lo(xo[0], xo[1], h0, l0); split_hi_lo(xo[2], xo[3], h1, l1);
      *(LAS v4u*)(XH + lr * 72 + cq) = h0; *(LAS v4u*)(XH + lr * 72 + cq + 8) = h1; *(LAS v4u*)(XL + lr * 72 + cq) = l0; *(LAS v4u*)(XL + lr * 72 + cq + 8) = l1; }
    LDS_BAR();
#pragma unroll 2
    for (int mt = 0; mt < 8; ++mt) { f32x4 acc = (f32x4){0.f, 0.f, 0.f, 0.f};
#pragma unroll
        for (int ks = 0; ks < 2; ++ks) { const int xo_ = (mt * 16 + m16) * 72 + ks * 32 + quad * 8;
            const bf16x8 ah = *(const LAS bf16x8*)(XH + xo_), al = *(const LAS bf16x8*)(XL + xo_), bh_ = __builtin_bit_cast(bf16x8, wh[ks]), bl_ = __builtin_bit_cast(bf16x8, wl[ks]);
            acc = __builtin_amdgcn_mfma_f32_16x16x32_bf16(ah, bh_, acc, 0, 0, 0); acc = __builtin_amdgcn_mfma_f32_16x16x32_bf16(al, bh_, acc, 0, 0, 0); acc = __builtin_amdgcn_mfma_f32_16x16x32_bf16(ah, bl_, acc, 0, 0, 0); }
#pragma unroll
        for (int i = 0; i < 4; ++i) { const int t = mt * 16 + quad * 4 + i, j = j0 + m16; const float sg = sigmoid_f(acc[i] + gbias);
            if (g == 0) R2[t * 64 + j] = sp8 * sg; else R1[t * 64 + j] = sg * R1[t * 64 + j]; } }
    LDS_BAR();
    if (!SAMPLE) {
        float P = 1.f, Hl = 0.f;
#pragma unroll 4
        for (int k = 0; k < 16; ++k) { const int lr = sub * 16 + k; const float la = R2[lr * 64 + c]; const float a = __expf(la), bb = __builtin_amdgcn_sqrtf(fmaxf(1.f - a * a, 0.f)) * R1[lr * 64 + c];
            R2[lr * 64 + c] = a; R1[lr * 64 + c] = bb; P *= a; Hl = a * Hl + bb; }
        RP[sub * 64 + c] = P; RH[sub * 64 + c] = Hl;
        LDS_BAR();
        float h = 0.f, cp = 1.f;
        { float rp_[7], rh_[7];
#pragma unroll
          for (int k2 = 0; k2 < 7; ++k2) { rp_[k2] = RP[k2 * 64 + c]; rh_[k2] = RH[k2 * 64 + c]; }
#pragma unroll
          for (int k2 = 0; k2 < 7; ++k2) if (k2 < sub) { h = rp_[k2] * h + rh_[k2]; cp *= rp_[k2]; } }
        const size_t row0 = (size_t)bi * SEQ + ch * 128 + sub * 16;
#pragma unroll 4
        for (int k = 0; k < 16; ++k) { const int lr = sub * 16 + k; const float a = R2[lr * 64 + c]; h = a * h + R1[lr * 64 + c]; cp *= a;
            P_HC[(row0 + k) * 512 + ch0] = pk2(h, cp); }
        if (sub == 7) { P_TOT[(size_t)(bi * 32 + ch) * 512 + ch0] = cp; P_TOT[(size_t)(128 + bi * 32 + ch) * 512 + ch0] = h; }
    } else {
#pragma unroll
        for (int s2 = 0; s2 < 2; ++s2) { const int sl = sub * 2 + s2, n = bi * 16 + sl; float h = INF(I_SHB)[(size_t)n * 512 + ch0];
#pragma unroll
            for (int t = 0; t < 8; ++t) { const int lr = sl * 8 + t; const float la = R2[lr * 64 + c]; const float a = __expf(la), bb = __builtin_amdgcn_sqrtf(fmaxf(1.f - a * a, 0.f)) * R1[lr * 64 + c];
                h = a * h + bb; const size_t row = (size_t)MP + n * 8 + t;
                const float gv = bf2f((unsigned)(unsigned short)P_GBF[row * 512 + ch0]);
                P_MIX[row * 1024 + 512 + ch0] = (bf16)f2bf(gelu_tanh_f(gv) * h); }
            C.out[O_HBS + (size_t)n * 512 + ch0] = h; }
    }
    LDS_BAR();
}
__device__ __forceinline__ void rglru_fix(const Args& A, Ctx& C, int item) {
    const int b = item >> 6, ch = (item >> 1) & 31, hf = item & 1, c = C.tid;
    float tp[31], th[31];
#pragma unroll
    for (int k = 0; k < 31; ++k) { tp[k] = P_TOT[(size_t)(b * 32 + k) * 512 + c]; th[k] = P_TOT[(size_t)(128 + b * 32 + k) * 512 + c]; }
    float hin = 0.f;
#pragma unroll
    for (int k = 0; k < 31; ++k) hin = (k < ch) ? tp[k] * hin + th[k] : hin;
    const size_t row0 = (size_t)b * SEQ + ch * 128 + hf * 64;
    float h = 0.f;
#pragma unroll 16
    for (int t = 0; t < 64; ++t) { const size_t o = (row0 + t) * 512 + c;
        const unsigned hc = P_HC[o]; h = bf2f(hc & 0xffffu) + __uint_as_float(hc & 0xffff0000u) * hin;
        P_MIX[(row0 + t) * 1024 + 512 + c] = (bf16)(pk2(gelu_tanh_f(bf2f((unsigned)(unsigned short)P_GBF[o])) * h, 0.f) & 0xffffu); }
    if (ch == 31 && hf == 1) C.out[O_HBP + (size_t)b * 512 + c] = P_TOT[(size_t)(b * 32 + 31) * 512 + c] * hin + P_TOT[(size_t)(128 + b * 32 + 31) * 512 + c];
}

__device__ __forceinline__ bf16x8 cvt8(const f32x4 a, const f32x4 b) { const v4u w = pack8(a, b); return __builtin_bit_cast(bf16x8, w); }
__device__ __forceinline__ void sattn_wave(const Args& A, Ctx& C, int n, int h, int s) {
    const int lane = C.lane, m16 = lane & 15, quad = lane >> 4, j = m16 >> 3, q = m16 & 7;
    bf16x8 bq[4];
#pragma unroll
    for (int kk = 0; kk < 4; ++kk) { bq[kk] = (bf16x8){0, 0, 0, 0, 0, 0, 0, 0};
        if (j == (kk >> 1)) bq[kk] = *(const bf16x8*)(P_Q + (size_t)(MP + n * 8 + q) * 512 + (h * 2 + j) * 64 + (kk & 1) * 32 + quad * 8); }
    float mrow = -1e30f, l = 0.f; f32x4 o[8];
#pragma unroll
    for (int dg = 0; dg < 8; ++dg) o[dg] = (f32x4){0.f, 0.f, 0.f, 0.f};
    constexpr int PPW = NPG / NSPLIT;
    const int* ptab = (const int*)(const GAS int*)A.in[I_PT] + n * NPG + s * PPW;
    const float* ckh = INF(I_CK) + h * 128; const float* cvh = INF(I_CV) + h * 128;
    const unsigned koff = (unsigned)(m16 * 512 + quad * 8);
    const unsigned voff = (unsigned)(quad * 4 * 512 + m16);
    f32x4 kq[16]; float vq[64];
#define SA_LOADK(ph_, ks_) do { const float* kb_ = ckh + ((size_t)(ph_) * PAGE + (ks_) * 32) * 512; \
        _Pragma("unroll") for (int tt = 0; tt < 2; ++tt) { const float* kr_ = kb_ + tt * 8192; asm volatile("" : "+s"(kr_)); \
            _Pragma("unroll") for (int kk = 0; kk < 4; ++kk) { kq[(tt * 4 + kk) * 2] = *(const f32x4*)(kr_ + (koff + (unsigned)(kk * 32))); kq[(tt * 4 + kk) * 2 + 1] = *(const f32x4*)(kr_ + (koff + (unsigned)(kk * 32 + 4))); } } } while (0)
#define SA_LOADV(ph_, ks_) do { const float* vb_ = cvh + ((size_t)(ph_) * PAGE + (ks_) * 32) * 512; \
        _Pragma("unroll") for (int i = 0; i < 4; ++i) { const float* v0_ = vb_ + i * 512; const float* v1_ = vb_ + (16 + i) * 512; asm volatile("" : "+s"(v0_), "+s"(v1_)); \
            _Pragma("unroll") for (int dg = 0; dg < 8; ++dg) { vq[dg * 8 + i] = v0_[voff + (unsigned)(dg * 16)]; vq[dg * 8 + 4 + i] = v1_[voff + (unsigned)(dg * 16)]; } } } while (0)
    int ph = __builtin_amdgcn_readfirstlane(ptab[0]);
    SA_LOADK(ph, 0); SA_LOADV(ph, 0);
#pragma unroll 1
    for (int pg = 0; pg < PPW; ++pg) {
        const bool lastpg = (pg + 1 == PPW); const int phn = __builtin_amdgcn_readfirstlane(ptab[lastpg ? pg : pg + 1]);
#pragma unroll 1
        for (int ks = 0; ks < 4; ++ks) {
            const int nph = (ks < 3) ? ph : phn, nks = (ks + 1) & 3; const bool more = !(lastpg && ks == 3);
            f32x4 sc2[2];
#pragma unroll
            for (int tt = 0; tt < 2; ++tt) { f32x4 acc = (f32x4){0.f, 0.f, 0.f, 0.f};
#pragma unroll
                for (int kk = 0; kk < 4; ++kk) acc = __builtin_amdgcn_mfma_f32_16x16x32_bf16(cvt8(kq[(tt * 4 + kk) * 2], kq[(tt * 4 + kk) * 2 + 1]), bq[kk], acc, 0, 0, 0);
                sc2[tt] = acc; }
            __builtin_amdgcn_sched_barrier(0);
            if (more) SA_LOADK(nph, nks);
            __builtin_amdgcn_sched_barrier(0);
            float mx = fmaxf(fmaxf(fmaxf(sc2[0][0], sc2[0][1]), fmaxf(sc2[0][2], sc2[0][3])), fmaxf(fmaxf(sc2[1][0], sc2[1][1]), fmaxf(sc2[1][2], sc2[1][3])));
            mx = fmaxf(mx, __shfl_xor(mx, 16)); mx = fmaxf(mx, __shfl_xor(mx, 32));
            const float mn = fmaxf(mrow, mx), scl = __builtin_amdgcn_exp2f(mrow - mn); mrow = mn;
            f32x4 p0, p1; float ps = 0.f;
#pragma unroll
            for (int i = 0; i < 4; ++i) { p0[i] = __builtin_amdgcn_exp2f(sc2[0][i] - mn); p1[i] = __builtin_amdgcn_exp2f(sc2[1][i] - mn); ps += p0[i] + p1[i]; }
            l = l * scl + ps;
            const bf16x8 pb = cvt8(p0, p1);
#pragma unroll
            for (int dg = 0; dg < 8; ++dg) { const f32x4 v0 = {vq[dg * 8], vq[dg * 8 + 1], vq[dg * 8 + 2], vq[dg * 8 + 3]}, v1 = {vq[dg * 8 + 4], vq[dg * 8 + 5], vq[dg * 8 + 6], vq[dg * 8 + 7]};
                o[dg] = o[dg] * scl; o[dg] = __builtin_amdgcn_mfma_f32_16x16x32_bf16(cvt8(v0, v1), pb, o[dg], 0, 0, 0); }
            __builtin_amdgcn_sched_barrier(0);
            if (more) SA_LOADV(nph, nks);
            __builtin_amdgcn_sched_barrier(0);
        }
        ph = phn;
    }
#undef SA_LOADK
#undef SA_LOADV
    l += __shfl_xor(l, 16); l += __shfl_xor(l, 32);
    float* pr = P_PART + ((size_t)((n * 4 + h) * NSPLIT + s) * 16 + m16) * PSTR;
#pragma unroll
    for (int dg = 0; dg < 8; ++dg) *(f32x4*)(pr + dg * 16 + quad * 4) = o[dg];
    if (quad == 0) { pr[128] = mrow; pr[129] = l; }
}

__device__ __forceinline__ void p5_combine(const Args& A, Ctx& C) {
    const int gw = C.vcu * NWAVES + C.wave, NGW = C.G * NWAVES, lane = C.lane;
    const float lam = lam_value(INF(I_ALAM), lane);
    const float osc = 1.f - LAM_INIT0;
    for (int it = C.vcu; it < 256; it += C.G) rglru_fix(A, C, it);
    {
        const int hh = lane >> 4, e0 = (lane & 15) * 8;
        const f32x4 g0 = *(const f32x4*)(INF(I_AHG) + e0), g1 = *(const f32x4*)(INF(I_AHG) + e0 + 4);
        for (int r = gw; r < MP; r += NGW) {
            const v4u a = *(const v4u*)(P_O2 + (size_t)r * 1024 + hh * 128 + e0), b = *(const v4u*)(P_O2 + (size_t)r * 1024 + 512 + hh * 128 + e0);
            const unsigned aw[4] = {a.x, a.y, a.z, a.w}, bw[4] = {b.x, b.y, b.z, b.w}; float d[8]; float q = 0.f;
#pragma unroll
            for (int i = 0; i < 4; ++i) { d[2 * i] = bf2f(aw[i] & 0xffffu) - lam * bf2f(bw[i] & 0xffffu); d[2 * i + 1] = bf2f(aw[i] >> 16) - lam * bf2f(bw[i] >> 16); q += d[2 * i] * d[2 * i] + d[2 * i + 1] * d[2 * i + 1]; }
            q += __shfl_xor(q, 1); q += __shfl_xor(q, 2); q += __shfl_xor(q, 4); q += __shfl_xor(q, 8);
            const float rs = rsqrtf(q * (1.f / 128.f) + EPS) * osc;
            f32x4 o0, o1;
#pragma unroll
            for (int i = 0; i < 4; ++i) { o0[i] = d[i] * rs * g0[i]; o1[i] = d[4 + i] * rs * g1[i]; }
            *(v4u*)(P_MIX + (size_t)r * 1024 + hh * 128 + e0) = pack8(o0, o1);
        }
    }
    {
        const int jh = lane >> 5, el = lane & 31, e0 = el * 4;
        const f32x4 hg = *(const f32x4*)(INF(I_AHG) + e0);
        for (int it = gw; it < NS * 4 * 8; it += NGW) {
            const int n = it >> 5, h = (it >> 3) & 3;
            const float* pbase = P_PART + ((size_t)(n * 4 + h) * NSPLIT * 16) * PSTR;
            { const int q = it & 7;
                const int row = jh * 8 + q;
                float ms[NSPLIT], ls[NSPLIT]; float M = -1e30f;
#pragma unroll
                for (int s = 0; s < NSPLIT; ++s) { const float* pr = pbase + ((size_t)s * 16 + row) * PSTR; ms[s] = pr[128]; ls[s] = pr[129]; M = fmaxf(M, ms[s]); }
                const unsigned qw = *(const unsigned*)(P_Q + (size_t)(MP + n * 8 + q) * 512 + (h * 2 + jh) * 64 + el * 2);
                const float q0 = bf2f(qw & 0xffffu), q1 = bf2f(qw >> 16);
                float sc[8];
#pragma unroll
                for (int t = 0; t < 8; ++t) { const f32x2 kv = *(const f32x2*)(C.out + O_KS + (size_t)(n * 8 + t) * 512 + (h * 2 + jh) * 64 + el * 2);
                    float d = q0 * kv.x + q1 * kv.y;
#pragma unroll
                    for (int o = 1; o < 32; o <<= 1) d += __shfl_xor(d, o);
                    sc[t] = (t <= q) ? d : -1e30f; M = fmaxf(M, sc[t]); }
                float L = 0.f; f32x4 O = (f32x4){0.f, 0.f, 0.f, 0.f};
#pragma unroll
                for (int s = 0; s < NSPLIT; ++s) { const float w = exp2f(ms[s] - M); L += ls[s] * w; O = O + *(const f32x4*)(pbase + ((size_t)s * 16 + row) * PSTR + e0) * w; }
#pragma unroll
                for (int t = 0; t < 8; ++t) { const float p = (t <= q) ? exp2f(sc[t] - M) : 0.f; L += p; O = O + *(const f32x4*)(C.out + O_VS + (size_t)(n * 8 + t) * 512 + h * 128 + e0) * p; }
                O = O * (1.f / L);
                f32x4 other;
#pragma unroll
                for (int i = 0; i < 4; ++i) other[i] = __shfl_xor(O[i], 32);
                f32x4 att = (jh == 0) ? (O - other * lam) : (other - O * lam);
                float qq = (att[0] * att[0] + att[1] * att[1]) + (att[2] * att[2] + att[3] * att[3]);
#pragma unroll
                for (int o = 1; o < 32; o <<= 1) qq += __shfl_xor(qq, o);
                const float rs = rsqrtf(qq * (1.f / 128.f) + EPS) * osc;
                if (jh == 0) { u32x2 w; w.x = pk2(att[0] * rs * hg[0], att[1] * rs * hg[1]); w.y = pk2(att[2] * rs * hg[2], att[3] * rs * hg[3]);
                    *(u32x2*)(P_MIX + (size_t)(MP + n * 8 + q) * 1024 + h * 128 + e0) = w; }
            }
        }
    }
}

__device__ __forceinline__ void sincos_f(float x, float& sn, float& cs) {
    const float k = rintf(x * 0.63661977236758134f);
    float r = fmaf(-k, 1.5707963705062866f, x); r = fmaf(-k, -4.3711388286737929e-8f, r);
    const float r2 = r * r;
    const float s = r + r * r2 * (-1.6666654611e-1f + r2 * (8.3321608736e-3f + r2 * (-1.9515295891e-4f)));
    const float c = 1.f - 0.5f * r2 + r2 * r2 * (4.166664568298827e-2f + r2 * (-1.388731625493765e-3f + r2 * 2.443315711809948e-5f));
    const int qd = ((int)k) & 3;
    sn = (qd == 0) ? s : (qd == 1) ? c : (qd == 2) ? -s : -c;
    cs = (qd == 0) ? c : (qd == 1) ? -s : (qd == 2) ? -c : s;
}
__device__ __forceinline__ void s5_consts(const Args& A, int g, int p, float& ar, float& ai, float& cr, float& ci) {
    const float dt = expf(INF(I_CLDT)[g]), are = INF(I_CARE)[g * 64 + p], aim = INF(I_CAIM)[g * 64 + p];
    const float mag = expf(dt * are); float sn, cs; sincos_f(dt * aim, sn, cs);
    ar = mag * cs; ai = mag * sn;
    const float den = are * are + aim * aim, nr = ar - 1.f;
    cr = (nr * are + ai * aim) / den; ci = (ai * are - nr * aim) / den;
}
template <bool SAMPLE>
__device__ __forceinline__ void s5_item(const Args& A, Ctx& C, int bi, int g) {
    LAS float* BU = (LAS float*)(C.lds);
    LAS bf16* S16 = (LAS bf16*)(C.lds + 67584);
    LAS bf16* UB = (LAS bf16*)(C.lds + 67584 + 34816);
    LAS f32x2* Lc = (LAS f32x2*)(C.lds + 67584 + 34816 + 20480);
    LAS f32x2* Ic = Lc + 896;
    static_assert(67584 + 34816 + 20480 + 7168 + 1024 <= RING_BYTES, "S5 LDS map");
    const int p = C.tid & 63, sub = C.wave, lane = C.lane, m16 = lane & 15, quad = lane >> 4;
    float ar, ai;
    { float cr, ci; s5_consts(A, g, p, ar, ai, cr, ci); ((LAS f32x2*)BU)[sub * 64 + p] = (f32x2){cr, ci}; }
    asm volatile("s_waitcnt lgkmcnt(0)" ::: "memory");
    bf16x4 bh[8];
#pragma unroll
    for (int nt = 0; nt < 8; ++nt) { const int n = nt * 16 + m16, pn = n >> 1; const f32x2 cc = ((const LAS f32x2*)BU)[sub * 64 + pn]; const float cr = cc.x, ci = cc.y;
      const f32x4 r0 = *(const f32x4*)(INF(I_CBRE) + ((size_t)g * 64 + pn) * 16 + quad * 4), i0 = *(const f32x4*)(INF(I_CBIM) + ((size_t)g * 64 + pn) * 16 + quad * 4);
      const f32x4 x0 = ((n & 1) == 0) ? (r0 * cr - i0 * ci) : (i0 * cr + r0 * ci);
      u32x2 w; w.x = pk2(x0[0], x0[1]); w.y = pk2(x0[2], x0[3]); bh[nt] = __builtin_bit_cast(bf16x4, w); }
    LDS_BAR();
    bf16x8 cf[4];
#pragma unroll
    for (int ks = 0; ks < 4; ++ks) { const size_t co = ((size_t)g * 16 + m16) * 64 + ks * 16 + quad * 4;
        const f32x4 xr = *(const f32x4*)(INF(I_CCRE) + co), xi = *(const f32x4*)(INF(I_CCIM) + co);
        cf[ks] = cvt8((f32x4){xr[0], -xi[0], xr[1], -xi[1]}, (f32x4){xr[2], -xi[2], xr[3], -xi[3]}); }
    const float dch = INF(I_CD)[g * 16 + m16];
    const size_t gbase = SAMPLE ? (size_t)MP + bi * 128 : (size_t)bi * SEQ;
    const int urow = C.tid >> 2, uq = (C.tid & 3) * 4;
    u32x2 uqv[4];
#define WAVE_LDS() asm volatile("s_waitcnt lgkmcnt(0)" ::: "memory")
#define S5_LOAD(j, chn) uqv[j] = *(const u32x2*)(P_U + (gbase + (size_t)(chn) * 128 + urow) * 512 + g * 16 + uq)
#define S5_PUT_U(buf, j) do { *(LAS u32x2*)(UB + (buf) * 2560 + urow * 20 + uq) = uqv[j]; } while (0)
#define S5_BP(buf) do { const bf16x4 ua = *(const LAS bf16x4*)(UB + (buf) * 2560 + (sub * 16 + m16) * 20 + quad * 4); \
        _Pragma("unroll") for (int nt = 0; nt < 8; ++nt) { \
            const f32x4 acc = __builtin_amdgcn_mfma_f32_16x16x16bf16_1k(ua, bh[nt], (f32x4){0.f, 0.f, 0.f, 0.f}, 0, 0, 0); \
            _Pragma("unroll") for (int i = 0; i < 4; ++i) BU[(sub * 16 + quad * 4 + i) * 132 + nt * 16 + m16] = acc[i]; } } while (0)
#define S5_CP(buf, grow0_) do { f32x4 acc = (f32x4){0.f, 0.f, 0.f, 0.f}; \
        _Pragma("unroll") for (int ks = 0; ks < 4; ++ks) acc = __builtin_amdgcn_mfma_f32_16x16x32_bf16(*(const LAS bf16x8*)(S16 + (sub * 16 + m16) * 136 + ks * 32 + quad * 8), cf[ks], acc, 0, 0, 0); \
        _Pragma("unroll") for (int i = 0; i < 4; ++i) { const int t = sub * 16 + quad * 4 + i; \
            const float y = acc[i] + dch * bf2f(UB[(buf) * 2560 + t * 20 + m16]); P_Z[((grow0_) + t) * 512 + g * 16 + m16] = (bf16)(pk2(gelu_tanh_f(y), 0.f) & 0xffffu); } } while (0)
#define S5_STEP1(sr_, si_, vx_, vy_) do { const float nr_ = fmaf(ar, sr_, fmaf(-ai, si_, (vx_))), ni_ = fmaf(ar, si_, fmaf(ai, sr_, (vy_))); sr_ = nr_; si_ = ni_; } while (0)
    if (SAMPLE) {
        S5_LOAD(0, 0); S5_PUT_U(0, 0);
        WAVE_LDS();
        S5_BP(0);
        WAVE_LDS();
#pragma unroll
        for (int s2 = 0; s2 < 2; ++s2) { const int sl = sub * 2 + s2, n = bi * 16 + sl;
            float sr = INF(I_SCRE)[(size_t)(n * 32 + g) * 64 + p], si = INF(I_SCIM)[(size_t)(n * 32 + g) * 64 + p];
#pragma unroll
            for (int t8 = 0; t8 < 8; ++t8) { const int t = sl * 8 + t8; const f32x2 v = *(const LAS f32x2*)(BU + t * 132 + 2 * p); S5_STEP1(sr, si, v.x, v.y);
                *(LAS unsigned*)(S16 + t * 136 + 2 * p) = pk2(sr, si); }
            C.out[O_CRES + (size_t)(n * 32 + g) * 64 + p] = sr; C.out[O_CIMS + (size_t)(n * 32 + g) * 64 + p] = si; }
        WAVE_LDS();
        S5_CP(0, gbase);
    } else {
        float pwr[16], pwi[16];
        pwr[0] = ar; pwi[0] = ai;
#pragma unroll
        for (int k = 1; k < 16; ++k) { pwr[k] = pwr[k - 1] * ar - pwi[k - 1] * ai; pwi[k] = pwr[k - 1] * ai + pwi[k - 1] * ar; }
        if (C.tid < 128) Ic[C.tid] = (f32x2){0.f, 0.f};
        float slr[16], sli[16];
#define S5_SCAN_A(lbuf) do { float sr = 0.f, si = 0.f; \
        _Pragma("unroll") for (int k = 0; k < 16; ++k) { const f32x2 v = *(const LAS f32x2*)(BU + (sub * 16 + k) * 132 + 2 * p); S5_STEP1(sr, si, v.x, v.y); slr[k] = sr; sli[k] = si; } \
        if (sub < 7) Lc[(lbuf) * 448 + sub * 64 + p] = (f32x2){sr, si}; } while (0)
#define S5_CARRY_B(cur_, ch_) do { const f32x2 q0 = Ic[(cur_) * 64 + p]; float qr = q0.x, qi = q0.y; \
        _Pragma("unroll") for (int k2 = 0; k2 < 7; ++k2) { const f32x2 l_ = Lc[(cur_) * 448 + k2 * 64 + p]; const float nr_ = fmaf(pwr[15], qr, fmaf(-pwi[15], qi, l_.x)), ni_ = fmaf(pwr[15], qi, fmaf(pwi[15], qr, l_.y)); qr = (k2 < sub) ? nr_ : qr; qi = (k2 < sub) ? ni_ : qi; } \
        float sr = 0.f, si = 0.f; \
        _Pragma("unroll") for (int k = 0; k < 16; ++k) { const int t = sub * 16 + k; sr = fmaf(pwr[k], qr, fmaf(-pwi[k], qi, slr[k])); si = fmaf(pwr[k], qi, fmaf(pwi[k], qr, sli[k])); \
            *(LAS unsigned*)(S16 + t * 136 + 2 * p) = pk2(sr, si); } \
        if (sub == 7) { Ic[((cur_) ^ 1) * 64 + p] = (f32x2){sr, si}; \
            if ((ch_) == 31) { C.out[O_CREP + (size_t)(bi * 32 + g) * 64 + p] = sr; C.out[O_CIMP + (size_t)(bi * 32 + g) * 64 + p] = si; } } } while (0)
        S5_LOAD(0, 0); S5_LOAD(1, 1); S5_LOAD(2, 2); S5_LOAD(3, 3);
        S5_PUT_U(0, 0); S5_PUT_U(1, 1);
        S5_LOAD(0, 4); S5_LOAD(1, 5);
        WAVE_LDS();
        S5_BP(0);
        WAVE_LDS();
#pragma unroll 1
        for (int c4 = 0; c4 < 32; c4 += 4) {
#define S5_STEP(J_) do { const int ch = c4 + (J_); constexpr int cur = (J_) & 1; \
            S5_SCAN_A(cur); \
            if (ch + 1 < 32) { S5_BP(cur ^ 1); } \
            LDS_BAR(); \
            S5_CARRY_B(cur, ch); \
            WAVE_LDS(); \
            S5_CP(cur, gbase + (size_t)ch * 128); \
            if (ch + 2 < 32) S5_PUT_U(cur, ((J_) + 2) & 3); \
            if (ch + 6 < 32) S5_LOAD(((J_) + 2) & 3, ch + 6); \
            } while (0)
            S5_STEP(0); S5_STEP(1); S5_STEP(2); S5_STEP(3);
#undef S5_STEP
        }
#undef S5_SCAN_A
#undef S5_CARRY_B
    }
    LDS_BAR();
#undef S5_STEP1
#undef S5_BP
#undef S5_CP
#undef S5_PUT_U
#undef S5_LOAD
#undef WAVE_LDS
}

template <bool SAMPLE>
__device__ __forceinline__ void conf_item(const Args& A, Ctx& C, int bi, int tb) {
    constexpr int NT = SAMPLE ? 8 : 16, NI = NT + 30;
    LAS float* L = (LAS float*)(C.lds);
    LAS float* Cc = (LAS float*)(C.lds + 94208);
    const int c = C.tid;
    float w[31];
#pragma unroll
    for (int k = 0; k < 31; ++k) w[k] = INF(I_DCW)[k * 512 + c];
    const float cb = INF(I_DCB)[c];
    const int t0 = tb * 16;
#pragma unroll
    for (int e0 = 0; e0 < NI * 128; e0 += NTHR) { const int e = e0 + C.tid; if (e >= NI * 128) break; const int i = e >> 7, q4 = (e & 127) * 4; f32x4 v;
        if (!SAMPLE) { v = (f32x4){0.f, 0.f, 0.f, 0.f}; }
        else { if (i < 30) { v = *(const f32x4*)(INF(I_SCD) + (size_t)(bi * 30 + i) * 512 + q4); if (i >= 8) *(f32x4*)(C.out + O_CDS + (size_t)(bi * 30 + (i - 8)) * 512 + q4) = v; }
            else { const u32x2 w = *(const u32x2*)(P_GG + (size_t)(MP + bi * 8 + (i - 30)) * 512 + q4); v = (f32x4){__uint_as_float(w.x << 16), __uint_as_float(w.x & 0xffff0000u), __uint_as_float(w.y << 16), __uint_as_float(w.y & 0xffff0000u)}; } }
        *(LAS f32x4*)(L + i * 512 + q4) = v; }
    LDS_BAR();
#pragma unroll 1
    for (int t = 0; t < NT; t += 2) { float a0 = cb, a1 = cb; const LAS float* lp = L + t * 512 + c;
#pragma unroll
        for (int k = 0; k < 32; ++k) { const float x = lp[k * 512]; if (k < 31) a0 += w[k] * x; if (k >= 1) a1 += w[k - 1] * x; }
        Cc[t * 512 + c] = a0; Cc[(t + 1) * 512 + c] = a1; }
    LDS_BAR();
    { const int lane = C.lane; const f32x4 g0 = *(const f32x4*)(INF(I_DLNG) + lane * 8), g1 = *(const f32x4*)(INF(I_DLNG) + lane * 8 + 4), b0 = *(const f32x4*)(INF(I_DLNB) + lane * 8), b1 = *(const f32x4*)(INF(I_DLNB) + lane * 8 + 4);
      constexpr int TPW = NT / 8;
#pragma unroll 1
      for (int k = 0; k < TPW; ++k) { const int t = C.wave * TPW + k;
          f32x4 x0 = *(const LAS f32x4*)(Cc + t * 512 + lane * 8), x1 = *(const LAS f32x4*)(Cc + t * 512 + lane * 8 + 4);
          const float mean = wave_sum((x0[0] + x0[1]) + (x0[2] + x0[3]) + (x1[0] + x1[1]) + (x1[2] + x1[3])) * (1.f / 512.f);
          x0 = x0 - mean; x1 = x1 - mean;
          const float var = wave_sum((x0[0] * x0[0] + x0[1] * x0[1]) + (x0[2] * x0[2] + x0[3] * x0[3]) + (x1[0] * x1[0] + x1[1] * x1[1]) + (x1[2] * x1[2] + x1[3] * x1[3])) * (1.f / 512.f);
          const float rs = rsqrtf(var + EPS); f32x4 o0, o1;
#pragma unroll
          for (int i = 0; i < 4; ++i) { const float y0 = x0[i] * rs * g0[i] + b0[i], y1 = x1[i] * rs * g1[i] + b1[i]; o0[i] = y0 * sigmoid_f(y0); o1[i] = y1 * sigmoid_f(y1); }
          const size_t row = SAMPLE ? (size_t)MP + bi * 8 + t : (size_t)bi * SEQ + t0 + t;
          *(v4u*)(P_MIX + row * 1024 + 512 + lane * 8) = pack8(o0, o1); } }
    LDS_BAR();
}

__device__ __forceinline__ void conf_item_p(const Args& A, Ctx& C, int bi, int tb) {
    constexpr int NT = 32, NI = NT + 30;
    LAS bf16* L = (LAS bf16*)(C.lds);
    LAS float* Cc = (LAS float*)(C.lds + 65536);
    const int cp = C.tid & 255, th = C.tid >> 8;
    const int t0 = tb * NT;
    { const bf16* gb_ = P_GG + (size_t)bi * SEQ * 512; asm volatile("" : "+s"(gb_));
#pragma unroll
      for (int e0 = 0; e0 < NI * 64; e0 += NTHR) { const int e = e0 + C.tid; if (e >= NI * 64) break; const int i = e >> 6, q8 = (e & 63) * 8; const int tk = t0 - 30 + i;
        v4u v = *(const v4u*)(gb_ + (unsigned)((tk < 0 ? 0 : tk) * 512 + q8)); if (tk < 0) v = (v4u){0u, 0u, 0u, 0u};
        *(LAS v4u*)(L + e * 8) = v; } }
    f32x2 wv[31];
#pragma unroll
    for (int k = 0; k < 31; ++k) wv[k] = *(const f32x2*)(INF(I_DCW) + k * 512 + 2 * cp);
    const f32x2 cb = *(const f32x2*)(INF(I_DCB) + 2 * cp);
    LDS_BAR();
#pragma unroll 1
    for (int r = 0; r < 2; ++r) { f32x2 a[8];
#pragma unroll
        for (int t = 0; t < 8; ++t) a[t] = cb;
        const LAS bf16* lp = L + (th * 16 + r * 8) * 512 + 2 * cp;
#pragma unroll
        for (int j = 0; j < 38; ++j) { const unsigned xb = *(const LAS unsigned*)(lp + j * 512); const f32x2 x = {__uint_as_float(xb << 16), __uint_as_float(xb & 0xffff0000u)};
#pragma unroll
            for (int t = 0; t < 8; ++t) if (j - t >= 0 && j - t <= 30) a[t] = __builtin_elementwise_fma(wv[j - t], x, a[t]); }
#pragma unroll
        for (int t = 0; t < 8; ++t) *(LAS f32x2*)(Cc + (th * 16 + r * 8 + t) * 512 + 2 * cp) = a[t]; }
    LDS_BAR();
    { const int lane = C.lane; const f32x4 g0 = *(const f32x4*)(INF(I_DLNG) + lane * 8), g1 = *(const f32x4*)(INF(I_DLNG) + lane * 8 + 4), b0 = *(const f32x4*)(INF(I_DLNB) + lane * 8), b1 = *(const f32x4*)(INF(I_DLNB) + lane * 8 + 4);
#pragma unroll 1
      for (int k = 0; k < NT / 8; ++k) { const int t = C.wave * (NT / 8) + k;
          f32x4 x0 = *(const LAS f32x4*)(Cc + t * 512 + lane * 8), x1 = *(const LAS f32x4*)(Cc + t * 512 + lane * 8 + 4);
          const float mean = wave_sum((x0[0] + x0[1]) + (x0[2] + x0[3]) + (x1[0] + x1[1]) + (x1[2] + x1[3])) * (1.f / 512.f);
          x0 = x0 - mean; x1 = x1 - mean;
          const float var = wave_sum((x0[0] * x0[0] + x0[1] * x0[1]) + (x0[2] * x0[2] + x0[3] * x0[3]) + (x1[0] * x1[0] + x1[1] * x1[1]) + (x1[2] * x1[2] + x1[3] * x1[3])) * (1.f / 512.f);
          const float rs = rsqrtf(var + EPS); f32x4 o0, o1;
#pragma unroll
          for (int i = 0; i < 4; ++i) { const float y0 = x0[i] * rs * g0[i] + b0[i], y1 = x1[i] * rs * g1[i] + b1[i]; o0[i] = y0 * sigmoid_f(y0); o1[i] = y1 * sigmoid_f(y1); }
          const size_t row = (size_t)bi * SEQ + t0 + t;
          *(v4u*)(P_MIX + row * 1024 + 512 + lane * 8) = pack8(o0, o1); } }
    LDS_BAR();
}

#ifndef MK_N_LAUNCHES
#define MK_N_LAUNCHES 1
#endif
constexpr int N_PHASES = 17;
constexpr int N_LAUNCHES = MK_N_LAUNCHES;
static_assert(N_LAUNCHES == 1 || N_LAUNCHES == N_PHASES, "MK_N_LAUNCHES is 1 or 17");
#ifndef MK_GRP_A
#define MK_GRP_A 4
#endif

#define Q_LOOP(cw, N, var, ...) do { for (;;) { __syncthreads(); if (C.tid == 0) C.MISC[16] = __hip_atomic_fetch_add(C.ctl + (cw), 1u, RLX_AGENT); __syncthreads(); \
            const int var = (int)__builtin_amdgcn_readfirstlane(C.MISC[16]); if (var >= (N)) break; \
            __VA_ARGS__ } } while (0)

template <int LO, int HI> __global__ void __launch_bounds__(NTHR, 2) mega_fwd(Args args) {
    extern __shared__ __attribute__((aligned(16))) unsigned char lds[];
    const Args& A = args;
    Ctx C;
    C.lds = (LAS unsigned char*)lds; C.MISC = (volatile LAS unsigned*)(C.lds + MISC_OFF);
    C.tid = threadIdx.x; C.lane = C.tid & 63; C.wave = __builtin_amdgcn_readfirstlane(C.tid >> 6);
    C.G = gridDim.x; { const int bx = blockIdx.x; C.vcu = (C.G % 8 == 0) ? (bx % 8) * (C.G / 8) + bx / 8 : bx; }
    GAS unsigned char* ws = (GAS unsigned char*)args.ws; C.ws = ws; C.out = (GAS float*)args.out; C.ctl = (gu32*)(ws + WS_CTL);
    for (int u = C.tid; u < (LDS_BYTES - LDSCTL_OFF) / 4; u += NTHR) ((LAS unsigned*)(C.lds + LDSCTL_OFF))[u] = 0u;
    __syncthreads();
    XcdBarrier bar; bar.bar = (unsigned*)(C.ctl + CW_BAR); bar.x = 0; bar.st = nullptr;
    if (HI - LO > 1) bar = xcd_barrier_post((unsigned*)(C.ctl + CW_BAR), C.MISC + 8);
#define IN(k) (LO <= (k) && (k) < HI)
#define PH(k) if (IN(k))
#define END_PH(k) do { if (IN(k) && IN((k) + 1)) xcd_barrier(bar); } while (0)
    LAS unsigned char* ring = C.lds + RING_OFF;
    GAS float* X = C.out;
#define PHASE_BEGIN() do { int t_ = threadIdx.x; asm volatile("" : "+v"(t_)); C.tid = t_; C.lane = t_ & 63; C.wave = __builtin_amdgcn_readfirstlane(t_ >> 6); \
        unsigned char* w_ = args.ws; asm volatile("" : "+s"(w_)); C.ws = (GAS unsigned char*)w_; ws = C.ws; C.ctl = (gu32*)C.ws; float* o_ = args.out; asm volatile("" : "+s"(o_)); C.out = (GAS float*)o_; X = C.out; } while (0)

    PH(0) { PHASE_BEGIN(); p0_prologue(args, C); END_PH(0); }

#define FFN_UP(ph, mi, cslot) PH(ph) { PHASE_BEGIN(); pg8::Gemm g{P_XB, (const bf16*)(GAS bf16*)(ws + WS_WGU + (mi) * WGU_BYTES), MT, NGU, 1024}; pg8::StaticOrder S; S.init(MT, NGU, C.G, (int)blockIdx.x); \
        LAS float* tab_ = (LAS float*)(C.lds + RSTAB_OFF); rstd_table_fill(tab_, P_SS, S, C.tid); EpiSwiGLU E{P_H, tab_}; pg8::gemm_phase<EpiSwiGLU, pg8::StaticOrder, true, true>(ring, g, S, E); \
        if ((cslot) >= 0) { const int nwg_ = (MT / 256) * (NGU / 256), rounds_ = (nwg_ + C.G - 1) / C.G, first_idle_ = nwg_ - (rounds_ - 1) * C.G;     \
            if ((int)blockIdx.x >= first_idle_) { PHASE_BEGIN(); conv_run<((cslot) < 0 ? 1 : (cslot))>(args, C, ((int)blockIdx.x - first_idle_) * NWAVES + C.wave, (C.G - first_idle_) * NWAVES); } } \
        END_PH(ph); }
#define GEMM_RESID(ph, Aptr, KK, Wptr, scale, wxb, XinP, XinS) PH(ph) { PHASE_BEGIN(); pg8::Gemm g{Aptr, Wptr, MP, 1024, KK}; pg8::StaticOrder S; S.init(MP, 1024, C.G, (int)blockIdx.x); \
        EpiResid E{XinP, X, P_XB, P_SS, scale, 1.f / (scale), wxb}; pg8::gemm_phase<EpiResid, pg8::StaticOrder, true, true>(ring, g, S, E); \
        gemm_small_resid<KK>((Aptr) + (size_t)MP * (KK), Wptr, XinS, X + (size_t)MP * 1024, P_XB + (size_t)MP * 1024, P_SS + (size_t)MP * 16, scale, (wxb) != 0, ring, C.G, (int)blockIdx.x, C.tid); \
        END_PH(ph); }

    FFN_UP(1, 0, 1)
    GEMM_RESID(2, P_H, FFP, (const bf16*)(GAS bf16*)(ws + WS_WDN + 0 * WDN_BYTES), 0.5f, 1, (const GAS float*)args.in[I_XP], (const GAS float*)args.in[I_XS])
    PH(3) { PHASE_BEGIN(); pg8::Gemm g{P_XB, (const bf16*)(GAS bf16*)(ws + WS_WIE), MT, NIE, 1024}; pg8::StaticOrder S; S.init(MT, NIE, C.G, (int)blockIdx.x);
        LAS float* tab_ = (LAS float*)(C.lds + RSTAB_OFF); rstd_table_fill(tab_, P_SS, S, C.tid);
        EpiInEven E{P_Q, P_K, P_V, P_XBF, P_GBF, (float*)(C.out + O_KP), (float*)(C.out + O_VP), (float*)(C.out + O_KS), (float*)(C.out + O_VS), tab_, INF(I_AQG), INF(I_AKG)};
        pg8::gemm_phase<EpiInEven, pg8::StaticOrder, true, true>(ring, g, S, E); END_PH(3); }
    PH(4) {
        const bool grp_a = (int)((blockIdx.x >> 3) & 7) < MK_GRP_A;
#pragma unroll 1
        for (int pass = 0; pass < 2; ++pass) {
            PHASE_BEGIN();
            if (pass == 1 || grp_a) Q_LOOP(CW_Q0 + 128, 256, a, sattn_wave(args, C, a >> 3, (a >> 1) & 3, (a & 1) * 8 + C.wave););
            if (pass == 0) {
                PHASE_BEGIN();
                Q_LOOP(CW_Q0 + 192, 16, a, rglru_item<true>(args, C, a & 1, 0, a >> 1););
                PHASE_BEGIN();
                Q_LOOP(CW_Q0, 1024, it, rglru_item<false>(args, C, it >> 8, (it >> 3) & 31, it & 7););
                PHASE_BEGIN();
                Q_LOOP(CW_Q0 + 64, 1024, a, { const int qb = 15 - (a >> 6), b = (a & 63) >> 4, vh = a & 15, h = vh >> 2, j = (vh >> 1) & 1, half = vh & 1;
                    attn_body::attn_unit<8>(b, (h * 2 + j) * 64, h * 128 + half * 64, j * 512 + h * 128 + half * 64, qb, (const attn_body::bf16*)P_Q, (const attn_body::bf16*)P_K, (const attn_body::bf16*)P_V, (attn_body::bf16*)P_O2, (char*)lds + RING_OFF); });
            }
        }
        END_PH(4);
    }
    PH(5) { PHASE_BEGIN(); p5_combine(args, C); END_PH(5); }
    GEMM_RESID(6, P_MIX, 1024, (const bf16*)(GAS bf16*)(ws + WS_WOE), 1.0f, 1, (const GAS float*)X, (const GAS float*)(X + (size_t)MP * 1024))
    FFN_UP(7, 1, 2)
    GEMM_RESID(8, P_H, FFP, (const bf16*)(GAS bf16*)(ws + WS_WDN + 1 * WDN_BYTES), 0.5f, 1, (const GAS float*)X, (const GAS float*)(X + (size_t)MP * 1024))

    FFN_UP(9, 2, 3)
    GEMM_RESID(10, P_H, FFP, (const bf16*)(GAS bf16*)(ws + WS_WDN + 2 * WDN_BYTES), 0.5f, 1, (const GAS float*)X, (const GAS float*)(X + (size_t)MP * 1024))
    PH(11) { PHASE_BEGIN(); pg8::Gemm g{P_XB, (const bf16*)(GAS bf16*)(ws + WS_WIO), MT, NIO, 1024}; pg8::StaticOrder S; S.init(MT, NIO, C.G, (int)blockIdx.x);
        LAS float* tab_ = (LAS float*)(C.lds + RSTAB_OFF); rstd_table_fill(tab_, P_SS, S, C.tid); EpiInOdd E{P_U, P_GG, tab_, (float*)(C.out + O_CDP), (float*)(C.out + O_CDS)}; pg8::gemm_phase<EpiInOdd, pg8::StaticOrder, true, true>(ring, g, S, E); END_PH(11); }
    PH(12) {
        PHASE_BEGIN();
        Q_LOOP(CW_Q1, 128, it, s5_item<false>(args, C, it >> 5, it & 31););
        PHASE_BEGIN();
        Q_LOOP(CW_Q1 + 64, 64, a, s5_item<true>(args, C, a & 1, a >> 1););
        PHASE_BEGIN();
        Q_LOOP(CW_Q1 + 192, 32, a, conf_item<true>(args, C, a, 0););
        PHASE_BEGIN();
        Q_LOOP(CW_Q1 + 128, 512, a, conf_item_p(args, C, a >> 7, a & 127););
        END_PH(12);
    }
    PH(13) { PHASE_BEGIN(); pg8::Gemm g{P_Z, (const bf16*)(GAS bf16*)(ws + WS_WGLU), MT, 512, 512}; pg8::StaticOrder S; S.init(MT, 512, C.G, (int)blockIdx.x);
        EpiGLU E{P_Z, P_MIX, INF(I_CGLUB)}; pg8::gemm_phase<EpiGLU, pg8::StaticOrder, true, true>(ring, g, S, E); END_PH(13); }
    GEMM_RESID(14, P_MIX, 1024, (const bf16*)(GAS bf16*)(ws + WS_WOO), 1.0f, 1, (const GAS float*)X, (const GAS float*)(X + (size_t)MP * 1024))
    FFN_UP(15, 3, -1)
    GEMM_RESID(16, P_H, FFP, (const bf16*)(GAS bf16*)(ws + WS_WDN + 3 * WDN_BYTES), 0.5f, 0, (const GAS float*)X, (const GAS float*)(X + (size_t)MP * 1024))
#undef IN
#undef PH
#undef END_PH
#undef PHASE_BEGIN
#undef FFN_UP
#undef GEMM_RESID
}

template <int K> static bool setup_one() {
    int per_cu = 0;
    if (hipFuncSetAttribute((const void*)mega_fwd<K, (N_LAUNCHES == 1 ? N_PHASES : K + 1)>, hipFuncAttributeMaxDynamicSharedMemorySize, LDS_BYTES) != hipSuccess) { fprintf(stderr, "kernel_launch: hipFuncSetAttribute failed\n"); return false; }
    if (hipOccupancyMaxActiveBlocksPerMultiprocessor(&per_cu, (const void*)mega_fwd<K, (N_LAUNCHES == 1 ? N_PHASES : K + 1)>, NTHR, LDS_BYTES) != hipSuccess || per_cu < 1) fprintf(stderr, "kernel_launch: occupancy query reports %d workgroups per CU\n", per_cu);
    return true;
}
template <int K> static void launch_one(int grid, const Args& a, hipStream_t stream) {
    hipLaunchKernelGGL((mega_fwd<K, (N_LAUNCHES == 1 ? N_PHASES : K + 1)>), dim3(grid), dim3(NTHR), LDS_BYTES, stream, a);
    const hipError_t le = hipPeekAtLastError();
    if (le != hipSuccess) fprintf(stderr, "kernel_launch: launch %d failed: %s\n", K, hipGetErrorName(le));
}
template <int K> struct Seq {
    static bool setup() { if (!setup_one<K>()) return false; if (N_LAUNCHES == 1) return true; return Seq<K + 1>::setup(); }
    static void launch(int grid, const Args& a, hipStream_t stream) { launch_one<K>(grid, a, stream); if (N_LAUNCHES != 1) Seq<K + 1>::launch(grid, a, stream); }
};
template <> struct Seq<(N_LAUNCHES == 1 ? 1 : N_PHASES)> { static bool setup() { return true; } static void launch(int, const Args&, hipStream_t) {} };
static bool setup_all() { return Seq<0>::setup(); }
static void launch_all(int grid, const Args& a, hipStream_t stream) { Seq<0>::launch(grid, a, stream); }
extern "C" void kernel_launch(void* const* d_in, const int* in_sizes, int n_in, void* d_out, int out_size, void* d_ws, size_t ws_size, hipStream_t stream) {
    static int grid = 0;
    if (grid == 0) {
        if (n_in != 44 || out_size != (int)O_END || ws_size < WS_END) { fprintf(stderr, "kernel_launch: unexpected shapes: n_in %d out %d ws %zu; nothing launched\n", n_in, out_size, ws_size); grid = -1; return; }
        int dev = 0, cus = 0, per_cu = 0;
        if (hipGetDevice(&dev) != hipSuccess || hipDeviceGetAttribute(&cus, hipDeviceAttributeMultiprocessorCount, dev) != hipSuccess) { fprintf(stderr, "kernel_launch: device query failed\n"); grid = -1; return; }
        if (!setup_all()) { grid = -1; return; }
        (void)hipGetLastError();
        grid = cus;
    }
    if (grid < 0) return;
    if (hipMemsetAsync((char*)d_ws + WS_CTL, 0, CTL_ZERO_BYTES, stream) != hipSuccess) { fprintf(stderr, "kernel_launch: memset failed\n"); return; }
    Args a{};
    for (int i = 0; i < 44; ++i) a.in[i] = d_in[i];
    a.out = (float*)d_out; a.ws = (unsigned char*)d_ws;
    launch_all(grid, a, stream);
}
```

```cpp
#ifndef MK_N_LAUNCHES
#define MK_N_LAUNCHES 1
#endif
#include <hip/hip_runtime.h>
#include <cstdio>
#include <cstdint>
namespace pg8 {
#define PG8_LAS __attribute__((address_space(3)))
typedef unsigned short bf16_t;
typedef short bf16x8 __attribute__((ext_vector_type(8)));
typedef float f32x4 __attribute__((ext_vector_type(4)));
typedef unsigned u32x4 __attribute__((ext_vector_type(4)));
constexpr int BM = 256, BK = 64, HALF = 128, HTB = HALF * BK * 2  , STAGE_BYTES = 8 * HTB, NXCD = 8, WGM = 8;

__host__ __device__ __forceinline__ int lds_byte(int r, int c) { const int st = (r >> 4) * 2 + (c >> 5), rr = r & 15, cc = c & 31, ob = rr * 64 + cc * 2; return st * 1024 + (ob ^ (((ob >> 9) & 1) << 5)); }
__host__ __device__ __forceinline__ void stage_rc(int b, int& R, int& C) { const int st = b / 1024, sb = b % 1024, swz = sb ^ (((sb >> 9) & 1) << 5); R = (st >> 1) * 16 + swz / 64; C = (st & 1) * 32 + (swz % 64) / 2; }
__host__ __device__ __forceinline__ int perm32(int rho) { const int n = rho >> 4, i = rho & 15; return 8 * (i >> 2) + 4 * n + (i & 3); }

struct Unit { int pm, pn; };
struct Gemm { const bf16_t* A; const bf16_t* Bt; int M, N, K; };

struct StaticOrder {
    int nM, nN, nwg, G, c;
    __host__ __device__ void init(int M, int N, int G_, int c_) { nM = M / BM; nN = N / BM; nwg = nM * nN; G = G_; c = c_; }
    __host__ __device__ bool next(int i, Unit& u) const {
        const long L = (long)i * G + c; if (L >= nwg) return false;
        int wgid = (int)L; { const int q = nwg / NXCD, r = nwg % NXCD, xcd = wgid % NXCD, off = wgid / NXCD; wgid = (xcd < r ? xcd * (q + 1) : r * (q + 1) + (xcd - r) * q) + off; }
        const int nig = WGM * nN, gid = wgid / nig, fm = gid * WGM, gsz = (nM - fm) < WGM ? (nM - fm) : WGM;
        u.pm = fm + ((wgid % nig) % gsz); u.pn = (wgid % nig) / gsz; return true;
    }
    __device__ __forceinline__ void a_ready(const Unit&) const {}
    __device__ __forceinline__ void done(const Unit&) const {}
};

__device__ __forceinline__ unsigned cvt_pk_bf16(float lo, float hi) { unsigned r; asm volatile("v_cvt_pk_bf16_f32 %0, %1, %2" : "=v"(r) : "v"(lo), "v"(hi)); return r; }
typedef float f32x2 __attribute__((ext_vector_type(2)));
template <class Epi, class Sched, bool ALIGN_EPI = false, bool SP2 = false>
__device__ __forceinline__ void gemm_phase(PG8_LAS unsigned char* lds, const Gemm g, const Sched& S, const Epi& E) {
    int tid_ = threadIdx.x; asm volatile("" : "+v"(tid_));
    const int tid = tid_, wid = __builtin_amdgcn_readfirstlane(tid >> 6), lane = tid & 63, wr = wid >> 2, wc = wid & 3, fr = lane & 15, fq = lane >> 4;
    const int K = g.K, nt = K / BK;
    unsigned voffA[2], voffB[2];
#pragma unroll
    for (int i = 0; i < 2; ++i) { int R, C; stage_rc(tid * 16 + i * 8192, R, C); const int Rb = Epi::PERM ? ((R & ~31) + perm32(R & 31)) : R;
        voffA[i] = (unsigned)(R * K + C) * 2u; voffB[i] = (unsigned)(Rb * K + C) * 2u; }
    const size_t kstep = (size_t)(BK * 2);
    const size_t hstep = (size_t)HALF * K * 2;
    const size_t tstep = 2 * hstep;
    const unsigned ldsw = (unsigned)wid * 1024u;
    const int aoff = lds_byte(wr * 64 + fr, fq * 8), boff = lds_byte(wc * 32 + fr, fq * 8);
#define PG8_SA(b, h) (((b) * 2 + (h)) * HTB)
#define PG8_SB(b, h) ((4 + (b) * 2 + (h)) * HTB)
#define PG8_STAGE(bufoff, gbase, voff) do { _Pragma("unroll") for (int _i = 0; _i < 2; ++_i) \
        __builtin_amdgcn_global_load_lds((const unsigned*)((const char*)(gbase) + (voff)[_i]), (PG8_LAS unsigned*)(lds + (bufoff) + ldsw + _i * 8192), 16, 0, 0); } while (0)
#define PG8_LDA(dst, b, h) do { _Pragma("unroll") for (int m = 0; m < 4; ++m) _Pragma("unroll") for (int k = 0; k < 2; ++k) dst[m][k] = *(const PG8_LAS bf16x8*)(lds + PG8_SA(b, h) + aoff + m * 2048 + k * 1024); } while (0)
#define PG8_LDB(dst, b, h) do { _Pragma("unroll") for (int n = 0; n < 2; ++n) _Pragma("unroll") for (int k = 0; k < 2; ++k) dst[n][k] = *(const PG8_LAS bf16x8*)(lds + PG8_SB(b, h) + boff + n * 2048 + k * 1024); } while (0)
#define PG8_MMA(ai, bj, At, Bt) do { __builtin_amdgcn_s_setprio(1); _Pragma("unroll") for (int m = 0; m < 4; ++m) _Pragma("unroll") for (int n = 0; n < 2; ++n) _Pragma("unroll") for (int k = 0; k < 2; ++k) \
        acc[ai][bj][m][n] = __builtin_amdgcn_mfma_f32_16x16x32_bf16(Bt[n][k], At[m][k], acc[ai][bj][m][n], 0, 0, 0); __builtin_amdgcn_s_setprio(0); } while (0)
#define PG8_WAIT_V(n) asm volatile("s_waitcnt vmcnt(" #n ")" ::: "memory")
#define PG8_WAIT_L(n) asm volatile("s_waitcnt lgkmcnt(" #n ")" ::: "memory")
#define PG8_BAR __builtin_amdgcn_s_barrier()
#define PG8_SCHED __builtin_amdgcn_sched_barrier(0)
    Unit cur, nxt; int ui = 0;
    if (!S.next(0, cur)) return;
    f32x4 acc[2][2][4][2];
#pragma unroll
    for (int a = 0; a < 2; ++a)
#pragma unroll
        for (int b = 0; b < 2; ++b)
#pragma unroll
            for (int m = 0; m < 4; ++m)
#pragma unroll
                for (int n = 0; n < 2; ++n) acc[a][b][m][n] = (f32x4){0.f, 0.f, 0.f, 0.f};
    if constexpr (Epi::INIT_ACC) E.init(acc, cur, wr, wc, fr, fq);
    bf16x8 At[4][2], B0[2][2], B1[2][2];
    const char* cA = (const char*)g.A + (size_t)cur.pm * tstep; const char* cB = (const char*)g.Bt + (size_t)cur.pn * tstep;
    S.a_ready(cur);
    if constexpr (SP2) {
        PG8_STAGE(PG8_SB(0, 0), cB, voffB); PG8_STAGE(PG8_SB(0, 1), cB + hstep, voffB); PG8_STAGE(PG8_SA(0, 0), cA, voffA); PG8_STAGE(PG8_SA(0, 1), cA + hstep, voffA);
        if (wr == 1) PG8_BAR;
        PG8_WAIT_V(2); PG8_BAR;
        PG8_STAGE(PG8_SB(1, 0), cB + kstep, voffB); PG8_STAGE(PG8_SA(1, 0), cA + kstep, voffA); PG8_STAGE(PG8_SB(1, 1), cB + hstep + kstep, voffB);
        PG8_WAIT_V(6); PG8_BAR;
    } else {
        PG8_STAGE(PG8_SB(0, 0), cB, voffB); PG8_STAGE(PG8_SA(0, 0), cA, voffA); PG8_STAGE(PG8_SB(0, 1), cB + hstep, voffB); PG8_STAGE(PG8_SA(0, 1), cA + hstep, voffA);
        if (wr == 1) PG8_BAR;
        PG8_WAIT_V(4); PG8_BAR;
        PG8_STAGE(PG8_SB(1, 0), cB + kstep, voffB); PG8_STAGE(PG8_SA(1, 0), cA + kstep, voffA); PG8_STAGE(PG8_SB(1, 1), cB + hstep + kstep, voffB);
        PG8_WAIT_V(6); PG8_BAR;
    }
    for (;;) {
        const bool has_next = S.next(ui + 1, nxt);
        const char* nA = has_next ? (const char*)g.A + (size_t)nxt.pm * tstep : cA; const char* nB = has_next ? (const char*)g.Bt + (size_t)nxt.pn * tstep : cB;
        for (int t = 0; t < nt; t += 2) {
            const bool last = (t == nt - 2);
            const char* a1 = cA + (size_t)(t + 1) * kstep;
            const char* a2 = last ? nA : cA + (size_t)(t + 2) * kstep; const char* b2 = last ? nB : cB + (size_t)(t + 2) * kstep;
            const char* a3 = a2 + kstep; const char* b3 = b2 + kstep;
            if (last && has_next) S.a_ready(nxt);
            if constexpr (SP2) {
            PG8_LDB(B0, 0, 0); PG8_LDB(B1, 0, 1); PG8_SCHED; PG8_LDA(At, 0, 0); PG8_STAGE(PG8_SA(1, 1), a1 + hstep, voffA);
            PG8_WAIT_V(8); PG8_WAIT_L(0); PG8_BAR; PG8_MMA(0, 0, At, B0); PG8_MMA(0, 1, At, B1); PG8_BAR; PG8_SCHED;
            PG8_LDA(At, 0, 1); PG8_STAGE(PG8_SB(0, 0), b2, voffB); PG8_STAGE(PG8_SB(0, 1), b2 + hstep, voffB); PG8_STAGE(PG8_SA(0, 0), a2, voffA);
            PG8_WAIT_V(8); PG8_WAIT_L(0); PG8_BAR; PG8_MMA(1, 0, At, B0); PG8_MMA(1, 1, At, B1); PG8_BAR; PG8_SCHED;
            PG8_LDB(B0, 1, 0); PG8_LDB(B1, 1, 1); PG8_SCHED; PG8_LDA(At, 1, 0); PG8_STAGE(PG8_SA(0, 1), a2 + hstep, voffA);
            PG8_WAIT_V(8); PG8_WAIT_L(0); PG8_BAR; PG8_MMA(0, 0, At, B0); PG8_MMA(0, 1, At, B1); PG8_BAR; PG8_SCHED;
            PG8_LDA(At, 1, 1); PG8_STAGE(PG8_SB(1, 0), b3, voffB); PG8_STAGE(PG8_SB(1, 1), b3 + hstep, voffB); PG8_STAGE(PG8_SA(1, 0), a3, voffA);
            PG8_WAIT_V(8); PG8_WAIT_L(0); PG8_BAR; PG8_MMA(1, 0, At, B0); PG8_MMA(1, 1, At, B1); PG8_BAR; PG8_SCHED;
            } else {
            PG8_LDB(B0, 0, 0); PG8_SCHED; PG8_LDA(At, 0, 0); PG8_STAGE(PG8_SA(1, 1), a1 + hstep, voffA);
            PG8_WAIT_L(8); PG8_BAR; PG8_WAIT_L(0); PG8_MMA(0, 0, At, B0); PG8_BAR; PG8_SCHED;
            PG8_LDB(B1, 0, 1); PG8_STAGE(PG8_SB(0, 0), b2, voffB);
            PG8_BAR; PG8_WAIT_L(0); PG8_MMA(0, 1, At, B1); PG8_BAR;
            PG8_LDA(At, 0, 1); PG8_STAGE(PG8_SA(0, 0), a2, voffA);
            PG8_BAR; PG8_WAIT_L(0); PG8_MMA(1, 0, At, B0); PG8_BAR; PG8_SCHED;
            PG8_STAGE(PG8_SB(0, 1), b2 + hstep, voffB);
            PG8_WAIT_V(6); PG8_BAR; PG8_MMA(1, 1, At, B1); PG8_BAR;
            PG8_LDB(B0, 1, 0); PG8_SCHED; PG8_LDA(At, 1, 0); PG8_STAGE(PG8_SA(0, 1), a2 + hstep, voffA);
            PG8_WAIT_L(8); PG8_BAR; PG8_WAIT_L(0); PG8_MMA(0, 0, At, B0); PG8_BAR; PG8_SCHED;
            PG8_LDB(B1, 1, 1); PG8_STAGE(PG8_SB(1, 0), b3, voffB);
            PG8_BAR; PG8_WAIT_L(0); PG8_MMA(0, 1, At, B1); PG8_BAR;
            PG8_LDA(At, 1, 1); PG8_STAGE(PG8_SA(1, 0), a3, voffA);
            PG8_BAR; PG8_WAIT_L(0); PG8_MMA(1, 0, At, B0); PG8_BAR; PG8_SCHED;
            PG8_STAGE(PG8_SB(1, 1), b3 + hstep, voffB);
            PG8_WAIT_V(6); PG8_BAR; PG8_MMA(1, 1, At, B1); PG8_BAR;
            }
        }
        if constexpr (ALIGN_EPI) { if (wr == 0) PG8_BAR; }
        if constexpr (!Epi::AFTER_DRAIN) { E(acc, cur, wr, wc, fr, fq, ui); S.done(cur); }
        if (!has_next) break;
#pragma unroll
        for (int a = 0; a < 2; ++a)
#pragma unroll
            for (int b = 0; b < 2; ++b)
#pragma unroll
                for (int m = 0; m < 4; ++m)
#pragma unroll
                    for (int n = 0; n < 2; ++n) acc[a][b][m][n] = (f32x4){0.f, 0.f, 0.f, 0.f};
        if constexpr (Epi::INIT_ACC) E.init(acc, nxt, wr, wc, fr, fq);
        cur = nxt; cA = nA; cB = nB; ++ui;
        if constexpr (ALIGN_EPI) { if (wr == 1) PG8_BAR; }
    }
    PG8_WAIT_V(0);
    if constexpr (!ALIGN_EPI) { if (wr == 0) PG8_BAR; }
    PG8_BAR;
    if constexpr (Epi::AFTER_DRAIN) { E.fused(acc, cur, wr, wc, fr, fq, lds, wid, lane); S.done(cur); }
#undef PG8_SA
#undef PG8_SB
#undef PG8_STAGE
#undef PG8_LDA
#undef PG8_LDB
#undef PG8_MMA
#undef PG8_WAIT_V
#undef PG8_WAIT_L
#undef PG8_BAR
#undef PG8_SCHED
}
}
#include <hip/hip_bf16.h>
#include <cmath>
#include <hip/hip_bf16.h>
#include <cmath>
namespace attn_body {
using bf16=__hip_bfloat16;
using bf16x8=__attribute__((ext_vector_type(8)))short;
using s16x4=__attribute__((ext_vector_type(4)))short;
using f32x16=__attribute__((ext_vector_type(16)))float;
using u32x4=__attribute__((ext_vector_type(4)))unsigned;
constexpr int BATCH=4,NHEAD=16,SEQ=4096,D=64,PQK=512,PV=512,PO=1024;
constexpr int NW=8,QBLK=32,QB=QBLK*NW,KVBLK=64,NQB=SEQ/QB;
constexpr int ATTN_UNIT_ROWS=QB;
__device__ __forceinline__ int crow(int r,int hi){return (r&3)+8*(r>>2)+4*hi;}
#define SBAR() __builtin_amdgcn_sched_barrier(0)
__device__ __forceinline__ void cmask(f32x16&p0,f32x16&p1,int jb,int qrel,int hi){
  const float NEG=-INFINITY; int kb=64*jb+4*hi;
  #pragma unroll
  for(int r=0;r<16;++r){int kv=kb+(r&3)+8*(r>>2); if(kv>qrel)p0[r]=NEG; if(kv+32>qrel)p1[r]=NEG;}
}

constexpr int NSLOT=3, SLOTB=8192;
constexpr int LDS_K=0, LDS_V=NSLOT*SLOTB, LDS_WS=2*NSLOT*SLOTB, LDS_OST=LDS_WS+NW*64*4, LDS_BYTES=LDS_OST+NW*4096;
constexpr float C2=0.125f*1.4426950408889634f;
__device__ __forceinline__ void glds16(const void*gsrc,unsigned lds_dst){unsigned keep;
  asm volatile("s_mov_b32 %0, m0\n\ts_mov_b32 m0, %2\n\ts_nop 0\n\tglobal_load_lds_dwordx4 %1, off\n\ts_mov_b32 m0, %0":"=&s"(keep):"v"(gsrc),"s"(lds_dst):"memory");}
__device__ __forceinline__ float max3f(float a,float b,float c){float r;asm("v_max3_f32 %0, %1, %2, %3":"=v"(r):"v"(a),"v"(b),"v"(c));return r;}
__device__ __forceinline__ float max2f(float a,float b){float r;asm("v_max_f32_e32 %0, %1, %2":"=v"(r):"v"(a),"v"(b));return r;}
__device__ __forceinline__ float fadd_s(float a,float b){float r;asm("v_add_f32_e32 %0, %1, %2":"=v"(r):"v"(a),"v"(b));return r;}
__device__ __forceinline__ float fsub_s(float a,float b){float r;asm("v_sub_f32_e32 %0, %1, %2":"=v"(r):"v"(a),"v"(b));return r;}
typedef float f32x2_t __attribute__((ext_vector_type(2))); typedef __bf16 bf16x2_t __attribute__((ext_vector_type(2)));
__device__ __forceinline__ unsigned cvtpk_s(float lo,float hi){f32x2_t v={lo,hi};bf16x2_t b=__builtin_convertvector(v,bf16x2_t);return __builtin_bit_cast(unsigned,b);}
#define WAIT_BAR(N) asm volatile("s_waitcnt vmcnt(" #N ") lgkmcnt(0)\n\ts_barrier":::"memory")

__device__ __forceinline__ void qkt(f32x16&p0,f32x16&p1,const char*Kslot,const bf16x8*qr,const f32x16&negm,int r32,int hi){
  const char*kb=Kslot+hi*1024+r32*16;
  #pragma unroll
  for(int d0=0;d0<4;++d0){
    const bf16x8 b0=*reinterpret_cast<const bf16x8*>(kb+d0*2048);
    const bf16x8 b1=*reinterpret_cast<const bf16x8*>(kb+d0*2048+512);
    if(d0==0){p0=__builtin_amdgcn_mfma_f32_32x32x16_bf16(b0,qr[0],negm,0,0,0);p1=__builtin_amdgcn_mfma_f32_32x32x16_bf16(b1,qr[0],negm,0,0,0);}
    else{p0=__builtin_amdgcn_mfma_f32_32x32x16_bf16(b0,qr[d0],p0,0,0,0);p1=__builtin_amdgcn_mfma_f32_32x32x16_bf16(b1,qr[d0],p1,0,0,0);}}
}
typedef __attribute__((address_space(3))) const char* lds_cptr;
typedef short v4i16_t __attribute__((ext_vector_type(4)));
__device__ __forceinline__ void kload8(bf16x8*kf,lds_cptr kp){
  kf[0]=*(const __attribute__((address_space(3))) bf16x8*)(kp);      kf[1]=*(const __attribute__((address_space(3))) bf16x8*)(kp+512);
  kf[2]=*(const __attribute__((address_space(3))) bf16x8*)(kp+2048); kf[3]=*(const __attribute__((address_space(3))) bf16x8*)(kp+2560);
  kf[4]=*(const __attribute__((address_space(3))) bf16x8*)(kp+4096); kf[5]=*(const __attribute__((address_space(3))) bf16x8*)(kp+4608);
  kf[6]=*(const __attribute__((address_space(3))) bf16x8*)(kp+6144); kf[7]=*(const __attribute__((address_space(3))) bf16x8*)(kp+6656);
}
__device__ __forceinline__ void kload2(bf16x8*kf,lds_cptr kp,int j){ kf[2*j]=*(const __attribute__((address_space(3))) bf16x8*)(kp+j*2048); kf[2*j+1]=*(const __attribute__((address_space(3))) bf16x8*)(kp+j*2048+512); }
__device__ __forceinline__ s16x4 vtr(lds_cptr p){ return __builtin_bit_cast(s16x4,__builtin_amdgcn_ds_read_tr16_b64_v4i16((__attribute__((address_space(3))) v4i16_t*)p)); }
__device__ __forceinline__ float rowmax(const f32x16&p0,const f32x16&p1){
  float a=max3f(p0[0],p0[1],p1[0]),b=max3f(p0[2],p0[3],p1[1]);a=max3f(a,p1[2],p1[3]);
  #pragma unroll
  for(int r=4;r<16;r+=4){a=max3f(a,p0[r],p0[r+1]);b=max3f(b,p0[r+2],p0[r+3]);a=max3f(a,p1[r],p1[r+1]);b=max3f(b,p1[r+2],p1[r+3]);}
  const float m=max2f(a,b);
  auto rr=__builtin_amdgcn_permlane32_swap(__float_as_uint(m),__float_as_uint(m),false,false);
  return max2f(__uint_as_float(rr[0]),__uint_as_float(rr[1]));
}
__device__ __forceinline__ void pv(f32x16*o,int vb,bf16x8 pa0,bf16x8 pa1,bf16x8 pa2,bf16x8 pa3){
  #pragma unroll
  for(int d0=0;d0<2;++d0){s16x4 lo[4],hi[4];
    #pragma unroll
    for(int ks=0;ks<4;++ks){
      asm volatile("ds_read_b64_tr_b16 %0,%1 offset:%c2":"=&v"(lo[ks]):"v"(vb),"i"(d0*4096+ks*1024):"memory");
      asm volatile("ds_read_b64_tr_b16 %0,%1 offset:%c2":"=&v"(hi[ks]):"v"(vb),"i"(d0*4096+ks*1024+512):"memory");}
    asm volatile("s_waitcnt lgkmcnt(0)":::"memory");SBAR();
    #define PK(k) (bf16x8){lo[k][0],lo[k][1],lo[k][2],lo[k][3],hi[k][0],hi[k][1],hi[k][2],hi[k][3]}
    o[d0]=__builtin_amdgcn_mfma_f32_32x32x16_bf16(pa0,PK(0),o[d0],0,0,0);
    o[d0]=__builtin_amdgcn_mfma_f32_32x32x16_bf16(pa1,PK(1),o[d0],0,0,0);
    o[d0]=__builtin_amdgcn_mfma_f32_32x32x16_bf16(pa2,PK(2),o[d0],0,0,0);
    o[d0]=__builtin_amdgcn_mfma_f32_32x32x16_bf16(pa3,PK(3),o[d0],0,0,0);
    #undef PK
  }
}

#ifndef ATTN_STORE16
#define ATTN_STORE16(p,v) (*(u32x4*)(p)=(v))
#endif
template<int THRL> __device__ __forceinline__ void attn_unit(int b,int qk_off,int v_off,int o_off,int qb,const bf16*Q,const bf16*__restrict__ K,const bf16*__restrict__ V,bf16*O,char*shm){
  int tid_=threadIdx.x; asm volatile("":"+v"(tid_)); const int tid=tid_,lane=tid&63,r32=lane&31,hi=lane>>5; const int wid=__builtin_amdgcn_readfirstlane(tid>>6);
  const long rowbase=(long)b*SEQ; const int q0=qb*QB;
  const bf16*Qw=Q+(rowbase+q0+wid*QBLK)*PQK+qk_off;
  const bf16*Kh=K+rowbase*PQK+qk_off,*Vh=V+rowbase*PV+v_off;
  const unsigned lds0=(unsigned)(uintptr_t)shm;
  float*wsf=(float*)(shm+LDS_WS)+wid*64;
  const bf16*ksrc=Kh+(long)lane*PQK+wid*8;
  const bf16*vsrc=Vh+(long)(16*(wid&3)+(lane>>2))*PV+(wid>>2)*32+(lane&3)*8;
  const unsigned kdst=lds0+LDS_K+wid*1024, vdst=lds0+LDS_V+wid*1024;
  #define DMA_K(t,slot) glds16(ksrc+(long)(t)*KVBLK*PQK,(unsigned)__builtin_amdgcn_readfirstlane(kdst+(slot)))
  #define DMA_V(t,slot) glds16(vsrc+(long)(t)*KVBLK*PV,(unsigned)__builtin_amdgcn_readfirstlane(vdst+(slot)))
  const int vb0=(int)(lds0+LDS_V)+((lane>>4)&1)*32+(lane&3)*8+(4*hi+((lane&15)>>2))*64;
  const char*Kbase=shm+LDS_K; bf16x8 kf[8];
  const lds_cptr shm3=(lds_cptr)shm; const lds_cptr kp0=shm3+LDS_K+hi*1024+r32*16; const lds_cptr vp0=shm3+LDS_V+((lane>>4)&1)*32+(lane&3)*8+(4*hi+((lane&15)>>2))*64;
  const int NT=(q0+QB)/KVBLK;
  DMA_K(0,0);DMA_V(0,0);DMA_K(1,SLOTB);
  bf16x8 qr[4];
  #pragma unroll
  for(int d0=0;d0<4;++d0)qr[d0]=*reinterpret_cast<const bf16x8*>(&Qw[(long)r32*PQK+d0*16+hi*8]);
  float mhat=0.f,l_reg=0.f;f32x16 o[2];o[0]=f32x16{};o[1]=f32x16{};f32x16 negm=f32x16{};asm volatile("":"+v"(negm));
  const int qrel=wid*QBLK+r32;
  #define CMASK(P0,P1,t) do{int jb_=(t)-(NT-4); if(jb_>=0)cmask(P0,P1,jb_,qrel,hi);}while(0)
  bool resc=false;
  #define START(P0,P1) do{ const float rm=rowmax(P0,P1); resc=false; \
    { const float dl=rm; mhat=fadd_s(mhat,dl); \
      _Pragma("unroll") for(int r=0;r<16;++r){P0[r]=fsub_s(P0[r],dl);P1[r]=fsub_s(P1[r],dl);} \
      _Pragma("unroll") for(int r=0;r<16;++r)negm[r]=-mhat; asm volatile("":"+v"(negm)); } \
    _Pragma("unroll") for(int r=0;r<16;++r)P0[r]=__builtin_amdgcn_exp2f(P0[r]); }while(0)
  #define RESC() do{ if(resc){ asm volatile("s_waitcnt lgkmcnt(0)":::"memory"); \
      _Pragma("unroll") for(int d_=0;d_<2;++d_) _Pragma("unroll") for(int r=0;r<16;++r)o[d_][r]*=wsf[crow(r,hi)]; } }while(0)
  f32x16 pA0,pA1,pB0,pB1;
  int sl_prev=0,sl_cur=0,sl_next=SLOTB;
  #define ROT() do{sl_prev=sl_cur;sl_cur=sl_next;sl_next=(sl_next==(NSLOT-1)*SLOTB)?0:sl_next+SLOTB;}while(0)
  DMA_K(2,2*SLOTB);
  WAIT_BAR(3);
  qkt(pA0,pA1,Kbase,qr,negm,r32,hi);asm volatile("s_nop 15\n\ts_nop 7":"+v"(pA0),"+v"(pA1));CMASK(pA0,pA1,0);
  START(pA0,pA1);
  _Pragma("unroll") for(int r=0;r<16;++r)pA1[r]=__builtin_amdgcn_exp2f(pA1[r]);
  WAIT_BAR(0);
  DMA_K(3,0);DMA_V(1,SLOTB);
  ROT();
  kload8(kf,kp0+sl_cur);
  WAIT_BAR(2);
  s16x4 vlo[8],vhi[8]; u32x4 pw0,pw1,pw2,pw3;
  #define PKW(P,B) cvtpk_s(P[B],P[B+1])
  #define PAF(k) __builtin_bit_cast(bf16x8,pw##k)
  #define VFR(i) (bf16x8){vlo[i][0],vlo[i][1],vlo[i][2],vlo[i][3],vhi[i][0],vhi[i][1],vhi[i][2],vhi[i][3]}
  #define PIN(x) asm volatile("":"+v"(x))
  #define MX3(a,b,c) __builtin_fmaxf(__builtin_fmaxf((a),(b)),(c))
  #define GAPA(MF,A0,A1,A2,A3,W0,W1,PW) do{ MF; sacc+=A0; sacc+=A1; sacc+=A2; sacc+=A3; PIN(sacc); W0; W1; PIN(PW); SBAR(); }while(0)
  #define EX(v) __builtin_amdgcn_exp2f(v)
  #define GAPB(MF,X,B) do{ MF; X[B]=EX(X[B]); X[B+1]=EX(X[B+1]); X[B+2]=EX(X[B+2]); X[B+3]=EX(X[B+3]); PIN(X); SBAR(); }while(0)
  #define VRD(i) do{ vlo[i]=vtr(vp_+(((i)>>2)*4096+((i)&3)*1024)); vhi[i]=vtr(vp_+(((i)>>2)*4096+((i)&3)*1024+512)); }while(0)
  #define KRD(G,j) do{ if(G){ kload2(kf,kp0+sl_next,j); SBAR(); } }while(0)
  #define STEP(C0,C1,P0,P1,t,GK,GV,GL) do{ SBAR(); \
    const lds_cptr vp_=vp0+sl_prev; \
    VRD(0); SBAR(); float sacc=(P0[0]+P0[1]); \
    GAPA(C0=__builtin_amdgcn_mfma_f32_32x32x16_bf16(kf[0],qr[0],negm,0,0,0), P0[2],P0[3],P0[4],P0[5],     pw0[0]=PKW(P0,0), pw0[1]=PKW(P0,2), pw0); \
    VRD(4); SBAR(); GAPA(C1=__builtin_amdgcn_mfma_f32_32x32x16_bf16(kf[1],qr[0],negm,0,0,0), P0[6],P0[7],P0[8],P0[9],     pw0[2]=PKW(P0,4), pw0[3]=PKW(P0,6), pw0); \
    VRD(1); SBAR(); GAPA(C0=__builtin_amdgcn_mfma_f32_32x32x16_bf16(kf[2],qr[1],C0,0,0,0),   P0[10],P0[11],P0[12],P0[13], pw1[0]=PKW(P0,8), pw1[1]=PKW(P0,10), pw1); \
    VRD(5); SBAR(); GAPA(C1=__builtin_amdgcn_mfma_f32_32x32x16_bf16(kf[3],qr[1],C1,0,0,0),   P0[14],P0[15],P1[0],P1[1],   pw1[2]=PKW(P0,12),pw1[3]=PKW(P0,14), pw1); \
    VRD(2); SBAR(); GAPA(C0=__builtin_amdgcn_mfma_f32_32x32x16_bf16(kf[4],qr[2],C0,0,0,0),   P1[2],P1[3],P1[4],P1[5],     pw2[0]=PKW(P1,0), pw2[1]=PKW(P1,2), pw2); \
    VRD(6); SBAR(); GAPA(C1=__builtin_amdgcn_mfma_f32_32x32x16_bf16(kf[5],qr[2],C1,0,0,0),   P1[6],P1[7],P1[8],P1[9],     pw2[2]=PKW(P1,4), pw2[3]=PKW(P1,6), pw2); \
    VRD(3); SBAR(); GAPA(C0=__builtin_amdgcn_mfma_f32_32x32x16_bf16(kf[6],qr[3],C0,0,0,0),   P1[10],P1[11],P1[12],P1[13], pw3[0]=PKW(P1,8), pw3[1]=PKW(P1,10), pw3); \
    VRD(7); SBAR(); GAPA(C1=__builtin_amdgcn_mfma_f32_32x32x16_bf16(kf[7],qr[3],C1,0,0,0),   P1[14],P1[15],0.f,0.f,       pw3[2]=PKW(P1,12),pw3[3]=PKW(P1,14), pw3); \
    l_reg+=sacc; \
    if(GK){DMA_K((t)+3,sl_cur);} if(GV){DMA_V((t)+1,sl_next);} \
    CMASK(C0,C1,t); \
    { float a=MX3(C0[0],C0[1],C1[0]),b=MX3(C0[2],C0[3],C1[1]); a=MX3(a,C1[2],C1[3]); \
      _Pragma("unroll") for(int r=4;r<16;r+=4){a=MX3(a,C0[r],C0[r+1]);b=MX3(b,C0[r+2],C0[r+3]);a=MX3(a,C1[r],C1[r+1]);b=MX3(b,C1[r+2],C1[r+3]);} \
      float rm=__builtin_fmaxf(a,b); { auto rr=__builtin_amdgcn_permlane32_swap(__float_as_uint(rm),__float_as_uint(rm),false,false); rm=__builtin_fmaxf(__uint_as_float(rr[0]),__uint_as_float(rr[1])); } \
      resc=false; \
      if(__builtin_expect(__any(rm>(float)THRL),0)){ const float dl=__builtin_fmaxf(rm,0.f); mhat+=dl; \
        _Pragma("unroll") for(int r=0;r<16;++r){C0[r]-=dl;C1[r]-=dl;} \
        _Pragma("unroll") for(int r=0;r<16;++r)negm[r]=-mhat; asm volatile("":"+v"(negm)); \
        const float f=__builtin_amdgcn_exp2f(-dl); l_reg*=f; if(hi==0)wsf[r32]=f; resc=true; } } \
    SBAR(); \
    GAPB(o[0]=__builtin_amdgcn_mfma_f32_32x32x16_bf16(PAF(0),VFR(0),o[0],0,0,0), C0,0); \
    GAPB(o[1]=__builtin_amdgcn_mfma_f32_32x32x16_bf16(PAF(0),VFR(4),o[1],0,0,0), C0,4); \
    KRD(GL,0); GAPB(o[0]=__builtin_amdgcn_mfma_f32_32x32x16_bf16(PAF(1),VFR(1),o[0],0,0,0), C0,8); \
    KRD(GL,1); GAPB(o[1]=__builtin_amdgcn_mfma_f32_32x32x16_bf16(PAF(1),VFR(5),o[1],0,0,0), C0,12); \
    KRD(GL,2); GAPB(o[0]=__builtin_amdgcn_mfma_f32_32x32x16_bf16(PAF(2),VFR(2),o[0],0,0,0), C1,0); \
    KRD(GL,3); GAPB(o[1]=__builtin_amdgcn_mfma_f32_32x32x16_bf16(PAF(2),VFR(6),o[1],0,0,0), C1,4); \
    GAPB(o[0]=__builtin_amdgcn_mfma_f32_32x32x16_bf16(PAF(3),VFR(3),o[0],0,0,0), C1,8); \
    GAPB(o[1]=__builtin_amdgcn_mfma_f32_32x32x16_bf16(PAF(3),VFR(7),o[1],0,0,0), C1,12); \
    }while(0)
  int t=1;
  #undef CMASK
  #define CMASK(P0,P1,t) do{}while(0)
  for(;t+5<NT;t+=2){
    STEP(pB0,pB1,pA0,pA1,t,true,true,true);     WAIT_BAR(2); RESC(); ROT();
    STEP(pA0,pA1,pB0,pB1,t+1,true,true,true);   WAIT_BAR(2); RESC(); ROT();
  }
  #undef CMASK
  #define CMASK(P0,P1,t) do{int jb_=(t)-(NT-4); if(jb_>=0)cmask(P0,P1,jb_,qrel,hi);}while(0)
  #define ENDW(tt) do{ if((tt)+3<NT){WAIT_BAR(2);} else if((tt)+2<NT){WAIT_BAR(1);} else {WAIT_BAR(0);} }while(0)
  for(;t+1<NT;t+=2){
    STEP(pB0,pB1,pA0,pA1,t,(t+3<NT),(t+1<NT),(t+1<NT));       ENDW(t);   RESC(); ROT();
    STEP(pA0,pA1,pB0,pB1,t+1,(t+4<NT),(t+2<NT),(t+2<NT));     ENDW(t+1); RESC(); ROT();
  }
  STEP(pB0,pB1,pA0,pA1,NT-1,false,false,false); RESC();
  { float sacc=pB0[0]+pB0[1]; _Pragma("unroll") for(int r=2;r<16;++r)sacc+=pB0[r]; _Pragma("unroll") for(int r=0;r<16;++r)sacc+=pB1[r]; l_reg+=sacc;
    pw0=(u32x4){PKW(pB0,0),PKW(pB0,2),PKW(pB0,4),PKW(pB0,6)};pw1=(u32x4){PKW(pB0,8),PKW(pB0,10),PKW(pB0,12),PKW(pB0,14)};pw2=(u32x4){PKW(pB1,0),PKW(pB1,2),PKW(pB1,4),PKW(pB1,6)};pw3=(u32x4){PKW(pB1,8),PKW(pB1,10),PKW(pB1,12),PKW(pB1,14)};
    SBAR(); pv(o,vb0+sl_cur,PAF(0),PAF(1),PAF(2),PAF(3)); }
  #undef PKW
  #undef PAF
  #undef VFR
  #undef PIN
  #undef MX3
  #undef GAPA
  #undef GAPB
  #undef EX
  #undef VRD
  #undef KRD
  #undef STEP
  #undef ENDW
  {auto rr=__builtin_amdgcn_permlane32_swap(__float_as_uint(l_reg),__float_as_uint(l_reg),false,false);l_reg=__uint_as_float(rr[0])+__uint_as_float(rr[1]);}
  if(hi==0)wsf[32+r32]=l_reg;asm volatile("s_waitcnt lgkmcnt(0)":::"memory");
  float rli[16];
  #pragma unroll
  for(int r=0;r<16;++r)rli[r]=__builtin_amdgcn_rcpf(wsf[32+crow(r,hi)]);
  bf16*Ow=O+(rowbase+q0+wid*QBLK)*PO+o_off;
  { bf16*stg=(bf16*)(shm+LDS_OST)+wid*2048;
    #pragma unroll
    for(int r=0;r<16;++r){const int orow=crow(r,hi);
      #pragma unroll
      for(int d0=0;d0<2;++d0)stg[orow*64+d0*32+r32]=__float2bfloat16(o[d0][r]*rli[r]);}
    asm volatile("s_waitcnt lgkmcnt(0)":::"memory");
    #pragma unroll
    for(int i=0;i<4;++i){const int row=i*8+(lane>>3),ch=lane&7; const u32x4 v=*(const u32x4*)(stg+row*64+ch*8); ATTN_STORE16(Ow+(long)row*PO+ch*8,v);} }
  asm volatile("s_waitcnt lgkmcnt(0)\n\ts_barrier":::"memory");
  #undef DMA_K
  #undef DMA_V
  #undef CMASK
  #undef START
  #undef RESC
  #undef ROT
}
constexpr int ATTN_LDS_BYTES=LDS_BYTES;
#undef SBAR
#undef WAIT_BAR
}
#define GAS __attribute__((address_space(1)))
#define LAS __attribute__((address_space(3)))
typedef unsigned short bf16;
typedef unsigned v4u __attribute__((ext_vector_type(4)));
typedef float f32x4 __attribute__((ext_vector_type(4)));
typedef short bf16x8 __attribute__((ext_vector_type(8)));
typedef short bf16x4 __attribute__((ext_vector_type(4)));
typedef GAS unsigned gu32;
typedef GAS unsigned long long gu64;
#define RLX_AGENT __ATOMIC_RELAXED, __HIP_MEMORY_SCOPE_AGENT
#define LDS_WAIT() asm volatile("s_waitcnt lgkmcnt(0)" ::: "memory")
#define VM_WAIT() asm volatile("s_waitcnt vmcnt(0)" ::: "memory")
__device__ __forceinline__ unsigned long long rt() { return __builtin_amdgcn_s_memrealtime(); }
__device__ __forceinline__ unsigned f2bf(float f) { unsigned u = __builtin_bit_cast(unsigned, f); return (u + 0x7fffu + ((u >> 16) & 1u)) >> 16; }
typedef float pk_f32x2 __attribute__((ext_vector_type(2))); typedef __bf16 pk_bf16x2 __attribute__((ext_vector_type(2)));
__device__ __forceinline__ unsigned pk2(float lo, float hi) { const pk_f32x2 v = {lo, hi}; return __builtin_bit_cast(unsigned, __builtin_convertvector(v, pk_bf16x2)); }

#define XB_TMO      128
#define XB_XCNT(j)  (256  + 64 * (j))
#define XB_XSUB(j)  (1280 + 64 * (j))
#define XB_XGEN(j)  (2304 + 64 * (j))
#define XB_TOP      3328
#define XB_TOPGEN   3392
#define XCD_BAR_WORDS 3456
#define XB_SPIN_CAP (1u << 18)

__device__ __forceinline__ unsigned xb_ld(unsigned* p)              { return __hip_atomic_load(p, __ATOMIC_RELAXED, __HIP_MEMORY_SCOPE_AGENT); }
__device__ __forceinline__ unsigned xb_add(unsigned* p, unsigned v) { return __hip_atomic_fetch_add(p, v, __ATOMIC_RELAXED, __HIP_MEMORY_SCOPE_AGENT); }
__device__ __forceinline__ unsigned xb_xcc_id() { return (unsigned)__builtin_amdgcn_s_getreg((3 << 11) | 20) & 0xFu; }
#define XB_SPIN(cond, bar) do { unsigned _sp = 0; while (cond) { __builtin_amdgcn_s_sleep(1); \
    if ((++_sp & 255u) == 0u) { if (xb_ld(&(bar)[XB_TMO])) break; if (_sp > XB_SPIN_CAP) { atomicAdd(&(bar)[XB_TMO], 1u); break; } } } } while (0)

struct XcdBarrier {
    unsigned* bar; unsigned x;
    volatile LAS unsigned* st;
};

__device__ __forceinline__ XcdBarrier xcd_barrier_post(unsigned* bar, volatile LAS unsigned* st) {
    XcdBarrier b; b.bar = bar; b.x = xb_xcc_id(); b.st = st;
    if (threadIdx.x == 0) (void)xb_add(&bar[XB_XCNT(b.x)], 1u);
    return b;
}
__device__ __forceinline__ void xcd_barrier_complete(unsigned* bar, unsigned x, unsigned& nloc, unsigned& nx) {
    const unsigned G = gridDim.x * gridDim.y * gridDim.z;
    unsigned sum, cnt, mine, sp = 0u;
    for (;;) {
        sum = 0u; cnt = 0u; mine = 0u;
#pragma unroll
        for (unsigned j = 0; j < 16; ++j) { const unsigned c = xb_ld(&bar[XB_XCNT(j)]); sum += c; cnt += (c > 0u) ? 1u : 0u; mine = (j == x) ? c : mine; }
        if (sum == G) break;
        __builtin_amdgcn_s_sleep(1);
        if ((++sp & 255u) == 0u) { if (xb_ld(&bar[XB_TMO])) break; if (sp > XB_SPIN_CAP) { atomicAdd(&bar[XB_TMO], 1u); break; } }
    }
    nloc = mine > 0u ? mine : 1u; nx = cnt > 0u ? cnt : 1u;
}

__device__ __forceinline__ void xcd_barrier(const XcdBarrier& b) {
    asm volatile("s_waitcnt vmcnt(0)" ::: "memory");
    __syncthreads();
    if (threadIdx.x == 0) {
        unsigned* bar = b.bar;
        __builtin_amdgcn_s_waitcnt(0);
        unsigned nloc = b.st[0], nx = b.st[1];
        if (nloc == 0u) { xcd_barrier_complete(bar, b.x, nloc, nx); b.st[0] = nloc; b.st[1] = nx; }
        const unsigned old = xb_add(&bar[XB_XSUB(b.x)], 1u);
        const unsigned gen = old / nloc;
        if (old + 1u == (gen + 1u) * nloc) {
            __builtin_amdgcn_fence(__ATOMIC_RELEASE, "agent");
            asm volatile("s_waitcnt vmcnt(0)" ::: "memory");
            const unsigned og = xb_add(&bar[XB_TOP], 1u);
            const unsigned tg = og / nx;
            if (og + 1u == (tg + 1u) * nx) xb_add(&bar[XB_TOPGEN], 1u);
            else XB_SPIN(xb_ld(&bar[XB_TOPGEN]) == tg, bar);
            __builtin_amdgcn_fence(__ATOMIC_ACQUIRE, "agent");
            xb_add(&bar[XB_XGEN(b.x)], 1u);
            asm volatile("s_waitcnt vmcnt(0)" ::: "memory");
        } else {
            XB_SPIN(xb_ld(&bar[XB_XGEN(b.x)]) == gen, bar);
            __builtin_amdgcn_fence(__ATOMIC_ACQUIRE, "agent");
            asm volatile("s_waitcnt vmcnt(0)" ::: "memory");
        }
    }
    __syncthreads();
}

constexpr int NWAVES = 8, NTHR = 512;
constexpr int DMODEL = 1024, SEQ = 4096, NB = 4, NS = 32, ST = 8, NPG = 64, PAGE = 128;
constexpr int MP = NB * SEQ, MS = NS * ST, MT = MP + MS;
constexpr int FF = 2752, FFP = 2816, NGU = 2 * FFP, NIE = 2560, NIO = 1536;
constexpr float EPS = 1e-6f;
constexpr float C2 = 0.125f * 1.4426950408889634f;
constexpr float LAM_INIT0 = 0.2f;
constexpr int NSPLIT = 16, PSTR = 132;

constexpr size_t O_Y = 0;
constexpr size_t O_KP = O_Y + (size_t)MT * 1024;
constexpr size_t O_VP = O_KP + (size_t)MP * 512;
constexpr size_t O_CBP = O_VP + (size_t)MP * 512;
constexpr size_t O_HBP = O_CBP + NB * 3 * 512;
constexpr size_t O_CREP = O_HBP + NB * 512;
constexpr size_t O_CIMP = O_CREP + NB * 32 * 64;
constexpr size_t O_CDP = O_CIMP + NB * 32 * 64;
constexpr size_t O_KS = O_CDP + NB * 30 * 512;
constexpr size_t O_VS = O_KS + (size_t)MS * 512;
constexpr size_t O_CBS = O_VS + (size_t)MS * 512;
constexpr size_t O_HBS = O_CBS + NS * 3 * 512;
constexpr size_t O_CRES = O_HBS + NS * 512;
constexpr size_t O_CIMS = O_CRES + NS * 32 * 64;
constexpr size_t O_CDS = O_CIMS + NS * 32 * 64;
constexpr size_t O_END = O_CDS + NS * 30 * 512;
static_assert(O_END == 34852864, "output size");

enum { I_XP = 0, I_XS, I_CK, I_CV, I_SCB, I_SHB, I_SCRE, I_SCIM, I_SCD, I_PT, I_F1G, I_F1GU, I_F1DN, I_MIXG, I_F2G, I_F2GU, I_F2DN, I_EWIN, I_EWOUT, I_AQG, I_AKG, I_ALAM, I_AHG,
       I_BCW, I_BCB, I_BGW, I_BGB, I_BLAM, I_OWIN, I_OWOUT, I_CARE, I_CAIM, I_CLDT, I_CBRE, I_CBIM, I_CCRE, I_CCIM, I_CD, I_CGLUW, I_CGLUB, I_DCW, I_DCB, I_DLNG, I_DLNB, N_IN };
static_assert(N_IN == 44, "inputs");

constexpr size_t MiB = 1u << 20;
constexpr size_t WS_CTL = 0, CTL_ZERO_BYTES = 1 * MiB;
constexpr size_t WS_WGU = 2 * MiB, WGU_BYTES = (size_t)NGU * 1024 * 2;
constexpr size_t WS_WDN = 46 * MiB, WDN_BYTES = (size_t)1024 * FFP * 2;
constexpr size_t WS_WIE = 68 * MiB, WS_WOE = 73 * MiB, WS_WIO = 75 * MiB, WS_WOO = 78 * MiB, WS_WGLU = 80 * MiB;
constexpr size_t WS_XB = 82 * MiB;
constexpr size_t WS_SS = 115 * MiB;
constexpr size_t WS_H = 118 * MiB;
constexpr size_t WS_Q = 208 * MiB, WS_K = 225 * MiB, WS_V = 242 * MiB;
constexpr size_t WS_XBF = 259 * MiB, WS_GBF = 292 * MiB;
constexpr size_t WS_O2 = 325 * MiB;
constexpr size_t WS_MIX = 357 * MiB;
constexpr size_t WS_U = 390 * MiB, WS_G = 423 * MiB;
constexpr size_t WS_Z = 456 * MiB;
constexpr size_t WS_PART = 473 * MiB;
constexpr size_t WS_HL = 492 * MiB, WS_CPD = 525 * MiB;
constexpr size_t WS_TOT = 558 * MiB;
constexpr size_t WS_END = 560 * MiB;
static_assert(WS_WGU + 4 * WGU_BYTES <= WS_WDN && WS_WDN + 4 * WDN_BYTES <= WS_WIE && WS_XB + (size_t)MT * 1024 * 2 <= WS_SS && WS_SS + (size_t)MT * 64 <= WS_H && WS_H + (size_t)MT * FFP * 2 <= WS_Q, "ws map 1");
static_assert(WS_Q + (size_t)MT * 1024 <= WS_K && WS_V + (size_t)MT * 1024 <= WS_XBF && WS_XBF + (size_t)MT * 2048 <= WS_GBF && WS_GBF + (size_t)MT * 2048 <= WS_O2 && WS_O2 + (size_t)MP * 2048 <= WS_MIX, "ws map 2");
static_assert(WS_MIX + (size_t)MT * 2048 <= WS_U && WS_U + (size_t)MT * 2048 <= WS_G && WS_G + (size_t)MT * 2048 <= WS_Z && WS_Z + (size_t)MT * 1024 <= WS_PART && WS_PART + (size_t)NS * 4 * NSPLIT * 16 * PSTR * 4 <= WS_END, "ws map 3");
constexpr int CW_TMO = 0, CW_CODE = 1;
constexpr int CW_BAR = 4096;
constexpr int CW_Q0 = 8192, CW_Q1 = 8192 + 256;

constexpr int RING_OFF = 0, RING_BYTES = 131072;
constexpr int LDSCTL_OFF = RING_BYTES, MISC_OFF = LDSCTL_OFF + 320;
constexpr int RSTAB_OFF = LDSCTL_OFF + 1024, RSTAB_SLOTS = 8;
constexpr int LDS_BYTES = 147456;
static_assert(RSTAB_OFF + RSTAB_SLOTS * 1024 <= LDS_BYTES, "LDS map");

typedef float f32x2 __attribute__((ext_vector_type(2)));
typedef unsigned u32x2 __attribute__((ext_vector_type(2)));
__device__ __forceinline__ float wave_sum(float v) {
#pragma unroll
    for (int o = 1; o < 64; o <<= 1) v += __shfl_xor(v, o);
    return v;
}
__device__ __forceinline__ float bf2f(unsigned h) { return __uint_as_float(h << 16); }
__device__ __forceinline__ float sigmoid_f(float x) { return __builtin_amdgcn_rcpf(1.f + __expf(-x)); }
__device__ __forceinline__ float gelu_tanh_f(float x) { return x * sigmoid_f(1.5957691216057308f * (x + 0.044715f * x * x * x)); }
__device__ __forceinline__ v4u pack8(const f32x4 a, const f32x4 b) { v4u w; w.x = pk2(a[0], a[1]); w.y = pk2(a[2], a[3]); w.z = pk2(b[0], b[1]); w.w = pk2(b[2], b[3]); return w; }

template <class Sched> __device__ __forceinline__ void rstd_table_fill(LAS float* tab, const float* SS, const Sched& S, int tid) {
    const int row = tid & 255;
#pragma unroll
    for (int i0 = 0; i0 < RSTAB_SLOTS; i0 += 2) { const int i = i0 + (tid >> 8); pg8::Unit u; const bool ok = S.next(i, u);
        const f32x4* q = (const f32x4*)(SS + (size_t)((ok ? u.pm : 0) * 256 + row) * 16);
        const f32x4 a = q[0], b = q[1], c = q[2], d = q[3];
        const float t = ((a[0] + a[1]) + (a[2] + a[3])) + ((b[0] + b[1]) + (b[2] + b[3])) + ((c[0] + c[1]) + (c[2] + c[3])) + ((d[0] + d[1]) + (d[2] + d[3]));
        if (ok) tab[i * 256 + row] = rsqrtf(t * (1.f / 1024.f) + EPS); }
    __syncthreads();
}
__device__ __forceinline__ void rows_rstd(const LAS float* tab, int ui, int prow0, float (&rs)[2][4]) {
#pragma unroll
    for (int ai = 0; ai < 2; ++ai)
#pragma unroll
        for (int m = 0; m < 4; ++m) rs[ai][m] = tab[ui * 256 + prow0 + ai * 128 + m * 16];
}
using pg8::Unit;
struct EpiSwiGLU {
    static constexpr bool PERM = true, AFTER_DRAIN = false, INIT_ACC = false;
    bf16* H; const LAS float* TAB;
    __device__ __forceinline__ void operator()(const f32x4 (&acc)[2][2][4][2], const Unit& u, int wr, int wc, int fr, int fq, int ui) const {
        const int row0 = u.pm * 256 + wr * 64 + fr, col0 = u.pn * 128 + wc * 32 + 8 * fq;
        float rsv[2][4]; rows_rstd(TAB, ui, wr * 64 + fr, rsv);
#pragma unroll
        for (int ai = 0; ai < 2; ++ai)
#pragma unroll
            for (int m = 0; m < 4; ++m) {
                const int r = row0 + ai * 128 + m * 16; const float rs = rsv[ai][m];
                f32x4 hv[2];
#pragma unroll
                for (int n = 0; n < 2; ++n) { const f32x4 g = acc[ai][0][m][n] * rs, up = acc[ai][1][m][n] * rs;
#pragma unroll
                    for (int i = 0; i < 4; ++i) hv[n][i] = g[i] * sigmoid_f(g[i]) * up[i]; }
                *(v4u*)(H + (size_t)r * FFP + col0) = pack8(hv[0], hv[1]);
            }
    }
};
struct EpiResid {
    static constexpr bool PERM = false, AFTER_DRAIN = false, INIT_ACC = true;
    const GAS float* Xin; GAS float* X; bf16* XB; float* SS; float s, sinv; int wxb;
    __device__ __forceinline__ void init(f32x4 (&acc)[2][2][4][2], const Unit& u, int wr, int wc, int fr, int fq) const {
        const int row0 = u.pm * 256 + wr * 64 + fr, col0 = u.pn * 256 + wc * 32 + 4 * fq;
#pragma unroll
        for (int ai = 0; ai < 2; ++ai)
#pragma unroll
            for (int m = 0; m < 4; ++m)
#pragma unroll
                for (int bj = 0; bj < 2; ++bj)
#pragma unroll
                    for (int n = 0; n < 2; ++n) acc[ai][bj][m][n] = *(const GAS f32x4*)(Xin + (size_t)(row0 + ai * 128 + m * 16) * 1024 + col0 + bj * 128 + n * 16) * sinv;
    }
    __device__ __forceinline__ void operator()(const f32x4 (&acc)[2][2][4][2], const Unit& u, int wr, int wc, int fr, int fq, int ui) const {
        const int row0 = u.pm * 256 + wr * 64 + fr, col0 = u.pn * 256 + wc * 32 + 4 * fq;
#pragma unroll
        for (int ai = 0; ai < 2; ++ai)
#pragma unroll
            for (int m = 0; m < 4; ++m) {
                const int r = row0 + ai * 128 + m * 16; float q = 0.f;
#pragma unroll
                for (int bj = 0; bj < 2; ++bj)
#pragma unroll
                    for (int n = 0; n < 2; ++n) { const size_t off = (size_t)r * 1024 + col0 + bj * 128 + n * 16;
                        const f32x4 x = acc[ai][bj][m][n] * s; *(GAS f32x4*)(X + off) = x;
                        q += (x[0] * x[0] + x[1] * x[1]) + (x[2] * x[2] + x[3] * x[3]);
                        if (wxb) { u32x2 w; w.x = pk2(x[0], x[1]); w.y = pk2(x[2], x[3]); *(u32x2*)(XB + off) = w; } }
                q += __shfl_xor(q, 16); q += __shfl_xor(q, 32);
                if (wxb && fq == 0) SS[(size_t)r * 16 + u.pn * 4 + wc] = q;
            }
    }
};
struct EpiInEven {
    static constexpr bool PERM = true, AFTER_DRAIN = false, INIT_ACC = false;
    bf16 *Q, *K, *V, *XBF, *GBF; float *okp, *ovp, *oks, *ovs, *ocbp, *ocbs; const LAS float* TAB; const float *qg, *kg;
    __device__ __forceinline__ void operator()(const f32x4 (&acc)[2][2][4][2], const Unit& u, int wr, int wc, int fr, int fq, int ui) const {
        const int row0 = u.pm * 256 + wr * 64 + fr; const int t = u.pn >> 1, chunk = (u.pn & 1) * 4 + wc, fc0 = chunk * 64 + 8 * fq;
        float rsv[2][4]; rows_rstd(TAB, ui, wr * 64 + fr, rsv);
        f32x4 gn[2][2];
        if (t < 2) { const float* gp = (t == 0 ? qg : kg) + 8 * fq; const float gs = (t == 0) ? C2 : 1.f;
#pragma unroll
            for (int bj = 0; bj < 2; ++bj)
#pragma unroll
                for (int n = 0; n < 2; ++n) gn[bj][n] = *(const f32x4*)(gp + 32 * bj + 4 * n) * gs; }
#pragma unroll
        for (int ai = 0; ai < 2; ++ai)
#pragma unroll
            for (int m = 0; m < 4; ++m) {
                const int r = row0 + ai * 128 + m * 16; const float rs = rsv[ai][m];
                f32x4 v[2][2];
#pragma unroll
                for (int bj = 0; bj < 2; ++bj)
#pragma unroll
                    for (int n = 0; n < 2; ++n) v[bj][n] = acc[ai][bj][m][n] * rs;
                if (t < 2) {
                    float q = 0.f;
#pragma unroll
                    for (int bj = 0; bj < 2; ++bj)
#pragma unroll
                        for (int n = 0; n < 2; ++n) q += (v[bj][n][0] * v[bj][n][0] + v[bj][n][1] * v[bj][n][1]) + (v[bj][n][2] * v[bj][n][2] + v[bj][n][3] * v[bj][n][3]);
                    q += __shfl_xor(q, 16); q += __shfl_xor(q, 32);
                    const float nr = rsqrtf(q * (1.f / 64.f) + EPS);
#pragma unroll
                    for (int bj = 0; bj < 2; ++bj)
#pragma unroll
                        for (int n = 0; n < 2; ++n) v[bj][n] = v[bj][n] * nr * gn[bj][n];
                }
                const size_t o5 = (size_t)r * 512 + fc0;
                if (t == 0) { *(v4u*)(Q + o5) = pack8(v[0][0], v[0][1]); *(v4u*)(Q + o5 + 32) = pack8(v[1][0], v[1][1]); }
                else if (t <= 2) {
                    bf16* B = (t == 1) ? K : V; *(v4u*)(B + o5) = pack8(v[0][0], v[0][1]); *(v4u*)(B + o5 + 32) = pack8(v[1][0], v[1][1]);
                    float* O = (r < MP) ? ((t == 1 ? okp : ovp) + o5) : ((t == 1 ? oks : ovs) + (o5 - (size_t)MP * 512));
                    *(f32x4*)(O) = v[0][0]; *(f32x4*)(O + 4) = v[0][1]; *(f32x4*)(O + 32) = v[1][0]; *(f32x4*)(O + 36) = v[1][1];
                } else if (t == 3) {
                    *(v4u*)(XBF + o5) = pack8(v[0][0], v[0][1]); *(v4u*)(XBF + o5 + 32) = pack8(v[1][0], v[1][1]);
                    float* O = nullptr;
                    if (u.pm * 256 >= MP) { const int rr = r - MP; if ((rr & 7) >= 5) O = ocbs + (size_t)((rr >> 3) * 3 + (rr & 7) - 5) * 512 + fc0; }
                    else if ((u.pm & (SEQ / 256 - 1)) == SEQ / 256 - 1) { const int tq = r & (SEQ - 1); if (tq >= SEQ - 3) O = ocbp + (size_t)((r / SEQ) * 3 + tq - (SEQ - 3)) * 512 + fc0; }
                    if (O) { *(f32x4*)(O) = v[0][0]; *(f32x4*)(O + 4) = v[0][1]; *(f32x4*)(O + 32) = v[1][0]; *(f32x4*)(O + 36) = v[1][1]; }
                } else { *(v4u*)(GBF + o5) = pack8(v[0][0], v[0][1]); *(v4u*)(GBF + o5 + 32) = pack8(v[1][0], v[1][1]); }
            }
    }
};
struct EpiInOdd {
    static constexpr bool PERM = false, AFTER_DRAIN = false, INIT_ACC = false;
    bf16 *U, *G; const LAS float* TAB; float *ocdp, *ocds;
    __device__ __forceinline__ void operator()(const f32x4 (&acc)[2][2][4][2], const Unit& u, int wr, int wc, int fr, int fq, int ui) const {
        const int row0 = u.pm * 256 + wr * 64 + fr, cw = wc * 32 + 4 * fq;
        float rsv[2][4]; rows_rstd(TAB, ui, wr * 64 + fr, rsv);
        const bool smp = u.pm * 256 >= MP, tailp = !smp && (u.pm & (SEQ / 256 - 1)) == SEQ / 256 - 1;
#pragma unroll
        for (int ai = 0; ai < 2; ++ai)
#pragma unroll
            for (int m = 0; m < 4; ++m) {
                const int r = row0 + ai * 128 + m * 16; const float rs = rsv[ai][m];
                if (u.pn < 2) {
#pragma unroll
                    for (int bj = 0; bj < 2; ++bj)
#pragma unroll
                        for (int n = 0; n < 2; ++n) { const f32x4 o = acc[ai][bj][m][n] * rs; u32x2 w; w.x = pk2(o[0], o[1]); w.y = pk2(o[2], o[3]); *(u32x2*)(U + (size_t)r * 512 + u.pn * 256 + bj * 128 + cw + n * 16) = w; }
                } else {
#pragma unroll
                    for (int n = 0; n < 2; ++n) { const f32x4 val = acc[ai][0][m][n] * rs, gt = acc[ai][1][m][n] * rs; f32x4 o;
#pragma unroll
                        for (int i = 0; i < 4; ++i) o[i] = val[i] * sigmoid_f(gt[i]);
                        const int col = (u.pn - 2) * 128 + cw + n * 16; u32x2 w; w.x = pk2(o[0], o[1]); w.y = pk2(o[2], o[3]);
                        *(u32x2*)(G + (size_t)r * 512 + col) = w;
                        if (smp) { const int rr = r - MP; *(f32x4*)(ocds + (size_t)((rr >> 3) * 30 + 22 + (rr & 7)) * 512 + col) = o; }
                        else if (tailp) { const int t = r & (SEQ - 1); if (t >= SEQ - 30) *(f32x4*)(ocdp + (size_t)((r / SEQ) * 30 + t - (SEQ - 30)) * 512 + col) = o; } }
                }
            }
    }
};
struct EpiGLU {
    static constexpr bool PERM = true, AFTER_DRAIN = false, INIT_ACC = false;
    const bf16* Z; bf16* MIX; const float* bias;
    __device__ __forceinline__ void operator()(const f32x4 (&acc)[2][2][4][2], const Unit& u, int wr, int wc, int fr, int fq, int ui) const {
        const int row0 = u.pm * 256 + wr * 64 + fr, col0 = u.pn * 256 + wc * 32 + 8 * fq;
        f32x4 bb[2][2];
#pragma unroll
        for (int bj = 0; bj < 2; ++bj) { bb[bj][0] = *(const f32x4*)(bias + col0 + bj * 128); bb[bj][1] = *(const f32x4*)(bias + col0 + bj * 128 + 4); }
        v4u zz[2][4][2];
#pragma unroll
        for (int ai = 0; ai < 2; ++ai)
#pragma unroll
            for (int m = 0; m < 4; ++m)
#pragma unroll
                for (int bj = 0; bj < 2; ++bj) zz[ai][m][bj] = *(const v4u*)(Z + (size_t)(row0 + ai * 128 + m * 16) * 512 + col0 + bj * 128);
#pragma unroll
        for (int ai = 0; ai < 2; ++ai)
#pragma unroll
            for (int m = 0; m < 4; ++m) {
                const int r = row0 + ai * 128 + m * 16;
#pragma unroll
                for (int bj = 0; bj < 2; ++bj) { const int c = col0 + bj * 128; const v4u z4 = zz[ai][m][bj];
                    const float z[8] = {bf2f(z4.x & 0xffffu), bf2f(z4.x >> 16), bf2f(z4.y & 0xffffu), bf2f(z4.y >> 16), bf2f(z4.z & 0xffffu), bf2f(z4.z >> 16), bf2f(z4.w & 0xffffu), bf2f(z4.w >> 16)};
                    f32x4 o0, o1;
#pragma unroll
                    for (int i = 0; i < 4; ++i) { o0[i] = z[i] * sigmoid_f(acc[ai][bj][m][0][i] + bb[bj][0][i]); o1[i] = z[4 + i] * sigmoid_f(acc[ai][bj][m][1][i] + bb[bj][1][i]); }
                    *(v4u*)(MIX + (size_t)r * 1024 + c) = pack8(o0, o1); }
            }
    }
};

template <int K>
__device__ __forceinline__ void gemm_small_resid(const bf16* A, const bf16* Bt, const GAS float* Xin, GAS float* X, bf16* XB, float* SS, float s, bool wxb, LAS unsigned char* lds, int G, int first, int tid) {
    const int wave = __builtin_amdgcn_readfirstlane(tid >> 6), lane = tid & 63, m16 = lane & 15, quad = lane >> 4;
    constexpr int KW = K / 8, STEPS = KW / 32, GRP = (STEPS + 1) / 2 > 6 ? 6 : (STEPS <= 6 ? STEPS : (STEPS + 1) / 2); static_assert(K % 256 == 0 && STEPS <= 12, "K split");
    LAS float* part = (LAS float*)lds;
    for (int tile = first; tile < 256; tile += G) {
        const int rt = tile >> 4, ct = tile & 15;
        const int row = tid >> 5, cp = tid & 31;
        const size_t off = (size_t)(rt * 16 + row) * 1024 + ct * 64 + cp * 2;
        const f32x2 xin = *(const GAS f32x2*)(Xin + off);
        const bf16* ap = A + (size_t)(rt * 16 + m16) * K + wave * KW + quad * 8;
        const bf16* bp = Bt + (size_t)(ct * 64 + m16) * K + wave * KW + quad * 8;
        f32x4 acc[4];
#pragma unroll
        for (int nt = 0; nt < 4; ++nt) acc[nt] = (f32x4){0.f, 0.f, 0.f, 0.f};
#pragma unroll 1
        for (int s0 = 0; s0 < STEPS; s0 += GRP) {
            bf16x8 af[GRP], bfr[GRP][4];
#pragma unroll
            for (int j = 0; j < GRP; ++j) if (s0 + j < STEPS) { af[j] = *(const bf16x8*)(ap + (s0 + j) * 32);
#pragma unroll
                for (int nt = 0; nt < 4; ++nt) bfr[j][nt] = *(const bf16x8*)(bp + (size_t)nt * 16 * K + (s0 + j) * 32); }
#pragma unroll
            for (int j = 0; j < GRP; ++j) if (s0 + j < STEPS) {
#pragma unroll
                for (int nt = 0; nt < 4; ++nt) acc[nt] = __builtin_amdgcn_mfma_f32_16x16x32_bf16(af[j], bfr[j][nt], acc[nt], 0, 0, 0); }
        }
#pragma unroll
        for (int nt = 0; nt < 4; ++nt)
#pragma unroll
            for (int i = 0; i < 4; ++i) part[(wave * 16 + quad * 4 + i) * 68 + nt * 16 + m16] = acc[nt][i];
        __syncthreads();
        float s0_ = 0.f, s1_ = 0.f;
#pragma unroll
        for (int w = 0; w < 8; ++w) { const f32x2 v = *(const LAS f32x2*)(part + (w * 16 + row) * 68 + cp * 2); s0_ += v.x; s1_ += v.y; }
        f32x2 x = xin; x.x += s * s0_; x.y += s * s1_; *(GAS f32x2*)(X + off) = x;
        float q = x.x * x.x + x.y * x.y;
        if (wxb) *(unsigned*)(XB + off) = pk2(x.x, x.y);
#pragma unroll
        for (int o = 1; o < 32; o <<= 1) q += __shfl_xor(q, o);
        if (wxb && cp == 0) SS[(size_t)(rt * 16 + row) * 16 + ct] = q;
        __syncthreads();
    }
}

struct Args { const void* in[44]; float* out; unsigned char* ws; int ph_lo, ph_hi; };
struct Ctx {
    LAS unsigned char* lds; volatile LAS unsigned* MISC; gu32* ctl;
    int tid, lane, wave, vcu, G;
    GAS float* out; GAS unsigned char* ws;
};
#define INF(i) ((const float*)(const GAS float*)A.in[i])
#define P_XB ((bf16*)(GAS bf16*)(C.ws + WS_XB))
#define P_H ((bf16*)(GAS bf16*)(C.ws + WS_H))
#define P_Q ((bf16*)(GAS bf16*)(C.ws + WS_Q))
#define P_K ((bf16*)(GAS bf16*)(C.ws + WS_K))
#define P_V ((bf16*)(GAS bf16*)(C.ws + WS_V))
#define P_O2 ((bf16*)(GAS bf16*)(C.ws + WS_O2))
#define P_MIX ((bf16*)(GAS bf16*)(C.ws + WS_MIX))
#define P_Z ((bf16*)(GAS bf16*)(C.ws + WS_Z))
#define P_SS ((float*)(GAS float*)(C.ws + WS_SS))
#define P_XBF ((bf16*)(GAS bf16*)(C.ws + WS_XBF))
#define P_GBF ((bf16*)(GAS bf16*)(C.ws + WS_GBF))
#define P_U ((bf16*)(GAS bf16*)(C.ws + WS_U))
#define P_GG ((bf16*)(GAS bf16*)(C.ws + WS_G))
#define P_PART ((float*)(GAS float*)(C.ws + WS_PART))
#define P_HC ((unsigned*)(GAS unsigned*)(C.ws + WS_HL))
#define P_TOT ((float*)(GAS float*)(C.ws + WS_TOT))

struct ConvD { const float* W; const float* gain; bf16* WT; int ldw, scol0, k0, Kdst, drow0; bool valid; };
enum { WT_GU = 0, WT_NAT = 1, WT_INE = 2, WT_INO = 3 };
__device__ __forceinline__ int src_col(int type, int n0) {
    const int pn = n0 >> 8, bj = (n0 >> 7) & 1;
    if (type == WT_GU) { const int j = pn * 128 + (n0 & 127); return j < FF ? bj * FF + j : -1; }
    if (type == WT_INE) { const int t = pn >> 1, wc = (n0 >> 5) & 3; return t * 512 + ((pn & 1) * 4 + wc) * 64 + bj * 32; }
    if (type == WT_INO) { return pn < 2 ? n0 : 512 + bj * 512 + (pn - 2) * 128 + (n0 & 127); }
    return n0;
}
__device__ __forceinline__ ConvD conv_mat(int type, const float* W, int ldw, int Ksrc, const float* gain, bf16* WT, int Kdst, int Ndst, int item) {
    const int nblk = Ndst / 32, kb = item / nblk, nb = item % nblk, k0 = kb * 64, n0 = nb * 32; const int sc = src_col(type, n0);
    ConvD d; d.W = W; d.gain = gain; d.WT = WT; d.ldw = ldw; d.scol0 = sc; d.k0 = k0; d.Kdst = Kdst; d.drow0 = n0; d.valid = (sc >= 0) && (k0 < Ksrc); return d;
}
__device__ __forceinline__ ConvD conv_decode(const Args& A, Ctx& C, int it) {
    constexpr int I_GU = 16 * (NGU / 32), I_DN = (FFP / 64) * 32, I_IE = 16 * (NIE / 32), I_O = 16 * 32, I_IO = 16 * (NIO / 32);
    int r = it;
    if (r < 4 * I_GU) { const int mi = r / I_GU, l = mi >> 1, f = mi & 1; r -= mi * I_GU;
        return conv_mat(WT_GU, (f ? INF(I_F2GU) : INF(I_F1GU)) + (size_t)l * 1024 * 5504, 5504, 1024, (f ? INF(I_F2G) : INF(I_F1G)) + l * 1024, (bf16*)(GAS bf16*)(C.ws + WS_WGU + mi * WGU_BYTES), 1024, NGU, r); }
    r -= 4 * I_GU;
    if (r < 4 * I_DN) { const int mi = r / I_DN, l = mi >> 1, f = mi & 1; r -= mi * I_DN;
        return conv_mat(WT_NAT, (f ? INF(I_F2DN) : INF(I_F1DN)) + (size_t)l * FF * 1024, 1024, FF, nullptr, (bf16*)(GAS bf16*)(C.ws + WS_WDN + mi * WDN_BYTES), FFP, 1024, r); }
    r -= 4 * I_DN;
    if (r < I_IE) return conv_mat(WT_INE, INF(I_EWIN), NIE, 1024, INF(I_MIXG), (bf16*)(GAS bf16*)(C.ws + WS_WIE), 1024, NIE, r);
    r -= I_IE;
    if (r < I_O) return conv_mat(WT_NAT, INF(I_EWOUT), 1024, 1024, nullptr, (bf16*)(GAS bf16*)(C.ws + WS_WOE), 1024, 1024, r);
    r -= I_O;
    if (r < I_IO) return conv_mat(WT_INO, INF(I_OWIN), NIO, 1024, INF(I_MIXG) + 1024, (bf16*)(GAS bf16*)(C.ws + WS_WIO), 1024, NIO, r);
    r -= I_IO;
    if (r < I_O) return conv_mat(WT_NAT, INF(I_OWOUT), 1024, 1024, nullptr, (bf16*)(GAS bf16*)(C.ws + WS_WOO), 1024, 1024, r);
    r -= I_O;
    return conv_mat(WT_NAT, INF(I_CGLUW), 512, 512, nullptr, (bf16*)(GAS bf16*)(C.ws + WS_WGLU), 512, 512, r);
}
__device__ __forceinline__ void conv_load(const ConvD& d, float (&wv)[32], float& g0, int lane) {
    const int sc = d.valid ? d.scol0 : 0, kq = d.valid ? d.k0 : 0;
#pragma unroll
    for (int i = 0; i < 32; ++i) { const int kk = 2 * i + (lane >> 5); wv[i] = d.W[(size_t)(kq + kk) * d.ldw + sc + (lane & 31)]; }
    g0 = d.gain ? d.gain[kq + lane] : 1.f;
}
__device__ __forceinline__ void conv_store(const ConvD& d, const float (&wv)[32], float g0, LAS float* scr, int lane) {
    const int c = lane & 7;
#pragma unroll
    for (int i = 0; i < 32; ++i) { const int kk = 2 * i + (lane >> 5); scr[kk * 33 + (lane & 31)] = d.valid ? wv[i] * __shfl(g0, kk) : 0.f; }
    LDS_WAIT(); asm volatile("" ::: "memory");
#pragma unroll
    for (int j = 0; j < 4; ++j) { const int n = (lane >> 3) + 8 * j; const LAS float* s = scr + (8 * c) * 33 + n;
        v4u o; o.x = pk2(s[0 * 33], s[1 * 33]); o.y = pk2(s[2 * 33], s[3 * 33]); o.z = pk2(s[4 * 33], s[5 * 33]); o.w = pk2(s[6 * 33], s[7 * 33]);
        *(GAS v4u*)(d.WT + (size_t)(d.drow0 + n) * d.Kdst + d.k0 + 8 * c) = o; }
    LDS_WAIT(); asm volatile("" ::: "memory");
}
struct ConvSeg { int start, n; };
template <int R> __device__ __forceinline__ int conv_range_item(int v) {
    constexpr int I_GU = 16 * (NGU / 32), I_DN = (FFP / 64) * 32, I_IE = 16 * (NIE / 32), I_O = 16 * 32, I_IO = 16 * (NIO / 32), I_GL = 8 * 16;
    constexpr int B_DN = 4 * I_GU, B_IE = B_DN + 4 * I_DN, B_OE = B_IE + I_IE, B_IO = B_OE + I_O, B_OO = B_IO + I_IO, B_GL = B_OO + I_O;
    constexpr ConvSeg segs[4][4] = { { {0, I_GU}, {B_DN, I_DN}, {B_IE, I_IE}, {0, 0} },
                                     { {B_OE, I_O}, {I_GU, I_GU}, {B_DN + I_DN, I_DN}, {0, 0} },
                                     { {2 * I_GU, I_GU}, {B_DN + 2 * I_DN, I_DN}, {B_IO, I_IO}, {0, 0} },
                                     { {B_GL, I_GL}, {B_OO, I_O}, {3 * I_GU, I_GU}, {B_DN + 3 * I_DN, I_DN} } };
#pragma unroll
    for (int k = 0; k < 4; ++k) { if (v < segs[R][k].n) return segs[R][k].start + v; v -= segs[R][k].n; }
    return -1;
}
template <int R> __device__ __forceinline__ void conv_run(const Args& A, Ctx& C, int gw, int NGW) {
    LAS float* scr = (LAS float*)(C.lds + RING_OFF + C.wave * 16384);
    for (int v = gw; ; v += 2 * NGW) {
        const int it0 = conv_range_item<R>(v); if (it0 < 0) break;
        const int it1 = conv_range_item<R>(v + NGW); const bool two = it1 >= 0;
        const ConvD d0 = conv_decode(A, C, it0), d1 = conv_decode(A, C, two ? it1 : it0);
        float w0[32], w1[32], g0, g1;
        conv_load(d0, w0, g0, C.lane); conv_load(d1, w1, g1, C.lane);
        conv_store(d0, w0, g0, scr, C.lane);
        if (two) conv_store(d1, w1, g1, scr, C.lane);
    }
}
__device__ __forceinline__ void p0_prologue(const Args& A, Ctx& C) {
    const int gw = C.vcu * NWAVES + C.wave, NGW = C.G * NWAVES;
    conv_run<0>(A, C, gw, NGW);
    for (int m0 = gw; m0 < MT; m0 += 2 * NGW) {
        f32x4 v[2][4]; float sq[2];
#pragma unroll
        for (int u = 0; u < 2; ++u) { const int m = m0 + u * NGW; const int mc = m < MT ? m : m0;
            const float* xrow = (mc < MP) ? INF(I_XP) + (size_t)mc * 1024 : INF(I_XS) + (size_t)(mc - MP) * 1024;
            const GAS f32x4* xr = (const GAS f32x4*)xrow + C.lane; float s = 0.f;
#pragma unroll
            for (int j = 0; j < 4; ++j) { v[u][j] = xr[64 * j]; s += (v[u][j].x * v[u][j].x + v[u][j].y * v[u][j].y) + (v[u][j].z * v[u][j].z + v[u][j].w * v[u][j].w); }
            sq[u] = s; }
#pragma unroll
        for (int u = 0; u < 2; ++u) { const int m = m0 + u * NGW; if (m >= MT) break;
            const float s = wave_sum(sq[u]);
            GAS unsigned long long* o8 = (GAS unsigned long long*)(P_XB + (size_t)m * 1024) + C.lane;
#pragma unroll
            for (int j = 0; j < 4; ++j) o8[64 * j] = (unsigned long long)pk2(v[u][j].x, v[u][j].y) | ((unsigned long long)pk2(v[u][j].z, v[u][j].w) << 32);
            if (C.lane < 16) P_SS[(size_t)m * 16 + C.lane] = (C.lane == 0) ? s : 0.f; }
    }
}

#define LDS_BAR() do { asm volatile("s_waitcnt lgkmcnt(0)" ::: "memory"); __builtin_amdgcn_s_barrier(); asm volatile("" ::: "memory"); } while (0)
__device__ __forceinline__ float lam_value(const float* lv, int lane) {
    const float a = wave_sum(lv[lane] * lv[64 + lane]), b = wave_sum(lv[128 + lane] * lv[192 + lane]);
    return expf(a) - expf(b) + LAM_INIT0;
}

__device__ __forceinline__ void split_hi_lo(const f32x4 a, const f32x4 b, v4u& hi, v4u& lo) {
    hi = pack8(a, b);
    f32x4 ra, rb;
    ra[0] = a[0] - __uint_as_float(hi.x << 16); ra[1] = a[1] - __uint_as_float(hi.x & 0xffff0000u); ra[2] = a[2] - __uint_as_float(hi.y << 16); ra[3] = a[3] - __uint_as_float(hi.y & 0xffff0000u);
    rb[0] = b[0] - __uint_as_float(hi.z << 16); rb[1] = b[1] - __uint_as_float(hi.z & 0xffff0000u); rb[2] = b[2] - __uint_as_float(hi.w << 16); rb[3] = b[3] - __uint_as_float(hi.w & 0xffff0000u);
    lo = pack8(ra, rb);
}
template <bool SAMPLE>
__device__ __forceinline__ void rglru_item(const Args& A, Ctx& C, int bi, int ch, int blk) {
    LAS float* R0 = (LAS float*)(C.lds);
    LAS bf16* XH = (LAS bf16*)(C.lds);
    LAS bf16* XL = (LAS bf16*)(C.lds + 18432);
    LAS float* R1 = (LAS float*)(C.lds + 45056);
    LAS float* R2 = (LAS float*)(C.lds + 45056 + 32768);
    LAS float* RP = (LAS float*)(C.lds + 45056 + 65536);
    LAS float* RH = RP + 512;
    const int c = C.tid & 63, sub = C.wave, ch0 = blk * 64 + c, lane = C.lane, m16 = lane & 15, quad = lane >> 4;
    const int g = sub >> 2, j0 = (sub & 3) * 16;
    v4u wh[2], wl[2];
    { const float* wp = INF(I_BGW) + ((size_t)(g * 8 + blk) * 64 + quad * 8) * 64 + j0 + m16;
#pragma unroll
      for (int ks = 0; ks < 2; ++ks) { f32x4 x0, x1;
#pragma unroll
          for (int i = 0; i < 4; ++i) { x0[i] = wp[(size_t)(ks * 32 + i) * 64]; x1[i] = wp[(size_t)(ks * 32 + 4 + i) * 64]; }
          split_hi_lo(x0, x1, wh[ks], wl[ks]); } }
    const float gbias = INF(I_BGB)[g * 512 + blk * 64 + j0 + m16];
    f32x4 kw[4][4], kb[4];
    { const int cq0 = (C.tid & 3) * 16;
#pragma unroll
      for (int q = 0; q < 4; ++q) { const int cc = blk * 64 + cq0 + q * 4; kb[q] = *(const f32x4*)(INF(I_BCB) + cc);
#pragma unroll
          for (int k = 0; k < 4; ++k) kw[k][q] = *(const f32x4*)(INF(I_BCW) + k * 512 + cc); } }
    const float sp8 = -8.f * log1pf(expf(-INF(I_BLAM)[blk * 64 + j0 + m16]));
    if (!SAMPLE) {
        const int t0 = ch * 128;
#pragma unroll
        for (int e0 = 0; e0 < 131 * 16; e0 += NTHR) { const int e = e0 + C.tid; if (e >= 131 * 16) break; const int i = e >> 4, q4 = (e & 15) * 4, tk = t0 - 3 + i;
            const u32x2 w = *(const u32x2*)(P_XBF + (size_t)(bi * SEQ + (tk < 0 ? 0 : tk)) * 512 + blk * 64 + q4);
            f32x4 v = {__uint_as_float(w.x << 16), __uint_as_float(w.x & 0xffff0000u), __uint_as_float(w.y << 16), __uint_as_float(w.y & 0xffff0000u)};
            if (tk < 0) v = (f32x4){0.f, 0.f, 0.f, 0.f};
            *(LAS f32x4*)(R0 + i * 64 + q4) = v; }
    } else {
#pragma unroll
        for (int e0 = 0; e0 < 176 * 16; e0 += NTHR) { const int e = e0 + C.tid; if (e >= 176 * 16) break; const int i = e >> 4, q4 = (e & 15) * 4, sl = i / 11, k = i % 11, n = bi * 16 + sl;
            f32x4 v;
            if (k < 3) v = *(const f32x4*)(INF(I_SCB) + (size_t)(n * 3 + k) * 512 + blk * 64 + q4);
            else { const u32x2 w = *(const u32x2*)(P_XBF + (size_t)(MP + n * 8 + (k - 3)) * 512 + blk * 64 + q4); v = (f32x4){__uint_as_float(w.x << 16), __uint_as_float(w.x & 0xffff0000u), __uint_as_float(w.y << 16), __uint_as_float(w.y & 0xffff0000u)}; }
            *(LAS f32x4*)(R0 + i * 64 + q4) = v; }
    }
    LDS_BAR();
    { const int lr = C.tid >> 2, cq = (C.tid & 3) * 16; const int base = SAMPLE ? ((lr >> 3) * 11 + (lr & 7)) : lr;
      f32x4 xo[4];
#pragma unroll
      for (int q = 0; q < 4; ++q) { const int cc = cq + q * 4;
          xo[q] = kb[q] + kw[0][q] * *(const LAS f32x4*)(R0 + base * 64 + cc) + kw[1][q] * *(const LAS f32x4*)(R0 + (base + 1) * 64 + cc) + kw[2][q] * *(const LAS f32x4*)(R0 + (base + 2) * 64 + cc) + kw[3][q] * *(const LAS f32x4*)(R0 + (base + 3) * 64 + cc);
          *(LAS f32x4*)(R1 + lr * 64 + cc) = xo[q]; }
      LDS_BAR();
      v4u h0, l0, h1, l1; split_hi_lo(xo[0], xo[1], h0, l0); split_hi_lo(xo[2], xo[3], h1, l1);
      *(LAS v4u*)(XH + lr * 72 + cq) = h0; *(LAS v4u*)(XH + lr * 72 + cq + 8) = h1; *(LAS v4u*)(XL + lr * 72 + cq) = l0; *(LAS v4u*)(XL + lr * 72 + cq + 8) = l1; }
    LDS_BAR();
#pragma unroll 2
    for (int mt = 0; mt < 8; ++mt) { f32x4 acc = (f32x4){0.f, 0.f, 0.f, 0.f};
#pragma unroll
        for (int ks = 0; ks < 2; ++ks) { const int xo_ = (mt * 16 + m16) * 72 + ks * 32 + quad * 8;
            const bf16x8 ah = *(const LAS bf16x8*)(XH + xo_), al = *(const LAS bf16x8*)(XL + xo_), bh_ = __builtin_bit_cast(bf16x8, wh[ks]), bl_ = __builtin_bit_cast(bf16x8, wl[ks]);
            acc = __builtin_amdgcn_mfma_f32_16x16x32_bf16(ah, bh_, acc, 0, 0, 0); acc = __builtin_amdgcn_mfma_f32_16x16x32_bf16(al, bh_, acc, 0, 0, 0); acc = __builtin_amdgcn_mfma_f32_16x16x32_bf16(ah, bl_, acc, 0, 0, 0); }
#pragma unroll
        for (int i = 0; i < 4; ++i) { const int t = mt * 16 + quad * 4 + i, j = j0 + m16; const float sg = sigmoid_f(acc[i] + gbias);
            if (g == 0) R2[t * 64 + j] = sp8 * sg; else R1[t * 64 + j] = sg * R1[t * 64 + j]; } }
    LDS_BAR();
    if (!SAMPLE) {
        float P = 1.f, Hl = 0.f;
#pragma unroll 4
        for (int k = 0; k < 16; ++k) { const int lr = sub * 16 + k; const float la = R2[lr * 64 + c]; const float a = __expf(la), bb = __builtin_amdgcn_sqrtf(fmaxf(1.f - a * a, 0.f)) * R1[lr * 64 + c];
            R2[lr * 64 + c] = a; R1[lr * 64 + c] = bb; P *= a; Hl = a * Hl + bb; }
        RP[sub * 64 + c] = P; RH[sub * 64 + c] = Hl;
        LDS_BAR();
        float h = 0.f, cp = 1.f;
        { float rp_[7], rh_[7];
#pragma unroll
          for (int k2 = 0; k2 < 7; ++k2) { rp_[k2] = RP[k2 * 64 + c]; rh_[k2] = RH[k2 * 64 + c]; }
#pragma unroll
          for (int k2 = 0; k2 < 7; ++k2) if (k2 < sub) { h = rp_[k2] * h + rh_[k2]; cp *= rp_[k2]; } }
        const size_t row0 = (size_t)bi * SEQ + ch * 128 + sub * 16;
#pragma unroll 4
        for (int k = 0; k < 16; ++k) { const int lr = sub * 16 + k; const float a = R2[lr * 64 + c]; h = a * h + R1[lr * 64 + c]; cp *= a;
            P_HC[(row0 + k) * 512 + ch0] = pk2(h, cp); }
        if (sub == 7) { P_TOT[(size_t)(bi * 32 + ch) * 512 + ch0] = cp; P_TOT[(size_t)(128 + bi * 32 + ch) * 512 + ch0] = h; }
    } else {
#pragma unroll
        for (int s2 = 0; s2 < 2; ++s2) { const int sl = sub * 2 + s2, n = bi * 16 + sl; float h = INF(I_SHB)[(size_t)n * 512 + ch0];
#pragma unroll
            for (int t = 0; t < 8; ++t) { const int lr = sl * 8 + t; const float la = R2[lr * 64 + c]; const float a = __expf(la), bb = __builtin_amdgcn_sqrtf(fmaxf(1.f - a * a, 0.f)) * R1[lr * 64 + c];
                h = a * h + bb; const size_t row = (size_t)MP + n * 8 + t;
                const float gv = bf2f((unsigned)(unsigned short)P_GBF[row * 512 + ch0]);
                P_MIX[row * 1024 + 512 + ch0] = (bf16)f2bf(gelu_tanh_f(gv) * h); }
            C.out[O_HBS + (size_t)n * 512 + ch0] = h; }
    }
    LDS_BAR();
}
__device__ __forceinline__ void rglru_fix(const Args& A, Ctx& C, int item) {
    const int b = item >> 6, ch = (item >> 1) & 31, hf = item & 1, c = C.tid;
    float tp[31], th[31];
#pragma unroll
    for (int k = 0; k < 31; ++k) { tp[k] = P_TOT[(size_t)(b * 32 + k) * 512 + c]; th[k] = P_TOT[(size_t)(128 + b * 32 + k) * 512 + c]; }
    float hin = 0.f;
#pragma unroll
    for (int k = 0; k < 31; ++k) hin = (k < ch) ? tp[k] * hin + th[k] : hin;
    const size_t row0 = (size_t)b * SEQ + ch * 128 + hf * 64;
    float h = 0.f;
#pragma unroll 16
    for (int t = 0; t < 64; ++t) { const size_t o = (row0 + t) * 512 + c;
        const unsigned hc = P_HC[o]; h = bf2f(hc & 0xffffu) + __uint_as_float(hc & 0xffff0000u) * hin;
        P_MIX[(row0 + t) * 1024 + 512 + c] = (bf16)(pk2(gelu_tanh_f(bf2f((unsigned)(unsigned short)P_GBF[o])) * h, 0.f) & 0xffffu); }
    if (ch == 31 && hf == 1) C.out[O_HBP + (size_t)b * 512 + c] = P_TOT[(size_t)(b * 32 + 31) * 512 + c] * hin + P_TOT[(size_t)(128 + b * 32 + 31) * 512 + c];
}

__device__ __forceinline__ bf16x8 cvt8(const f32x4 a, const f32x4 b) { const v4u w = pack8(a, b); return __builtin_bit_cast(bf16x8, w); }
__device__ __forceinline__ void sattn_wave(const Args& A, Ctx& C, int n, int h, int s) {
    const int lane = C.lane, m16 = lane & 15, quad = lane >> 4, j = m16 >> 3, q = m16 & 7;
    bf16x8 bq[4];
#pragma unroll
    for (int kk = 0; kk < 4; ++kk) { bq[kk] = (bf16x8){0, 0, 0, 0, 0, 0, 0, 0};
        if (j == (kk >> 1)) bq[kk] = *(const bf16x8*)(P_Q + (size_t)(MP + n * 8 + q) * 512 + (h * 2 + j) * 64 + (kk & 1) * 32 + quad * 8); }
    float mrow = -1e30f, l = 0.f; f32x4 o[8];
#pragma unroll
    for (int dg = 0; dg < 8; ++dg) o[dg] = (f32x4){0.f, 0.f, 0.f, 0.f};
    constexpr int PPW = NPG / NSPLIT;
    const int* ptab = (const int*)(const GAS int*)A.in[I_PT] + n * NPG + s * PPW;
    const float* ckh = INF(I_CK) + h * 128; const float* cvh = INF(I_CV) + h * 128;
    const unsigned koff = (unsigned)(m16 * 512 + quad * 8);
    const unsigned voff = (unsigned)(quad * 4 * 512 + m16);
    f32x4 kq[16]; float vq[64];
#define SA_LOADK(ph_, ks_) do { const float* kb_ = ckh + ((size_t)(ph_) * PAGE + (ks_) * 32) * 512; \
        _Pragma("unroll") for (int tt = 0; tt < 2; ++tt) { const float* kr_ = kb_ + tt * 8192; asm volatile("" : "+s"(kr_)); \
            _Pragma("unroll") for (int kk = 0; kk < 4; ++kk) { kq[(tt * 4 + kk) * 2] = *(const f32x4*)(kr_ + (koff + (unsigned)(kk * 32))); kq[(tt * 4 + kk) * 2 + 1] = *(const f32x4*)(kr_ + (koff + (unsigned)(kk * 32 + 4))); } } } while (0)
#define SA_LOADV(ph_, ks_) do { const float* vb_ = cvh + ((size_t)(ph_) * PAGE + (ks_) * 32) * 512; \
        _Pragma("unroll") for (int i = 0; i < 4; ++i) { const float* v0_ = vb_ + i * 512; const float* v1_ = vb_ + (16 + i) * 512; asm volatile("" : "+s"(v0_), "+s"(v1_)); \
            _Pragma("unroll") for (int dg = 0; dg < 8; ++dg) { vq[dg * 8 + i] = v0_[voff + (unsigned)(dg * 16)]; vq[dg * 8 + 4 + i] = v1_[voff + (unsigned)(dg * 16)]; } } } while (0)
    int ph = __builtin_amdgcn_readfirstlane(ptab[0]);
    SA_LOADK(ph, 0); SA_LOADV(ph, 0);
#pragma unroll 1
    for (int pg = 0; pg < PPW; ++pg) {
        const bool lastpg = (pg + 1 == PPW); const int phn = __builtin_amdgcn_readfirstlane(ptab[lastpg ? pg : pg + 1]);
#pragma unroll 1
        for (int ks = 0; ks < 4; ++ks) {
            const int nph = (ks < 3) ? ph : phn, nks = (ks + 1) & 3; const bool more = !(lastpg && ks == 3);
            f32x4 sc2[2];
#pragma unroll
            for (int tt = 0; tt < 2; ++tt) { f32x4 acc = (f32x4){0.f, 0.f, 0.f, 0.f};
#pragma unroll
                for (int kk = 0; kk < 4; ++kk) acc = __builtin_amdgcn_mfma_f32_16x16x32_bf16(cvt8(kq[(tt * 4 + kk) * 2], kq[(tt * 4 + kk) * 2 + 1]), bq[kk], acc, 0, 0, 0);
                sc2[tt] = acc; }
            __builtin_amdgcn_sched_barrier(0);
            if (more) SA_LOADK(nph, nks);
            __builtin_amdgcn_sched_barrier(0);
            float mx = fmaxf(fmaxf(fmaxf(sc2[0][0], sc2[0][1]), fmaxf(sc2[0][2], sc2[0][3])), fmaxf(fmaxf(sc2[1][0], sc2[1][1]), fmaxf(sc2[1][2], sc2[1][3])));
            mx = fmaxf(mx, __shfl_xor(mx, 16)); mx = fmaxf(mx, __shfl_xor(mx, 32));
            const float mn = fmaxf(mrow, mx), scl = __builtin_amdgcn_exp2f(mrow - mn); mrow = mn;
            f32x4 p0, p1; float ps = 0.f;
#pragma unroll
            for (int i = 0; i < 4; ++i) { p0[i] = __builtin_amdgcn_exp2f(sc2[0][i] - mn); p1[i] = __builtin_amdgcn_exp2f(sc2[1][i] - mn); ps += p0[i] + p1[i]; }
            l = l * scl + ps;
            const bf16x8 pb = cvt8(p0, p1);
#pragma unroll
            for (int dg = 0; dg < 8; ++dg) { const f32x4 v0 = {vq[dg * 8], vq[dg * 8 + 1], vq[dg * 8 + 2], vq[dg * 8 + 3]}, v1 = {vq[dg * 8 + 4], vq[dg * 8 + 5], vq[dg * 8 + 6], vq[dg * 8 + 7]};
                o[dg] = o[dg] * scl; o[dg] = __builtin_amdgcn_mfma_f32_16x16x32_bf16(cvt8(v0, v1), pb, o[dg], 0, 0, 0); }
            __builtin_amdgcn_sched_barrier(0);
            if (more) SA_LOADV(nph, nks);
            __builtin_amdgcn_sched_barrier(0);
        }
        ph = phn;
    }
#undef SA_LOADK
#undef SA_LOADV
    l += __shfl_xor(l, 16); l += __shfl_xor(l, 32);
    float* pr = P_PART + ((size_t)((n * 4 + h) * NSPLIT + s) * 16 + m16) * PSTR;
#pragma unroll
    for (int dg = 0; dg < 8; ++dg) *(f32x4*)(pr + dg * 16 + quad * 4) = o[dg];
    if (quad == 0) { pr[128] = mrow; pr[129] = l; }
}

__device__ __forceinline__ void p5_combine(const Args& A, Ctx& C) {
    const int gw = C.vcu * NWAVES + C.wave, NGW = C.G * NWAVES, lane = C.lane;
    const float lam = lam_value(INF(I_ALAM), lane);
    const float osc = 1.f - LAM_INIT0;
    for (int it = C.vcu; it < 256; it += C.G) rglru_fix(A, C, it);
    {
        const int hh = lane >> 4, e0 = (lane & 15) * 8;
        const f32x4 g0 = *(const f32x4*)(INF(I_AHG) + e0), g1 = *(const f32x4*)(INF(I_AHG) + e0 + 4);
        for (int r = gw; r < MP; r += NGW) {
            const v4u a = *(const v4u*)(P_O2 + (size_t)r * 1024 + hh * 128 + e0), b = *(const v4u*)(P_O2 + (size_t)r * 1024 + 512 + hh * 128 + e0);
            const unsigned aw[4] = {a.x, a.y, a.z, a.w}, bw[4] = {b.x, b.y, b.z, b.w}; float d[8]; float q = 0.f;
#pragma unroll
            for (int i = 0; i < 4; ++i) { d[2 * i] = bf2f(aw[i] & 0xffffu) - lam * bf2f(bw[i] & 0xffffu); d[2 * i + 1] = bf2f(aw[i] >> 16) - lam * bf2f(bw[i] >> 16); q += d[2 * i] * d[2 * i] + d[2 * i + 1] * d[2 * i + 1]; }
            q += __shfl_xor(q, 1); q += __shfl_xor(q, 2); q += __shfl_xor(q, 4); q += __shfl_xor(q, 8);
            const float rs = rsqrtf(q * (1.f / 128.f) + EPS) * osc;
            f32x4 o0, o1;
#pragma unroll
            for (int i = 0; i < 4; ++i) { o0[i] = d[i] * rs * g0[i]; o1[i] = d[4 + i] * rs * g1[i]; }
            *(v4u*)(P_MIX + (size_t)r * 1024 + hh * 128 + e0) = pack8(o0, o1);
        }
    }
    {
        const int jh = lane >> 5, el = lane & 31, e0 = el * 4;
        const f32x4 hg = *(const f32x4*)(INF(I_AHG) + e0);
        for (int it = gw; it < NS * 4 * 8; it += NGW) {
            const int n = it >> 5, h = (it >> 3) & 3;
            const float* pbase = P_PART + ((size_t)(n * 4 + h) * NSPLIT * 16) * PSTR;
            { const int q = it & 7;
                const int row = jh * 8 + q;
                float ms[NSPLIT], ls[NSPLIT]; float M = -1e30f;
#pragma unroll
                for (int s = 0; s < NSPLIT; ++s) { const float* pr = pbase + ((size_t)s * 16 + row) * PSTR; ms[s] = pr[128]; ls[s] = pr[129]; M = fmaxf(M, ms[s]); }
                const unsigned qw = *(const unsigned*)(P_Q + (size_t)(MP + n * 8 + q) * 512 + (h * 2 + jh) * 64 + el * 2);
                const float q0 = bf2f(qw & 0xffffu), q1 = bf2f(qw >> 16);
                float sc[8];
#pragma unroll
                for (int t = 0; t < 8; ++t) { const f32x2 kv = *(const f32x2*)(C.out + O_KS + (size_t)(n * 8 + t) * 512 + (h * 2 + jh) * 64 + el * 2);
                    float d = q0 * kv.x + q1 * kv.y;
#pragma unroll
                    for (int o = 1; o < 32; o <<= 1) d += __shfl_xor(d, o);
                    sc[t] = (t <= q) ? d : -1e30f; M = fmaxf(M, sc[t]); }
                float L = 0.f; f32x4 O = (f32x4){0.f, 0.f, 0.f, 0.f};
#pragma unroll
                for (int s = 0; s < NSPLIT; ++s) { const float w = exp2f(ms[s] - M); L += ls[s] * w; O = O + *(const f32x4*)(pbase + ((size_t)s * 16 + row) * PSTR + e0) * w; }
#pragma unroll
                for (int t = 0; t < 8; ++t) { const float p = (t <= q) ? exp2f(sc[t] - M) : 0.f; L += p; O = O + *(const f32x4*)(C.out + O_VS + (size_t)(n * 8 + t) * 512 + h * 128 + e0) * p; }
                O = O * (1.f / L);
                f32x4 other;
#pragma unroll
                for (int i = 0; i < 4; ++i) other[i] = __shfl_xor(O[i], 32);
                f32x4 att = (jh == 0) ? (O - other * lam) : (other - O * lam);
                float qq = (att[0] * att[0] + att[1] * att[1]) + (att[2] * att[2] + att[3] * att[3]);
#pragma unroll
                for (int o = 1; o < 32; o <<= 1) qq += __shfl_xor(qq, o);
                const float rs = rsqrtf(qq * (1.f / 128.f) + EPS) * osc;
                if (jh == 0) { u32x2 w; w.x = pk2(att[0] * rs * hg[0], att[1] * rs * hg[1]); w.y = pk2(att[2] * rs * hg[2], att[3] * rs * hg[3]);
                    *(u32x2*)(P_MIX + (size_t)(MP + n * 8 + q) * 1024 + h * 128 + e0) = w; }
            }
        }
    }
}

__device__ __forceinline__ void sincos_f(float x, float& sn, float& cs) {
    const float k = rintf(x * 0.63661977236758134f);
    float r = fmaf(-k, 1.5707963705062866f, x); r = fmaf(-k, -4.3711388286737929e-8f, r);
    const float r2 = r * r;
    const float s = r + r * r2 * (-1.6666654611e-1f + r2 * (8.3321608736e-3f + r2 * (-1.9515295891e-4f)));
    const float c = 1.f - 0.5f * r2 + r2 * r2 * (4.166664568298827e-2f + r2 * (-1.388731625493765e-3f + r2 * 2.443315711809948e-5f));
    const int qd = ((int)k) & 3;
    sn = (qd == 0) ? s : (qd == 1) ? c : (qd == 2) ? -s : -c;
    cs = (qd == 0) ? c : (qd == 1) ? -s : (qd == 2) ? -c : s;
}
__device__ __forceinline__ void s5_consts(const Args& A, int g, int p, float& ar, float& ai, float& cr, float& ci) {
    const float dt = expf(INF(I_CLDT)[g]), are = INF(I_CARE)[g * 64 + p], aim = INF(I_CAIM)[g * 64 + p];
    const float mag = expf(dt * are); float sn, cs; sincos_f(dt * aim, sn, cs);
    ar = mag * cs; ai = mag * sn;
    const float den = are * are + aim * aim, nr = ar - 1.f;
    cr = (nr * are + ai * aim) / den; ci = (ai * are - nr * aim) / den;
}
template <bool SAMPLE>
__device__ __forceinline__ void s5_item(const Args& A, Ctx& C, int bi, int g) {
    LAS float* BU = (LAS float*)(C.lds);
    LAS bf16* S16 = (LAS bf16*)(C.lds + 67584);
    LAS bf16* UB = (LAS bf16*)(C.lds + 67584 + 34816);
    LAS f32x2* Lc = (LAS f32x2*)(C.lds + 67584 + 34816 + 20480);
    LAS f32x2* Ic = Lc + 896;
    static_assert(67584 + 34816 + 20480 + 7168 + 1024 <= RING_BYTES, "S5 LDS map");
    const int p = C.tid & 63, sub = C.wave, lane = C.lane, m16 = lane & 15, quad = lane >> 4;
    float ar, ai;
    { float cr, ci; s5_consts(A, g, p, ar, ai, cr, ci); ((LAS f32x2*)BU)[sub * 64 + p] = (f32x2){cr, ci}; }
    asm volatile("s_waitcnt lgkmcnt(0)" ::: "memory");
    bf16x4 bh[8];
#pragma unroll
    for (int nt = 0; nt < 8; ++nt) { const int n = nt * 16 + m16, pn = n >> 1; const f32x2 cc = ((const LAS f32x2*)BU)[sub * 64 + pn]; const float cr = cc.x, ci = cc.y;
      const f32x4 r0 = *(const f32x4*)(INF(I_CBRE) + ((size_t)g * 64 + pn) * 16 + quad * 4), i0 = *(const f32x4*)(INF(I_CBIM) + ((size_t)g * 64 + pn) * 16 + quad * 4);
      const f32x4 x0 = ((n & 1) == 0) ? (r0 * cr - i0 * ci) : (i0 * cr + r0 * ci);
      u32x2 w; w.x = pk2(x0[0], x0[1]); w.y = pk2(x0[2], x0[3]); bh[nt] = __builtin_bit_cast(bf16x4, w); }
    LDS_BAR();
    bf16x8 cf[4];
#pragma unroll
    for (int ks = 0; ks < 4; ++ks) { const size_t co = ((size_t)g * 16 + m16) * 64 + ks * 16 + quad * 4;
        const f32x4 xr = *(const f32x4*)(INF(I_CCRE) + co), xi = *(const f32x4*)(INF(I_CCIM) + co);
        cf[ks] = cvt8((f32x4){xr[0], -xi[0], xr[1], -xi[1]}, (f32x4){xr[2], -xi[2], xr[3], -xi[3]}); }
    const float dch = INF(I_CD)[g * 16 + m16];
    const size_t gbase = SAMPLE ? (size_t)MP + bi * 128 : (size_t)bi * SEQ;
    const int urow = C.tid >> 2, uq = (C.tid & 3) * 4;
    u32x2 uqv[4];
#define WAVE_LDS() asm volatile("s_waitcnt lgkmcnt(0)" ::: "memory")
#define S5_LOAD(j, chn) uqv[j] = *(const u32x2*)(P_U + (gbase + (size_t)(chn) * 128 + urow) * 512 + g * 16 + uq)
#define S5_PUT_U(buf, j) do { *(LAS u32x2*)(UB + (buf) * 2560 + urow * 20 + uq) = uqv[j]; } while (0)
#define S5_BP(buf) do { const bf16x4 ua = *(const LAS bf16x4*)(UB + (buf) * 2560 + (sub * 16 + m16) * 20 + quad * 4); \
        _Pragma("unroll") for (int nt = 0; nt < 8; ++nt) { \
            const f32x4 acc = __builtin_amdgcn_mfma_f32_16x16x16bf16_1k(ua, bh[nt], (f32x4){0.f, 0.f, 0.f, 0.f}, 0, 0, 0); \
            _Pragma("unroll") for (int i = 0; i < 4; ++i) BU[(sub * 16 + quad * 4 + i) * 132 + nt * 16 + m16] = acc[i]; } } while (0)
#define S5_CP(buf, grow0_) do { f32x4 acc = (f32x4){0.f, 0.f, 0.f, 0.f}; \
        _Pragma("unroll") for (int ks = 0; ks < 4; ++ks) acc = __builtin_amdgcn_mfma_f32_16x16x32_bf16(*(const LAS bf16x8*)(S16 + (sub * 16 + m16) * 136 + ks * 32 + quad * 8), cf[ks], acc, 0, 0, 0); \
        _Pragma("unroll") for (int i = 0; i < 4; ++i) { const int t = sub * 16 + quad * 4 + i; \
            const float y = acc[i] + dch * bf2f(UB[(buf) * 2560 + t * 20 + m16]); P_Z[((grow0_) + t) * 512 + g * 16 + m16] = (bf16)(pk2(gelu_tanh_f(y), 0.f) & 0xffffu); } } while (0)
#define S5_STEP1(sr_, si_, vx_, vy_) do { const float nr_ = fmaf(ar, sr_, fmaf(-ai, si_, (vx_))), ni_ = fmaf(ar, si_, fmaf(ai, sr_, (vy_))); sr_ = nr_; si_ = ni_; } while (0)
    if (SAMPLE) {
        S5_LOAD(0, 0); S5_PUT_U(0, 0);
        WAVE_LDS();
        S5_BP(0);
        WAVE_LDS();
#pragma unroll
        for (int s2 = 0; s2 < 2; ++s2) { const int sl = sub * 2 + s2, n = bi * 16 + sl;
            float sr = INF(I_SCRE)[(size_t)(n * 32 + g) * 64 + p], si = INF(I_SCIM)[(size_t)(n * 32 + g) * 64 + p];
#pragma unroll
            for (int t8 = 0; t8 < 8; ++t8) { const int t = sl * 8 + t8; const f32x2 v = *(const LAS f32x2*)(BU + t * 132 + 2 * p); S5_STEP1(sr, si, v.x, v.y);
                *(LAS unsigned*)(S16 + t * 136 + 2 * p) = pk2(sr, si); }
            C.out[O_CRES + (size_t)(n * 32 + g) * 64 + p] = sr; C.out[O_CIMS + (size_t)(n * 32 + g) * 64 + p] = si; }
        WAVE_LDS();
        S5_CP(0, gbase);
    } else {
        float pwr[16], pwi[16];
        pwr[0] = ar; pwi[0] = ai;
#pragma unroll
        for (int k = 1; k < 16; ++k) { pwr[k] = pwr[k - 1] * ar - pwi[k - 1] * ai; pwi[k] = pwr[k - 1] * ai + pwi[k - 1] * ar; }
        if (C.tid < 128) Ic[C.tid] = (f32x2){0.f, 0.f};
        float slr[16], sli[16];
#define S5_SCAN_A(lbuf) do { float sr = 0.f, si = 0.f; \
        _Pragma("unroll") for (int k = 0; k < 16; ++k) { const f32x2 v = *(const LAS f32x2*)(BU + (sub * 16 + k) * 132 + 2 * p); S5_STEP1(sr, si, v.x, v.y); slr[k] = sr; sli[k] = si; } \
        if (sub < 7) Lc[(lbuf) * 448 + sub * 64 + p] = (f32x2){sr, si}; } while (0)
#define S5_CARRY_B(cur_, ch_) do { const f32x2 q0 = Ic[(cur_) * 64 + p]; float qr = q0.x, qi = q0.y; \
        _Pragma("unroll") for (int k2 = 0; k2 < 7; ++k2) { const f32x2 l_ = Lc[(cur_) * 448 + k2 * 64 + p]; const float nr_ = fmaf(pwr[15], qr, fmaf(-pwi[15], qi, l_.x)), ni_ = fmaf(pwr[15], qi, fmaf(pwi[15], qr, l_.y)); qr = (k2 < sub) ? nr_ : qr; qi = (k2 < sub) ? ni_ : qi; } \
        float sr = 0.f, si = 0.f; \
        _Pragma("unroll") for (int k = 0; k < 16; ++k) { const int t = sub * 16 + k; sr = fmaf(pwr[k], qr, fmaf(-pwi[k], qi, slr[k])); si = fmaf(pwr[k], qi, fmaf(pwi[k], qr, sli[k])); \
            *(LAS unsigned*)(S16 + t * 136 + 2 * p) = pk2(sr, si); } \
        if (sub == 7) { Ic[((cur_) ^ 1) * 64 + p] = (f32x2){sr, si}; \
            if ((ch_) == 31) { C.out[O_CREP + (size_t)(bi * 32 + g) * 64 + p] = sr; C.out[O_CIMP + (size_t)(bi * 32 + g) * 64 + p] = si; } } } while (0)
        S5_LOAD(0, 0); S5_LOAD(1, 1); S5_LOAD(2, 2); S5_LOAD(3, 3);
        S5_PUT_U(0, 0); S5_PUT_U(1, 1);
        S5_LOAD(0, 4); S5_LOAD(1, 5);
        WAVE_LDS();
        S5_BP(0);
        WAVE_LDS();
#pragma unroll 1
        for (int c4 = 0; c4 < 32; c4 += 4) {
#define S5_STEP(J_) do { const int ch = c4 + (J_); constexpr int cur = (J_) & 1; \
            S5_SCAN_A(cur); \
            if (ch + 1 < 32) { S5_BP(cur ^ 1); } \
            LDS_BAR(); \
            S5_CARRY_B(cur, ch); \
            WAVE_LDS(); \
            S5_CP(cur, gbase + (size_t)ch * 128); \
            if (ch + 2 < 32) S5_PUT_U(cur, ((J_) + 2) & 3); \
            if (ch + 6 < 32) S5_LOAD(((J_) + 2) & 3, ch + 6); \
            } while (0)
            S5_STEP(0); S5_STEP(1); S5_STEP(2); S5_STEP(3);
#undef S5_STEP
        }
#undef S5_SCAN_A
#undef S5_CARRY_B
    }
    LDS_BAR();
#undef S5_STEP1
#undef S5_BP
#undef S5_CP
#undef S5_PUT_U
#undef S5_LOAD
#undef WAVE_LDS
}

template <bool SAMPLE>
__device__ __forceinline__ void conf_item(const Args& A, Ctx& C, int bi, int tb) {
    constexpr int NT = SAMPLE ? 8 : 16, NI = NT + 30;
    LAS float* L = (LAS float*)(C.lds);
    LAS float* Cc = (LAS float*)(C.lds + 94208);
    const int c = C.tid;
    float w[31];
#pragma unroll
    for (int k = 0; k < 31; ++k) w[k] = INF(I_DCW)[k * 512 + c];
    const float cb = INF(I_DCB)[c];
    const int t0 = tb * 16;
#pragma unroll
    for (int e0 = 0; e0 < NI * 128; e0 += NTHR) { const int e = e0 + C.tid; if (e >= NI * 128) break; const int i = e >> 7, q4 = (e & 127) * 4; f32x4 v;
        if (!SAMPLE) { v = (f32x4){0.f, 0.f, 0.f, 0.f}; }
        else { if (i < 30) { v = *(const f32x4*)(INF(I_SCD) + (size_t)(bi * 30 + i) * 512 + q4); if (i >= 8) *(f32x4*)(C.out + O_CDS + (size_t)(bi * 30 + (i - 8)) * 512 + q4) = v; }
            else { const u32x2 w = *(const u32x2*)(P_GG + (size_t)(MP + bi * 8 + (i - 30)) * 512 + q4); v = (f32x4){__uint_as_float(w.x << 16), __uint_as_float(w.x & 0xffff0000u), __uint_as_float(w.y << 16), __uint_as_float(w.y & 0xffff0000u)}; } }
        *(LAS f32x4*)(L + i * 512 + q4) = v; }
    LDS_BAR();
#pragma unroll 1
    for (int t = 0; t < NT; t += 2) { float a0 = cb, a1 = cb; const LAS float* lp = L + t * 512 + c;
#pragma unroll
        for (int k = 0; k < 32; ++k) { const float x = lp[k * 512]; if (k < 31) a0 += w[k] * x; if (k >= 1) a1 += w[k - 1] * x; }
        Cc[t * 512 + c] = a0; Cc[(t + 1) * 512 + c] = a1; }
    LDS_BAR();
    { const int lane = C.lane; const f32x4 g0 = *(const f32x4*)(INF(I_DLNG) + lane * 8), g1 = *(const f32x4*)(INF(I_DLNG) + lane * 8 + 4), b0 = *(const f32x4*)(INF(I_DLNB) + lane * 8), b1 = *(const f32x4*)(INF(I_DLNB) + lane * 8 + 4);
      constexpr int TPW = NT / 8;
#pragma unroll 1
      for (int k = 0; k < TPW; ++k) { const int t = C.wave * TPW + k;
          f32x4 x0 = *(const LAS f32x4*)(Cc + t * 512 + lane * 8), x1 = *(const LAS f32x4*)(Cc + t * 512 + lane * 8 + 4);
          const float mean = wave_sum((x0[0] + x0[1]) + (x0[2] + x0[3]) + (x1[0] + x1[1]) + (x1[2] + x1[3])) * (1.f / 512.f);
          x0 = x0 - mean; x1 = x1 - mean;
          const float var = wave_sum((x0[0] * x0[0] + x0[1] * x0[1]) + (x0[2] * x0[2] + x0[3] * x0[3]) + (x1[0] * x1[0] + x1[1] * x1[1]) + (x1[2] * x1[2] + x1[3] * x1[3])) * (1.f / 512.f);
          const float rs = rsqrtf(var + EPS); f32x4 o0, o1;
#pragma unroll
          for (int i = 0; i < 4; ++i) { const float y0 = x0[i] * rs * g0[i] + b0[i], y1 = x1[i] * rs * g1[i] + b1[i]; o0[i] = y0 * sigmoid_f(y0); o1[i] = y1 * sigmoid_f(y1); }
          const size_t row = SAMPLE ? (size_t)MP + bi * 8 + t : (size_t)bi * SEQ + t0 + t;
          *(v4u*)(P_MIX + row * 1024 + 512 + lane * 8) = pack8(o0, o1); } }
    LDS_BAR();
}

__device__ __forceinline__ void conf_item_p(const Args& A, Ctx& C, int bi, int tb) {
    constexpr int NT = 32, NI = NT + 30;
    LAS bf16* L = (LAS bf16*)(C.lds);
    LAS float* Cc = (LAS float*)(C.lds + 65536);
    const int cp = C.tid & 255, th = C.tid >> 8;
    const int t0 = tb * NT;
    { const bf16* gb_ = P_GG + (size_t)bi * SEQ * 512; asm volatile("" : "+s"(gb_));
#pragma unroll
      for (int e0 = 0; e0 < NI * 64; e0 += NTHR) { const int e = e0 + C.tid; if (e >= NI * 64) break; const int i = e >> 6, q8 = (e & 63) * 8; const int tk = t0 - 30 + i;
        v4u v = *(const v4u*)(gb_ + (unsigned)((tk < 0 ? 0 : tk) * 512 + q8)); if (tk < 0) v = (v4u){0u, 0u, 0u, 0u};
        *(LAS v4u*)(L + e * 8) = v; } }
    f32x2 wv[31];
#pragma unroll
    for (int k = 0; k < 31; ++k) wv[k] = *(const f32x2*)(INF(I_DCW) + k * 512 + 2 * cp);
    const f32x2 cb = *(const f32x2*)(INF(I_DCB) + 2 * cp);
    LDS_BAR();
#pragma unroll 1
    for (int r = 0; r < 2; ++r) { f32x2 a[8];
#pragma unroll
        for (int t = 0; t < 8; ++t) a[t] = cb;
        const LAS bf16* lp = L + (th * 16 + r * 8) * 512 + 2 * cp;
#pragma unroll
        for (int j = 0; j < 38; ++j) { const unsigned xb = *(const LAS unsigned*)(lp + j * 512); const f32x2 x = {__uint_as_float(xb << 16), __uint_as_float(xb & 0xffff0000u)};
#pragma unroll
            for (int t = 0; t < 8; ++t) if (j - t >= 0 && j - t <= 30) a[t] = __builtin_elementwise_fma(wv[j - t], x, a[t]); }
#pragma unroll
        for (int t = 0; t < 8; ++t) *(LAS f32x2*)(Cc + (th * 16 + r * 8 + t) * 512 + 2 * cp) = a[t]; }
    LDS_BAR();
    { const int lane = C.lane; const f32x4 g0 = *(const f32x4*)(INF(I_DLNG) + lane * 8), g1 = *(const f32x4*)(INF(I_DLNG) + lane * 8 + 4), b0 = *(const f32x4*)(INF(I_DLNB) + lane * 8), b1 = *(const f32x4*)(INF(I_DLNB) + lane * 8 + 4);
#pragma unroll 1
      for (int k = 0; k < NT / 8; ++k) { const int t = C.wave * (NT / 8) + k;
          f32x4 x0 = *(const LAS f32x4*)(Cc + t * 512 + lane * 8), x1 = *(const LAS f32x4*)(Cc + t * 512 + lane * 8 + 4);
          const float mean = wave_sum((x0[0] + x0[1]) + (x0[2] + x0[3]) + (x1[0] + x1[1]) + (x1[2] + x1[3])) * (1.f / 512.f);
          x0 = x0 - mean; x1 = x1 - mean;
          const float var = wave_sum((x0[0] * x0[0] + x0[1] * x0[1]) + (x0[2] * x0[2] + x0[3] * x0[3]) + (x1[0] * x1[0] + x1[1] * x1[1]) + (x1[2] * x1[2] + x1[3] * x1[3])) * (1.f / 512.f);
          const float rs = rsqrtf(var + EPS); f32x4 o0, o1;
#pragma unroll
          for (int i = 0; i < 4; ++i) { const float y0 = x0[i] * rs * g0[i] + b0[i], y1 = x1[i] * rs * g1[i] + b1[i]; o0[i] = y0 * sigmoid_f(y0); o1[i] = y1 * sigmoid_f(y1); }
          const size_t row = (size_t)bi * SEQ + t0 + t;
          *(v4u*)(P_MIX + row * 1024 + 512 + lane * 8) = pack8(o0, o1); } }
    LDS_BAR();
}

#ifndef MK_N_LAUNCHES
#define MK_N_LAUNCHES 1
#endif
constexpr int N_PHASES = 17;
constexpr int N_LAUNCHES = MK_N_LAUNCHES;
static_assert(N_LAUNCHES == 1 || N_LAUNCHES == N_PHASES, "MK_N_LAUNCHES is 1 or 17");
#ifndef MK_GRP_A
#define MK_GRP_A 4
#endif

#define Q_LOOP(cw, N, var, ...) do { for (;;) { __syncthreads(); if (C.tid == 0) C.MISC[16] = __hip_atomic_fetch_add(C.ctl + (cw), 1u, RLX_AGENT); __syncthreads(); \
            const int var = (int)__builtin_amdgcn_readfirstlane(C.MISC[16]); if (var >= (N)) break; \
            __VA_ARGS__ } } while (0)

template <int LO, int HI> __global__ void __launch_bounds__(NTHR, 2) mega_fwd(Args args) {
    extern __shared__ __attribute__((aligned(16))) unsigned char lds[];
    const Args& A = args;
    Ctx C;
    C.lds = (LAS unsigned char*)lds; C.MISC = (volatile LAS unsigned*)(C.lds + MISC_OFF);
    C.tid = threadIdx.x; C.lane = C.tid & 63; C.wave = __builtin_amdgcn_readfirstlane(C.tid >> 6);
    C.G = gridDim.x; { const int bx = blockIdx.x; C.vcu = (C.G % 8 == 0) ? (bx % 8) * (C.G / 8) + bx / 8 : bx; }
    GAS unsigned char* ws = (GAS unsigned char*)args.ws; C.ws = ws; C.out = (GAS float*)args.out; C.ctl = (gu32*)(ws + WS_CTL);
    for (int u = C.tid; u < (LDS_BYTES - LDSCTL_OFF) / 4; u += NTHR) ((LAS unsigned*)(C.lds + LDSCTL_OFF))[u] = 0u;
    __syncthreads();
    XcdBarrier bar; bar.bar = (unsigned*)(C.ctl + CW_BAR); bar.x = 0; bar.st = nullptr;
    if (HI - LO > 1) bar = xcd_barrier_post((unsigned*)(C.ctl + CW_BAR), C.MISC + 8);
#define IN(k) (LO <= (k) && (k) < HI)
#define PH(k) if (IN(k))
#define END_PH(k) do { if (IN(k) && IN((k) + 1)) xcd_barrier(bar); } while (0)
    LAS unsigned char* ring = C.lds + RING_OFF;
    GAS float* X = C.out;
#define PHASE_BEGIN() do { int t_ = threadIdx.x; asm volatile("" : "+v"(t_)); C.tid = t_; C.lane = t_ & 63; C.wave = __builtin_amdgcn_readfirstlane(t_ >> 6); \
        unsigned char* w_ = args.ws; asm volatile("" : "+s"(w_)); C.ws = (GAS unsigned char*)w_; ws = C.ws; C.ctl = (gu32*)C.ws; float* o_ = args.out; asm volatile("" : "+s"(o_)); C.out = (GAS float*)o_; X = C.out; } while (0)

    PH(0) { PHASE_BEGIN(); p0_prologue(args, C); END_PH(0); }

#define FFN_UP(ph, mi, cslot) PH(ph) { PHASE_BEGIN(); pg8::Gemm g{P_XB, (const bf16*)(GAS bf16*)(ws + WS_WGU + (mi) * WGU_BYTES), MT, NGU, 1024}; pg8::StaticOrder S; S.init(MT, NGU, C.G, (int)blockIdx.x); \
        LAS float* tab_ = (LAS float*)(C.lds + RSTAB_OFF); rstd_table_fill(tab_, P_SS, S, C.tid); EpiSwiGLU E{P_H, tab_}; pg8::gemm_phase<EpiSwiGLU, pg8::StaticOrder, true, true>(ring, g, S, E); \
        if ((cslot) >= 0) { const int nwg_ = (MT / 256) * (NGU / 256), rounds_ = (nwg_ + C.G - 1) / C.G, first_idle_ = nwg_ - (rounds_ - 1) * C.G;     \
            if ((int)blockIdx.x >= first_idle_) { PHASE_BEGIN(); conv_run<((cslot) < 0 ? 1 : (cslot))>(args, C, ((int)blockIdx.x - first_idle_) * NWAVES + C.wave, (C.G - first_idle_) * NWAVES); } } \
        END_PH(ph); }
#define GEMM_RESID(ph, Aptr, KK, Wptr, scale, wxb, XinP, XinS) PH(ph) { PHASE_BEGIN(); pg8::Gemm g{Aptr, Wptr, MP, 1024, KK}; pg8::StaticOrder S; S.init(MP, 1024, C.G, (int)blockIdx.x); \
        EpiResid E{XinP, X, P_XB, P_SS, scale, 1.f / (scale), wxb}; pg8::gemm_phase<EpiResid, pg8::StaticOrder, true, true>(ring, g, S, E); \
        gemm_small_resid<KK>((Aptr) + (size_t)MP * (KK), Wptr, XinS, X + (size_t)MP * 1024, P_XB + (size_t)MP * 1024, P_SS + (size_t)MP * 16, scale, (wxb) != 0, ring, C.G, (int)blockIdx.x, C.tid); \
        END_PH(ph); }

    FFN_UP(1, 0, 1)
    GEMM_RESID(2, P_H, FFP, (const bf16*)(GAS bf16*)(ws + WS_WDN + 0 * WDN_BYTES), 0.5f, 1, (const GAS float*)args.in[I_XP], (const GAS float*)args.in[I_XS])
    PH(3) { PHASE_BEGIN(); pg8::Gemm g{P_XB, (const bf16*)(GAS bf16*)(ws + WS_WIE), MT, NIE, 1024}; pg8::StaticOrder S; S.init(MT, NIE, C.G, (int)blockIdx.x);
        LAS float* tab_ = (LAS float*)(C.lds + RSTAB_OFF); rstd_table_fill(tab_, P_SS, S, C.tid);
        EpiInEven E{P_Q, P_K, P_V, P_XBF, P_GBF, (float*)(C.out + O_KP), (float*)(C.out + O_VP), (float*)(C.out + O_KS), (float*)(C.out + O_VS), (float*)(C.out + O_CBP), (float*)(C.out + O_CBS), tab_, INF(I_AQG), INF(I_AKG)};
        pg8::gemm_phase<EpiInEven, pg8::StaticOrder, true, true>(ring, g, S, E); END_PH(3); }
    PH(4) {
        const bool grp_a = (int)((blockIdx.x >> 3) & 7) < MK_GRP_A;
#pragma unroll 1
        for (int pass = 0; pass < 2; ++pass) {
            PHASE_BEGIN();
            if (pass == 1 || grp_a) Q_LOOP(CW_Q0 + 128, 256, a, sattn_wave(args, C, a >> 3, (a >> 1) & 3, (a & 1) * 8 + C.wave););
            if (pass == 0) {
                PHASE_BEGIN();
                Q_LOOP(CW_Q0 + 192, 16, a, rglru_item<true>(args, C, a & 1, 0, a >> 1););
                PHASE_BEGIN();
                Q_LOOP(CW_Q0, 1024, it, rglru_item<false>(args, C, it >> 8, (it >> 3) & 31, it & 7););
                PHASE_BEGIN();
                Q_LOOP(CW_Q0 + 64, 1024, a, { const int qb = 15 - (a >> 6), b = (a & 63) >> 4, vh = a & 15, h = vh >> 2, j = (vh >> 1) & 1, half = vh & 1;
                    attn_body::attn_unit<8>(b, (h * 2 + j) * 64, h * 128 + half * 64, j * 512 + h * 128 + half * 64, qb, (const attn_body::bf16*)P_Q, (const attn_body::bf16*)P_K, (const attn_body::bf16*)P_V, (attn_body::bf16*)P_O2, (char*)lds + RING_OFF); });
            }
        }
        END_PH(4);
    }
    PH(5) { PHASE_BEGIN(); p5_combine(args, C); END_PH(5); }
    GEMM_RESID(6, P_MIX, 1024, (const bf16*)(GAS bf16*)(ws + WS_WOE), 1.0f, 1, (const GAS float*)X, (const GAS float*)(X + (size_t)MP * 1024))
    FFN_UP(7, 1, 2)
    GEMM_RESID(8, P_H, FFP, (const bf16*)(GAS bf16*)(ws + WS_WDN + 1 * WDN_BYTES), 0.5f, 1, (const GAS float*)X, (const GAS float*)(X + (size_t)MP * 1024))

    FFN_UP(9, 2, 3)
    GEMM_RESID(10, P_H, FFP, (const bf16*)(GAS bf16*)(ws + WS_WDN + 2 * WDN_BYTES), 0.5f, 1, (const GAS float*)X, (const GAS float*)(X + (size_t)MP * 1024))
    PH(11) { PHASE_BEGIN(); pg8::Gemm g{P_XB, (const bf16*)(GAS bf16*)(ws + WS_WIO), MT, NIO, 1024}; pg8::StaticOrder S; S.init(MT, NIO, C.G, (int)blockIdx.x);
        LAS float* tab_ = (LAS float*)(C.lds + RSTAB_OFF); rstd_table_fill(tab_, P_SS, S, C.tid); EpiInOdd E{P_U, P_GG, tab_, (float*)(C.out + O_CDP), (float*)(C.out + O_CDS)}; pg8::gemm_phase<EpiInOdd, pg8::StaticOrder, true, true>(ring, g, S, E); END_PH(11); }
    PH(12) {
        PHASE_BEGIN();
        Q_LOOP(CW_Q1, 128, it, s5_item<false>(args, C, it >> 5, it & 31););
        PHASE_BEGIN();
        Q_LOOP(CW_Q1 + 64, 64, a, s5_item<true>(args, C, a & 1, a >> 1););
        PHASE_BEGIN();
        Q_LOOP(CW_Q1 + 192, 32, a, conf_item<true>(args, C, a, 0););
        PHASE_BEGIN();
        Q_LOOP(CW_Q1 + 128, 512, a, conf_item_p(args, C, a >> 7, a & 127););
        END_PH(12);
    }
    PH(13) { PHASE_BEGIN(); pg8::Gemm g{P_Z, (const bf16*)(GAS bf16*)(ws + WS_WGLU), MT, 512, 512}; pg8::StaticOrder S; S.init(MT, 512, C.G, (int)blockIdx.x);
        EpiGLU E{P_Z, P_MIX, INF(I_CGLUB)}; pg8::gemm_phase<EpiGLU, pg8::StaticOrder, true, true>(ring, g, S, E); END_PH(13); }
    GEMM_RESID(14, P_MIX, 1024, (const bf16*)(GAS bf16*)(ws + WS_WOO), 1.0f, 1, (const GAS float*)X, (const GAS float*)(X + (size_t)MP * 1024))
    FFN_UP(15, 3, -1)
    GEMM_RESID(16, P_H, FFP, (const bf16*)(GAS bf16*)(ws + WS_WDN + 3 * WDN_BYTES), 0.5f, 0, (const GAS float*)X, (const GAS float*)(X + (size_t)MP * 1024))
#undef IN
#undef PH
#undef END_PH
#undef PHASE_BEGIN
#undef FFN_UP
#undef GEMM_RESID
}

template <int K> static bool setup_one() {
    int per_cu = 0;
    if (hipFuncSetAttribute((const void*)mega_fwd<K, (N_LAUNCHES == 1 ? N_PHASES : K + 1)>, hipFuncAttributeMaxDynamicSharedMemorySize, LDS_BYTES) != hipSuccess) { fprintf(stderr, "kernel_launch: hipFuncSetAttribute failed\n"); return false; }
    if (hipOccupancyMaxActiveBlocksPerMultiprocessor(&per_cu, (const void*)mega_fwd<K, (N_LAUNCHES == 1 ? N_PHASES : K + 1)>, NTHR, LDS_BYTES) != hipSuccess || per_cu < 1) fprintf(stderr, "kernel_launch: occupancy query reports %d workgroups per CU\n", per_cu);
    return true;
}
template <int K> static void launch_one(int grid, const Args& a, hipStream_t stream) {
    hipLaunchKernelGGL((mega_fwd<K, (N_LAUNCHES == 1 ? N_PHASES : K + 1)>), dim3(grid), dim3(NTHR), LDS_BYTES, stream, a);
    const hipError_t le = hipPeekAtLastError();
    if (le != hipSuccess) fprintf(stderr, "kernel_launch: launch %d failed: %s\n", K, hipGetErrorName(le));
}
template <int K> struct Seq {
    static bool setup() { if (!setup_one<K>()) return false; if (N_LAUNCHES == 1) return true; return Seq<K + 1>::setup(); }
    static void launch(int grid, const Args& a, hipStream_t stream) { launch_one<K>(grid, a, stream); if (N_LAUNCHES != 1) Seq<K + 1>::launch(grid, a, stream); }
};
template <> struct Seq<(N_LAUNCHES == 1 ? 1 : N_PHASES)> { static bool setup() { return true; } static void launch(int, const Args&, hipStream_t) {} };
static bool setup_all() { return Seq<0>::setup(); }
static void launch_all(int grid, const Args& a, hipStream_t stream) { Seq<0>::launch(grid, a, stream); }
extern "C" void kernel_launch(void* const* d_in, const int* in_sizes, int n_in, void* d_out, int out_size, void* d_ws, size_t ws_size, hipStream_t stream) {
    static int grid = 0;
    if (grid == 0) {
        if (n_in != 44 || out_size != (int)O_END || ws_size < WS_END) { fprintf(stderr, "kernel_launch: unexpected shapes: n_in %d out %d ws %zu; nothing launched\n", n_in, out_size, ws_size); grid = -1; return; }
        int dev = 0, cus = 0, per_cu = 0;
        if (hipGetDevice(&dev) != hipSuccess || hipDeviceGetAttribute(&cus, hipDeviceAttributeMultiprocessorCount, dev) != hipSuccess) { fprintf(stderr, "kernel_launch: device query failed\n"); grid = -1; return; }
        if (!setup_all()) { grid = -1; return; }
        (void)hipGetLastError();
        grid = cus;
    }
    if (grid < 0) return;
    if (hipMemsetAsync((char*)d_ws + WS_CTL, 0, CTL_ZERO_BYTES, stream) != hipSuccess) { fprintf(stderr, "kernel_launch: memset failed\n"); return; }
    Args a{};
    for (int i = 0; i < 44; ++i) a.in[i] = d_in[i];
    a.out = (float*)d_out; a.ws = (unsigned char*)d_ws;
    launch_all(grid, a, stream);
}
```

```cpp
#ifndef MK_N_LAUNCHES
#define MK_N_LAUNCHES 1
#endif
#include <hip/hip_runtime.h>
#include <cstdio>
#include <cstdint>
namespace pg8 {
#define PG8_LAS __attribute__((address_space(3)))
typedef unsigned short bf16_t;
typedef short bf16x8 __attribute__((ext_vector_type(8)));
typedef float f32x4 __attribute__((ext_vector_type(4)));
typedef unsigned u32x4 __attribute__((ext_vector_type(4)));
constexpr int BM = 256, BK = 64, HALF = 128, HTB = HALF * BK * 2  , STAGE_BYTES = 8 * HTB, NXCD = 8, WGM = 8;

__host__ __device__ __forceinline__ int lds_byte(int r, int c) { const int st = (r >> 4) * 2 + (c >> 5), rr = r & 15, cc = c & 31, ob = rr * 64 + cc * 2; return st * 1024 + (ob ^ (((ob >> 9) & 1) << 5)); }
__host__ __device__ __forceinline__ void stage_rc(int b, int& R, int& C) { const int st = b / 1024, sb = b % 1024, swz = sb ^ (((sb >> 9) & 1) << 5); R = (st >> 1) * 16 + swz / 64; C = (st & 1) * 32 + (swz % 64) / 2; }
__host__ __device__ __forceinline__ int perm32(int rho) { const int n = rho >> 4, i = rho & 15; return 8 * (i >> 2) + 4 * n + (i & 3); }

struct Unit { int pm, pn; };
struct Gemm { const bf16_t* A; const bf16_t* Bt; int M, N, K; };

struct StaticOrder {
    int nM, nN, nwg, G, c;
    __host__ __device__ void init(int M, int N, int G_, int c_) { nM = M / BM; nN = N / BM; nwg = nM * nN; G = G_; c = c_; }
    __host__ __device__ bool next(int i, Unit& u) const {
        const long L = (long)i * G + c; if (L >= nwg) return false;
        int wgid = (int)L; { const int q = nwg / NXCD, r = nwg % NXCD, xcd = wgid % NXCD, off = wgid / NXCD; wgid = (xcd < r ? xcd * (q + 1) : r * (q + 1) + (xcd - r) * q) + off; }
        const int nig = WGM * nN, gid = wgid / nig, fm = gid * WGM, gsz = (nM - fm) < WGM ? (nM - fm) : WGM;
        u.pm = fm + ((wgid % nig) % gsz); u.pn = (wgid % nig) / gsz; return true;
    }
    __device__ __forceinline__ void a_ready(const Unit&) const {}
    __device__ __forceinline__ void done(const Unit&) const {}
};

__device__ __forceinline__ unsigned cvt_pk_bf16(float lo, float hi) { unsigned r; asm volatile("v_cvt_pk_bf16_f32 %0, %1, %2" : "=v"(r) : "v"(lo), "v"(hi)); return r; }
typedef float f32x2 __attribute__((ext_vector_type(2)));
template <class Epi, class Sched, bool ALIGN_EPI = false, bool SP2 = false>
__device__ __forceinline__ void gemm_phase(PG8_LAS unsigned char* lds, const Gemm g, const Sched& S, const Epi& E) {
    int tid_ = threadIdx.x; asm volatile("" : "+v"(tid_));
    const int tid = tid_, wid = __builtin_amdgcn_readfirstlane(tid >> 6), lane = tid & 63, wr = wid >> 2, wc = wid & 3, fr = lane & 15, fq = lane >> 4;
    const int K = g.K, nt = K / BK;
    unsigned voffA[2], voffB[2];
#pragma unroll
    for (int i = 0; i < 2; ++i) { int R, C; stage_rc(tid * 16 + i * 8192, R, C); const int Rb = Epi::PERM ? ((R & ~31) + perm32(R & 31)) : R;
        voffA[i] = (unsigned)(R * K + C) * 2u; voffB[i] = (unsigned)(Rb * K + C) * 2u; }
    const size_t kstep = (size_t)(BK * 2);
    const size_t hstep = (size_t)HALF * K * 2;
    const size_t tstep = 2 * hstep;
    const unsigned ldsw = (unsigned)wid * 1024u;
    const int aoff = lds_byte(wr * 64 + fr, fq * 8), boff = lds_byte(wc * 32 + fr, fq * 8);
#define PG8_SA(b, h) (((b) * 2 + (h)) * HTB)
#define PG8_SB(b, h) ((4 + (b) * 2 + (h)) * HTB)
#define PG8_STAGE(bufoff, gbase, voff) do { _Pragma("unroll") for (int _i = 0; _i < 2; ++_i) \
        __builtin_amdgcn_global_load_lds((const unsigned*)((const char*)(gbase) + (voff)[_i]), (PG8_LAS unsigned*)(lds + (bufoff) + ldsw + _i * 8192), 16, 0, 0); } while (0)
#define PG8_LDA(dst, b, h) do { _Pragma("unroll") for (int m = 0; m < 4; ++m) _Pragma("unroll") for (int k = 0; k < 2; ++k) dst[m][k] = *(const PG8_LAS bf16x8*)(lds + PG8_SA(b, h) + aoff + m * 2048 + k * 1024); } while (0)
#define PG8_LDB(dst, b, h) do { _Pragma("unroll") for (int n = 0; n < 2; ++n) _Pragma("unroll") for (int k = 0; k < 2; ++k) dst[n][k] = *(const PG8_LAS bf16x8*)(lds + PG8_SB(b, h) + boff + n * 2048 + k * 1024); } while (0)
#define PG8_MMA(ai, bj, At, Bt) do { __builtin_amdgcn_s_setprio(1); _Pragma("unroll") for (int m = 0; m < 4; ++m) _Pragma("unroll") for (int n = 0; n < 2; ++n) _Pragma("unroll") for (int k = 0; k < 2; ++k) \
        acc[ai][bj][m][n] = __builtin_amdgcn_mfma_f32_16x16x32_bf16(Bt[n][k], At[m][k], acc[ai][bj][m][n], 0, 0, 0); __builtin_amdgcn_s_setprio(0); } while (0)
#define PG8_WAIT_V(n) asm volatile("s_waitcnt vmcnt(" #n ")" ::: "memory")
#define PG8_WAIT_L(n) asm volatile("s_waitcnt lgkmcnt(" #n ")" ::: "memory")
#define PG8_BAR __builtin_amdgcn_s_barrier()
#define PG8_SCHED __builtin_amdgcn_sched_barrier(0)
    Unit cur, nxt; int ui = 0;
    if (!S.next(0, cur)) return;
    f32x4 acc[2][2][4][2];
#pragma unroll
    for (int a = 0; a < 2; ++a)
#pragma unroll
        for (int b = 0; b < 2; ++b)
#pragma unroll
            for (int m = 0; m < 4; ++m)
#pragma unroll
                for (int n = 0; n < 2; ++n) acc[a][b][m][n] = (f32x4){0.f, 0.f, 0.f, 0.f};
    if constexpr (Epi::INIT_ACC) E.init(acc, cur, wr, wc, fr, fq);
    bf16x8 At[4][2], B0[2][2], B1[2][2];
    const char* cA = (const char*)g.A + (size_t)cur.pm * tstep; const char* cB = (const char*)g.Bt + (size_t)cur.pn * tstep;
    S.a_ready(cur);
    if constexpr (SP2) {
        PG8_STAGE(PG8_SB(0, 0), cB, voffB); PG8_STAGE(PG8_SB(0, 1), cB + hstep, voffB); PG8_STAGE(PG8_SA(0, 0), cA, voffA); PG8_STAGE(PG8_SA(0, 1), cA + hstep, voffA);
        if constexpr (Epi::HAS_PRE) E.pre(S, tid);
        if (wr == 1) PG8_BAR;
        PG8_WAIT_V(2); PG8_BAR;
        PG8_STAGE(PG8_SB(1, 0), cB + kstep, voffB); PG8_STAGE(PG8_SA(1, 0), cA + kstep, voffA); PG8_STAGE(PG8_SB(1, 1), cB + hstep + kstep, voffB);
        PG8_WAIT_V(6); PG8_BAR;
    } else {
        PG8_STAGE(PG8_SB(0, 0), cB, voffB); PG8_STAGE(PG8_SA(0, 0), cA, voffA); PG8_STAGE(PG8_SB(0, 1), cB + hstep, voffB); PG8_STAGE(PG8_SA(0, 1), cA + hstep, voffA);
        if (wr == 1) PG8_BAR;
        PG8_WAIT_V(4); PG8_BAR;
        PG8_STAGE(PG8_SB(1, 0), cB + kstep, voffB); PG8_STAGE(PG8_SA(1, 0), cA + kstep, voffA); PG8_STAGE(PG8_SB(1, 1), cB + hstep + kstep, voffB);
        PG8_WAIT_V(6); PG8_BAR;
    }
    for (;;) {
        const bool has_next = S.next(ui + 1, nxt);
        const char* nA = has_next ? (const char*)g.A + (size_t)nxt.pm * tstep : cA; const char* nB = has_next ? (const char*)g.Bt + (size_t)nxt.pn * tstep : cB;
        for (int t = 0; t < nt; t += 2) {
            const bool last = (t == nt - 2);
            const char* a1 = cA + (size_t)(t + 1) * kstep;
            const char* a2 = last ? nA : cA + (size_t)(t + 2) * kstep; const char* b2 = last ? nB : cB + (size_t)(t + 2) * kstep;
            const char* a3 = a2 + kstep; const char* b3 = b2 + kstep;
            if (last && has_next) S.a_ready(nxt);
            if constexpr (SP2) {
            PG8_LDB(B0, 0, 0); PG8_LDB(B1, 0, 1); PG8_SCHED; PG8_LDA(At, 0, 0); PG8_STAGE(PG8_SA(1, 1), a1 + hstep, voffA);
            PG8_WAIT_V(8); PG8_WAIT_L(0); PG8_BAR; PG8_MMA(0, 0, At, B0); PG8_MMA(0, 1, At, B1); PG8_BAR; PG8_SCHED;
            PG8_LDA(At, 0, 1); PG8_STAGE(PG8_SB(0, 0), b2, voffB); PG8_STAGE(PG8_SB(0, 1), b2 + hstep, voffB); PG8_STAGE(PG8_SA(0, 0), a2, voffA);
            PG8_WAIT_V(8); PG8_WAIT_L(0); PG8_BAR; PG8_MMA(1, 0, At, B0); PG8_MMA(1, 1, At, B1); PG8_BAR; PG8_SCHED;
            PG8_LDB(B0, 1, 0); PG8_LDB(B1, 1, 1); PG8_SCHED; PG8_LDA(At, 1, 0); PG8_STAGE(PG8_SA(0, 1), a2 + hstep, voffA);
            PG8_WAIT_V(8); PG8_WAIT_L(0); PG8_BAR; PG8_MMA(0, 0, At, B0); PG8_MMA(0, 1, At, B1); PG8_BAR; PG8_SCHED;
            PG8_LDA(At, 1, 1); PG8_STAGE(PG8_SB(1, 0), b3, voffB); PG8_STAGE(PG8_SB(1, 1), b3 + hstep, voffB); PG8_STAGE(PG8_SA(1, 0), a3, voffA);
            PG8_WAIT_V(8); PG8_WAIT_L(0); PG8_BAR; PG8_MMA(1, 0, At, B0); PG8_MMA(1, 1, At, B1); PG8_BAR; PG8_SCHED;
            } else {
            PG8_LDB(B0, 0, 0); PG8_SCHED; PG8_LDA(At, 0, 0); PG8_STAGE(PG8_SA(1, 1), a1 + hstep, voffA);
            PG8_WAIT_L(8); PG8_BAR; PG8_WAIT_L(0); PG8_MMA(0, 0, At, B0); PG8_BAR; PG8_SCHED;
            PG8_LDB(B1, 0, 1); PG8_STAGE(PG8_SB(0, 0), b2, voffB);
            PG8_BAR; PG8_WAIT_L(0); PG8_MMA(0, 1, At, B1); PG8_BAR;
            PG8_LDA(At, 0, 1); PG8_STAGE(PG8_SA(0, 0), a2, voffA);
            PG8_BAR; PG8_WAIT_L(0); PG8_MMA(1, 0, At, B0); PG8_BAR; PG8_SCHED;
            PG8_STAGE(PG8_SB(0, 1), b2 + hstep, voffB);
            PG8_WAIT_V(6); PG8_BAR; PG8_MMA(1, 1, At, B1); PG8_BAR;
            PG8_LDB(B0, 1, 0); PG8_SCHED; PG8_LDA(At, 1, 0); PG8_STAGE(PG8_SA(0, 1), a2 + hstep, voffA);
            PG8_WAIT_L(8); PG8_BAR; PG8_WAIT_L(0); PG8_MMA(0, 0, At, B0); PG8_BAR; PG8_SCHED;
            PG8_LDB(B1, 1, 1); PG8_STAGE(PG8_SB(1, 0), b3, voffB);
            PG8_BAR; PG8_WAIT_L(0); PG8_MMA(0, 1, At, B1); PG8_BAR;
            PG8_LDA(At, 1, 1); PG8_STAGE(PG8_SA(1, 0), a3, voffA);
            PG8_BAR; PG8_WAIT_L(0); PG8_MMA(1, 0, At, B0); PG8_BAR; PG8_SCHED;
            PG8_STAGE(PG8_SB(1, 1), b3 + hstep, voffB);
            PG8_WAIT_V(6); PG8_BAR; PG8_MMA(1, 1, At, B1); PG8_BAR;
            }
        }
        if constexpr (ALIGN_EPI) { if (wr == 0) PG8_BAR; }
        if constexpr (!Epi::AFTER_DRAIN) { E(acc, cur, wr, wc, fr, fq, ui); S.done(cur); }
        if (!has_next) break;
#pragma unroll
        for (int a = 0; a < 2; ++a)
#pragma unroll
            for (int b = 0; b < 2; ++b)
#pragma unroll
                for (int m = 0; m < 4; ++m)
#pragma unroll
                    for (int n = 0; n < 2; ++n) acc[a][b][m][n] = (f32x4){0.f, 0.f, 0.f, 0.f};
        if constexpr (Epi::INIT_ACC) E.init(acc, nxt, wr, wc, fr, fq);
        cur = nxt; cA = nA; cB = nB; ++ui;
        if constexpr (ALIGN_EPI) { if (wr == 1) PG8_BAR; }
    }
    PG8_WAIT_V(0);
    if constexpr (!ALIGN_EPI) { if (wr == 0) PG8_BAR; }
    PG8_BAR;
    if constexpr (Epi::AFTER_DRAIN) { E.fused(acc, cur, wr, wc, fr, fq, lds, wid, lane); S.done(cur); }
#undef PG8_SA
#undef PG8_SB
#undef PG8_STAGE
#undef PG8_LDA
#undef PG8_LDB
#undef PG8_MMA
#undef PG8_WAIT_V
#undef PG8_WAIT_L
#undef PG8_BAR
#undef PG8_SCHED
}
}
#include <hip/hip_bf16.h>
#include <cmath>
#include <hip/hip_bf16.h>
#include <cmath>
namespace attn_body {
using bf16=__hip_bfloat16;
using bf16x8=__attribute__((ext_vector_type(8)))short;
using s16x4=__attribute__((ext_vector_type(4)))short;
using f32x16=__attribute__((ext_vector_type(16)))float;
using u32x4=__attribute__((ext_vector_type(4)))unsigned;
constexpr int BATCH=4,NHEAD=16,SEQ=4096,D=64,PQK=512,PV=512,PO=1024;
constexpr int NW=8,QBLK=32,QB=QBLK*NW,KVBLK=64,NQB=SEQ/QB;
constexpr int ATTN_UNIT_ROWS=QB;
__device__ __forceinline__ int crow(int r,int hi){return (r&3)+8*(r>>2)+4*hi;}
#define SBAR() __builtin_amdgcn_sched_barrier(0)
__device__ __forceinline__ void cmask(f32x16&p0,f32x16&p1,int jb,int qrel,int hi){
  const float NEG=-INFINITY; int kb=64*jb+4*hi;
  #pragma unroll
  for(int r=0;r<16;++r){int kv=kb+(r&3)+8*(r>>2); if(kv>qrel)p0[r]=NEG; if(kv+32>qrel)p1[r]=NEG;}
}

constexpr int NSLOT=3, SLOTB=8192;
constexpr int LDS_K=0, LDS_V=NSLOT*SLOTB, LDS_WS=2*NSLOT*SLOTB, LDS_OST=LDS_WS+NW*64*4, LDS_BYTES=LDS_OST+NW*4096;
constexpr float C2=0.125f*1.4426950408889634f;
__device__ __forceinline__ void glds16(const void*gsrc,unsigned lds_dst){unsigned keep;
  asm volatile("s_mov_b32 %0, m0\n\ts_mov_b32 m0, %2\n\ts_nop 0\n\tglobal_load_lds_dwordx4 %1, off\n\ts_mov_b32 m0, %0":"=&s"(keep):"v"(gsrc),"s"(lds_dst):"memory");}
__device__ __forceinline__ float max3f(float a,float b,float c){float r;asm("v_max3_f32 %0, %1, %2, %3":"=v"(r):"v"(a),"v"(b),"v"(c));return r;}
__device__ __forceinline__ float max2f(float a,float b){float r;asm("v_max_f32_e32 %0, %1, %2":"=v"(r):"v"(a),"v"(b));return r;}
__device__ __forceinline__ float fadd_s(float a,float b){float r;asm("v_add_f32_e32 %0, %1, %2":"=v"(r):"v"(a),"v"(b));return r;}
__device__ __forceinline__ float fsub_s(float a,float b){float r;asm("v_sub_f32_e32 %0, %1, %2":"=v"(r):"v"(a),"v"(b));return r;}
typedef float f32x2_t __attribute__((ext_vector_type(2))); typedef __bf16 bf16x2_t __attribute__((ext_vector_type(2)));
__device__ __forceinline__ unsigned cvtpk_s(float lo,float hi){f32x2_t v={lo,hi};bf16x2_t b=__builtin_convertvector(v,bf16x2_t);return __builtin_bit_cast(unsigned,b);}
#define WAIT_BAR(N) asm volatile("s_waitcnt vmcnt(" #N ") lgkmcnt(0)\n\ts_barrier":::"memory")

__device__ __forceinline__ void qkt(f32x16&p0,f32x16&p1,const char*Kslot,const bf16x8*qr,const f32x16&negm,int r32,int hi){
  const char*kb=Kslot+hi*1024+r32*16;
  #pragma unroll
  for(int d0=0;d0<4;++d0){
    const bf16x8 b0=*reinterpret_cast<const bf16x8*>(kb+d0*2048);
    const bf16x8 b1=*reinterpret_cast<const bf16x8*>(kb+d0*2048+512);
    if(d0==0){p0=__builtin_amdgcn_mfma_f32_32x32x16_bf16(b0,qr[0],negm,0,0,0);p1=__builtin_amdgcn_mfma_f32_32x32x16_bf16(b1,qr[0],negm,0,0,0);}
    else{p0=__builtin_amdgcn_mfma_f32_32x32x16_bf16(b0,qr[d0],p0,0,0,0);p1=__builtin_amdgcn_mfma_f32_32x32x16_bf16(b1,qr[d0],p1,0,0,0);}}
}
typedef __attribute__((address_space(3))) const char* lds_cptr;
typedef short v4i16_t __attribute__((ext_vector_type(4)));
__device__ __forceinline__ void kload8(bf16x8*kf,lds_cptr kp){
  kf[0]=*(const __attribute__((address_space(3))) bf16x8*)(kp);      kf[1]=*(const __attribute__((address_space(3))) bf16x8*)(kp+512);
  kf[2]=*(const __attribute__((address_space(3))) bf16x8*)(kp+2048); kf[3]=*(const __attribute__((address_space(3))) bf16x8*)(kp+2560);
  kf[4]=*(const __attribute__((address_space(3))) bf16x8*)(kp+4096); kf[5]=*(const __attribute__((address_space(3))) bf16x8*)(kp+4608);
  kf[6]=*(const __attribute__((address_space(3))) bf16x8*)(kp+6144); kf[7]=*(const __attribute__((address_space(3))) bf16x8*)(kp+6656);
}
__device__ __forceinline__ void kload2(bf16x8*kf,lds_cptr kp,int j){ kf[2*j]=*(const __attribute__((address_space(3))) bf16x8*)(kp+j*2048); kf[2*j+1]=*(const __attribute__((address_space(3))) bf16x8*)(kp+j*2048+512); }
__device__ __forceinline__ s16x4 vtr(lds_cptr p){ return __builtin_bit_cast(s16x4,__builtin_amdgcn_ds_read_tr16_b64_v4i16((__attribute__((address_space(3))) v4i16_t*)p)); }
__device__ __forceinline__ float rowmax(const f32x16&p0,const f32x16&p1){
  float a=max3f(p0[0],p0[1],p1[0]),b=max3f(p0[2],p0[3],p1[1]);a=max3f(a,p1[2],p1[3]);
  #pragma unroll
  for(int r=4;r<16;r+=4){a=max3f(a,p0[r],p0[r+1]);b=max3f(b,p0[r+2],p0[r+3]);a=max3f(a,p1[r],p1[r+1]);b=max3f(b,p1[r+2],p1[r+3]);}
  const float m=max2f(a,b);
  auto rr=__builtin_amdgcn_permlane32_swap(__float_as_uint(m),__float_as_uint(m),false,false);
  return max2f(__uint_as_float(rr[0]),__uint_as_float(rr[1]));
}
__device__ __forceinline__ void pv(f32x16*o,int vb,bf16x8 pa0,bf16x8 pa1,bf16x8 pa2,bf16x8 pa3){
  #pragma unroll
  for(int d0=0;d0<2;++d0){s16x4 lo[4],hi[4];
    #pragma unroll
    for(int ks=0;ks<4;++ks){
      asm volatile("ds_read_b64_tr_b16 %0,%1 offset:%c2":"=&v"(lo[ks]):"v"(vb),"i"(d0*4096+ks*1024):"memory");
      asm volatile("ds_read_b64_tr_b16 %0,%1 offset:%c2":"=&v"(hi[ks]):"v"(vb),"i"(d0*4096+ks*1024+512):"memory");}
    asm volatile("s_waitcnt lgkmcnt(0)":::"memory");SBAR();
    #define PK(k) (bf16x8){lo[k][0],lo[k][1],lo[k][2],lo[k][3],hi[k][0],hi[k][1],hi[k][2],hi[k][3]}
    o[d0]=__builtin_amdgcn_mfma_f32_32x32x16_bf16(pa0,PK(0),o[d0],0,0,0);
    o[d0]=__builtin_amdgcn_mfma_f32_32x32x16_bf16(pa1,PK(1),o[d0],0,0,0);
    o[d0]=__builtin_amdgcn_mfma_f32_32x32x16_bf16(pa2,PK(2),o[d0],0,0,0);
    o[d0]=__builtin_amdgcn_mfma_f32_32x32x16_bf16(pa3,PK(3),o[d0],0,0,0);
    #undef PK
  }
}

#ifndef ATTN_STORE16
#define ATTN_STORE16(p,v) (*(u32x4*)(p)=(v))
#endif
template<int THRL> __device__ __forceinline__ void attn_unit(int b,int qk_off,int v_off,int o_off,int qb,const bf16*Q,const bf16*__restrict__ K,const bf16*__restrict__ V,bf16*O,char*shm){
  int tid_=threadIdx.x; asm volatile("":"+v"(tid_)); const int tid=tid_,lane=tid&63,r32=lane&31,hi=lane>>5; const int wid=__builtin_amdgcn_readfirstlane(tid>>6);
  const long rowbase=(long)b*SEQ; const int q0=qb*QB;
  const bf16*Qw=Q+(rowbase+q0+wid*QBLK)*PQK+qk_off;
  const bf16*Kh=K+rowbase*PQK+qk_off,*Vh=V+rowbase*PV+v_off;
  const unsigned lds0=(unsigned)(uintptr_t)shm;
  float*wsf=(float*)(shm+LDS_WS)+wid*64;
  const bf16*ksrc=Kh+(long)lane*PQK+wid*8;
  const bf16*vsrc=Vh+(long)(16*(wid&3)+(lane>>2))*PV+(wid>>2)*32+(lane&3)*8;
  const unsigned kdst=lds0+LDS_K+wid*1024, vdst=lds0+LDS_V+wid*1024;
  #define DMA_K(t,slot) glds16(ksrc+(long)(t)*KVBLK*PQK,(unsigned)__builtin_amdgcn_readfirstlane(kdst+(slot)))
  #define DMA_V(t,slot) glds16(vsrc+(long)(t)*KVBLK*PV,(unsigned)__builtin_amdgcn_readfirstlane(vdst+(slot)))
  const int vb0=(int)(lds0+LDS_V)+((lane>>4)&1)*32+(lane&3)*8+(4*hi+((lane&15)>>2))*64;
  const char*Kbase=shm+LDS_K; bf16x8 kf[8];
  const lds_cptr shm3=(lds_cptr)shm; const lds_cptr kp0=shm3+LDS_K+hi*1024+r32*16; const lds_cptr vp0=shm3+LDS_V+((lane>>4)&1)*32+(lane&3)*8+(4*hi+((lane&15)>>2))*64;
  const int NT=(q0+QB)/KVBLK;
  DMA_K(0,0);DMA_V(0,0);DMA_K(1,SLOTB);
  bf16x8 qr[4];
  #pragma unroll
  for(int d0=0;d0<4;++d0)qr[d0]=*reinterpret_cast<const bf16x8*>(&Qw[(long)r32*PQK+d0*16+hi*8]);
  float mhat=0.f,l_reg=0.f;f32x16 o[2];o[0]=f32x16{};o[1]=f32x16{};f32x16 negm=f32x16{};asm volatile("":"+v"(negm));
  const int qrel=wid*QBLK+r32;
  #define CMASK(P0,P1,t) do{int jb_=(t)-(NT-4); if(jb_>=0)cmask(P0,P1,jb_,qrel,hi);}while(0)
  bool resc=false;
  #define START(P0,P1) do{ const float rm=rowmax(P0,P1); resc=false; \
    { const float dl=rm; mhat=fadd_s(mhat,dl); \
      _Pragma("unroll") for(int r=0;r<16;++r){P0[r]=fsub_s(P0[r],dl);P1[r]=fsub_s(P1[r],dl);} \
      _Pragma("unroll") for(int r=0;r<16;++r)negm[r]=-mhat; asm volatile("":"+v"(negm)); } \
    _Pragma("unroll") for(int r=0;r<16;++r)P0[r]=__builtin_amdgcn_exp2f(P0[r]); }while(0)
  #define RESC() do{ if(resc){ asm volatile("s_waitcnt lgkmcnt(0)":::"memory"); \
      _Pragma("unroll") for(int d_=0;d_<2;++d_) _Pragma("unroll") for(int r=0;r<16;++r)o[d_][r]*=wsf[crow(r,hi)]; } }while(0)
  f32x16 pA0,pA1,pB0,pB1;
  int sl_prev=0,sl_cur=0,sl_next=SLOTB;
  #define ROT() do{sl_prev=sl_cur;sl_cur=sl_next;sl_next=(sl_next==(NSLOT-1)*SLOTB)?0:sl_next+SLOTB;}while(0)
  DMA_K(2,2*SLOTB);
  WAIT_BAR(3);
  qkt(pA0,pA1,Kbase,qr,negm,r32,hi);asm volatile("s_nop 15\n\ts_nop 7":"+v"(pA0),"+v"(pA1));CMASK(pA0,pA1,0);
  START(pA0,pA1);
  _Pragma("unroll") for(int r=0;r<16;++r)pA1[r]=__builtin_amdgcn_exp2f(pA1[r]);
  WAIT_BAR(0);
  DMA_K(3,0);DMA_V(1,SLOTB);
  ROT();
  kload8(kf,kp0+sl_cur);
  WAIT_BAR(2);
  s16x4 vlo[8],vhi[8]; u32x4 pw0,pw1,pw2,pw3;
  #define PKW(P,B) cvtpk_s(P[B],P[B+1])
  #define PAF(k) __builtin_bit_cast(bf16x8,pw##k)
  #define VFR(i) (bf16x8){vlo[i][0],vlo[i][1],vlo[i][2],vlo[i][3],vhi[i][0],vhi[i][1],vhi[i][2],vhi[i][3]}
  #define PIN(x) asm volatile("":"+v"(x))
  #define MX3(a,b,c) __builtin_fmaxf(__builtin_fmaxf((a),(b)),(c))
  #define GAPA(MF,A0,A1,A2,A3,W0,W1,PW) do{ MF; sacc+=A0; sacc+=A1; sacc+=A2; sacc+=A3; PIN(sacc); W0; W1; PIN(PW); SBAR(); }while(0)
  #define EX(v) __builtin_amdgcn_exp2f(v)
  #define GAPB(MF,X,B) do{ MF; X[B]=EX(X[B]); X[B+1]=EX(X[B+1]); X[B+2]=EX(X[B+2]); X[B+3]=EX(X[B+3]); PIN(X); SBAR(); }while(0)
  #define VRD(i) do{ vlo[i]=vtr(vp_+(((i)>>2)*4096+((i)&3)*1024)); vhi[i]=vtr(vp_+(((i)>>2)*4096+((i)&3)*1024+512)); }while(0)
  #define KRD(G,j) do{ if(G){ kload2(kf,kp0+sl_next,j); SBAR(); } }while(0)
  #define STEP(C0,C1,P0,P1,t,GK,GV,GL) do{ SBAR(); \
    const lds_cptr vp_=vp0+sl_prev; \
    VRD(0); SBAR(); float sacc=(P0[0]+P0[1]); \
    GAPA(C0=__builtin_amdgcn_mfma_f32_32x32x16_bf16(kf[0],qr[0],negm,0,0,0), P0[2],P0[3],P0[4],P0[5],     pw0[0]=PKW(P0,0), pw0[1]=PKW(P0,2), pw0); \
    VRD(4); SBAR(); GAPA(C1=__builtin_amdgcn_mfma_f32_32x32x16_bf16(kf[1],qr[0],negm,0,0,0), P0[6],P0[7],P0[8],P0[9],     pw0[2]=PKW(P0,4), pw0[3]=PKW(P0,6), pw0); \
    VRD(1); SBAR(); GAPA(C0=__builtin_amdgcn_mfma_f32_32x32x16_bf16(kf[2],qr[1],C0,0,0,0),   P0[10],P0[11],P0[12],P0[13], pw1[0]=PKW(P0,8), pw1[1]=PKW(P0,10), pw1); \
    VRD(5); SBAR(); GAPA(C1=__builtin_amdgcn_mfma_f32_32x32x16_bf16(kf[3],qr[1],C1,0,0,0),   P0[14],P0[15],P1[0],P1[1],   pw1[2]=PKW(P0,12),pw1[3]=PKW(P0,14), pw1); \
    VRD(2); SBAR(); GAPA(C0=__builtin_amdgcn_mfma_f32_32x32x16_bf16(kf[4],qr[2],C0,0,0,0),   P1[2],P1[3],P1[4],P1[5],     pw2[0]=PKW(P1,0), pw2[1]=PKW(P1,2), pw2); \
    VRD(6); SBAR(); GAPA(C1=__builtin_amdgcn_mfma_f32_32x32x16_bf16(kf[5],qr[2],C1,0,0,0),   P1[6],P1[7],P1[8],P1[9],     pw2[2]=PKW(P1,4), pw2[3]=PKW(P1,6), pw2); \
    VRD(3); SBAR(); GAPA(C0=__builtin_amdgcn_mfma_f32_32x32x16_bf16(kf[6],qr[3],C0,0,0,0),   P1[10],P1[11],P1[12],P1[13], pw3[0]=PKW(P1,8), pw3[1]=PKW(P1,10), pw3); \
    VRD(7); SBAR(); GAPA(C1=__builtin_amdgcn_mfma_f32_32x32x16_bf16(kf[7],qr[3],C1,0,0,0),   P1[14],P1[15],0.f,0.f,       pw3[2]=PKW(P1,12),pw3[3]=PKW(P1,14), pw3); \
    l_reg+=sacc; \
    if(GK){DMA_K((t)+3,sl_cur);} if(GV){DMA_V((t)+1,sl_next);} \
    CMASK(C0,C1,t); \
    { float a=MX3(C0[0],C0[1],C1[0]),b=MX3(C0[2],C0[3],C1[1]); a=MX3(a,C1[2],C1[3]); \
      _Pragma("unroll") for(int r=4;r<16;r+=4){a=MX3(a,C0[r],C0[r+1]);b=MX3(b,C0[r+2],C0[r+3]);a=MX3(a,C1[r],C1[r+1]);b=MX3(b,C1[r+2],C1[r+3]);} \
      float rm=__builtin_fmaxf(a,b); { auto rr=__builtin_amdgcn_permlane32_swap(__float_as_uint(rm),__float_as_uint(rm),false,false); rm=__builtin_fmaxf(__uint_as_float(rr[0]),__uint_as_float(rr[1])); } \
      resc=false; \
      if(__builtin_expect(__any(rm>(float)THRL),0)){ const float dl=__builtin_fmaxf(rm,0.f); mhat+=dl; \
        _Pragma("unroll") for(int r=0;r<16;++r){C0[r]-=dl;C1[r]-=dl;} \
        _Pragma("unroll") for(int r=0;r<16;++r)negm[r]=-mhat; asm volatile("":"+v"(negm)); \
        const float f=__builtin_amdgcn_exp2f(-dl); l_reg*=f; if(hi==0)wsf[r32]=f; resc=true; } } \
    SBAR(); \
    GAPB(o[0]=__builtin_amdgcn_mfma_f32_32x32x16_bf16(PAF(0),VFR(0),o[0],0,0,0), C0,0); \
    GAPB(o[1]=__builtin_amdgcn_mfma_f32_32x32x16_bf16(PAF(0),VFR(4),o[1],0,0,0), C0,4); \
    KRD(GL,0); GAPB(o[0]=__builtin_amdgcn_mfma_f32_32x32x16_bf16(PAF(1),VFR(1),o[0],0,0,0), C0,8); \
    KRD(GL,1); GAPB(o[1]=__builtin_amdgcn_mfma_f32_32x32x16_bf16(PAF(1),VFR(5),o[1],0,0,0), C0,12); \
    KRD(GL,2); GAPB(o[0]=__builtin_amdgcn_mfma_f32_32x32x16_bf16(PAF(2),VFR(2),o[0],0,0,0), C1,0); \
    KRD(GL,3); GAPB(o[1]=__builtin_amdgcn_mfma_f32_32x32x16_bf16(PAF(2),VFR(6),o[1],0,0,0), C1,4); \
    GAPB(o[0]=__builtin_amdgcn_mfma_f32_32x32x16_bf16(PAF(3),VFR(3),o[0],0,0,0), C1,8); \
    GAPB(o[1]=__builtin_amdgcn_mfma_f32_32x32x16_bf16(PAF(3),VFR(7),o[1],0,0,0), C1,12); \
    }while(0)
  int t=1;
  #undef CMASK
  #define CMASK(P0,P1,t) do{}while(0)
  for(;t+5<NT;t+=2){
    STEP(pB0,pB1,pA0,pA1,t,true,true,true);     WAIT_BAR(2); RESC(); ROT();
    STEP(pA0,pA1,pB0,pB1,t+1,true,true,true);   WAIT_BAR(2); RESC(); ROT();
  }
  #undef CMASK
  #define CMASK(P0,P1,t) do{int jb_=(t)-(NT-4); if(jb_>=0)cmask(P0,P1,jb_,qrel,hi);}while(0)
  #define ENDW(tt) do{ if((tt)+3<NT){WAIT_BAR(2);} else if((tt)+2<NT){WAIT_BAR(1);} else {WAIT_BAR(0);} }while(0)
  for(;t+1<NT;t+=2){
    STEP(pB0,pB1,pA0,pA1,t,(t+3<NT),(t+1<NT),(t+1<NT));       ENDW(t);   RESC(); ROT();
    STEP(pA0,pA1,pB0,pB1,t+1,(t+4<NT),(t+2<NT),(t+2<NT));     ENDW(t+1); RESC(); ROT();
  }
  STEP(pB0,pB1,pA0,pA1,NT-1,false,false,false); RESC();
  { float sacc=pB0[0]+pB0[1]; _Pragma("unroll") for(int r=2;r<16;++r)sacc+=pB0[r]; _Pragma("unroll") for(int r=0;r<16;++r)sacc+=pB1[r]; l_reg+=sacc;
    pw0=(u32x4){PKW(pB0,0),PKW(pB0,2),PKW(pB0,4),PKW(pB0,6)};pw1=(u32x4){PKW(pB0,8),PKW(pB0,10),PKW(pB0,12),PKW(pB0,14)};pw2=(u32x4){PKW(pB1,0),PKW(pB1,2),PKW(pB1,4),PKW(pB1,6)};pw3=(u32x4){PKW(pB1,8),PKW(pB1,10),PKW(pB1,12),PKW(pB1,14)};
    SBAR(); pv(o,vb0+sl_cur,PAF(0),PAF(1),PAF(2),PAF(3)); }
  #undef PKW
  #undef PAF
  #undef VFR
  #undef PIN
  #undef MX3
  #undef GAPA
  #undef GAPB
  #undef EX
  #undef VRD
  #undef KRD
  #undef STEP
  #undef ENDW
  {auto rr=__builtin_amdgcn_permlane32_swap(__float_as_uint(l_reg),__float_as_uint(l_reg),false,false);l_reg=__uint_as_float(rr[0])+__uint_as_float(rr[1]);}
  if(hi==0)wsf[32+r32]=l_reg;asm volatile("s_waitcnt lgkmcnt(0)":::"memory");
  float rli[16];
  #pragma unroll
  for(int r=0;r<16;++r)rli[r]=__builtin_amdgcn_rcpf(wsf[32+crow(r,hi)]);
  bf16*Ow=O+(rowbase+q0+wid*QBLK)*PO+o_off;
  { bf16*stg=(bf16*)(shm+LDS_OST)+wid*2048;
    #pragma unroll
    for(int r=0;r<16;++r){const int orow=crow(r,hi);
      #pragma unroll
      for(int d0=0;d0<2;++d0)stg[orow*64+d0*32+r32]=__float2bfloat16(o[d0][r]*rli[r]);}
    asm volatile("s_waitcnt lgkmcnt(0)":::"memory");
    #pragma unroll
    for(int i=0;i<4;++i){const int row=i*8+(lane>>3),ch=lane&7; const u32x4 v=*(const u32x4*)(stg+row*64+ch*8); ATTN_STORE16(Ow+(long)row*PO+ch*8,v);} }
  asm volatile("s_waitcnt lgkmcnt(0)\n\ts_barrier":::"memory");
  #undef DMA_K
  #undef DMA_V
  #undef CMASK
  #undef START
  #undef RESC
  #undef ROT
}
constexpr int ATTN_LDS_BYTES=LDS_BYTES;
#undef SBAR
#undef WAIT_BAR
}
#define GAS __attribute__((address_space(1)))
#define LAS __attribute__((address_space(3)))
typedef unsigned short bf16;
typedef unsigned v4u __attribute__((ext_vector_type(4)));
typedef float f32x4 __attribute__((ext_vector_type(4)));
typedef short bf16x8 __attribute__((ext_vector_type(8)));
typedef short bf16x4 __attribute__((ext_vector_type(4)));
typedef GAS unsigned gu32;
typedef GAS unsigned long long gu64;
#define RLX_AGENT __ATOMIC_RELAXED, __HIP_MEMORY_SCOPE_AGENT
#define LDS_WAIT() asm volatile("s_waitcnt lgkmcnt(0)" ::: "memory")
#define VM_WAIT() asm volatile("s_waitcnt vmcnt(0)" ::: "memory")
__device__ __forceinline__ unsigned long long rt() { return __builtin_amdgcn_s_memrealtime(); }
__device__ __forceinline__ unsigned f2bf(float f) { unsigned u = __builtin_bit_cast(unsigned, f); return (u + 0x7fffu + ((u >> 16) & 1u)) >> 16; }
typedef float pk_f32x2 __attribute__((ext_vector_type(2))); typedef __bf16 pk_bf16x2 __attribute__((ext_vector_type(2)));
__device__ __forceinline__ unsigned pk2(float lo, float hi) { const pk_f32x2 v = {lo, hi}; return __builtin_bit_cast(unsigned, __builtin_convertvector(v, pk_bf16x2)); }

#define XB_TMO      128
#define XB_XCNT(j)  (256  + 64 * (j))
#define XB_XSUB(j)  (1280 + 64 * (j))
#define XB_XGEN(j)  (2304 + 64 * (j))
#define XB_TOP      3328
#define XB_TOPGEN   3392
#define XCD_BAR_WORDS 3456
#define XB_SPIN_CAP (1u << 18)

__device__ __forceinline__ unsigned xb_ld(unsigned* p)              { return __hip_atomic_load(p, __ATOMIC_RELAXED, __HIP_MEMORY_SCOPE_AGENT); }
__device__ __forceinline__ unsigned xb_add(unsigned* p, unsigned v) { return __hip_atomic_fetch_add(p, v, __ATOMIC_RELAXED, __HIP_MEMORY_SCOPE_AGENT); }
__device__ __forceinline__ unsigned xb_xcc_id() { return (unsigned)__builtin_amdgcn_s_getreg((3 << 11) | 20) & 0xFu; }
#define XB_SPIN(cond, bar) do { unsigned _sp = 0; while (cond) { __builtin_amdgcn_s_sleep(1); \
    if ((++_sp & 255u) == 0u) { if (xb_ld(&(bar)[XB_TMO])) break; if (_sp > XB_SPIN_CAP) { atomicAdd(&(bar)[XB_TMO], 1u); break; } } } } while (0)

struct XcdBarrier {
    unsigned* bar; unsigned x;
    volatile LAS unsigned* st;
};

__device__ __forceinline__ XcdBarrier xcd_barrier_post(unsigned* bar, volatile LAS unsigned* st) {
    XcdBarrier b; b.bar = bar; b.x = xb_xcc_id(); b.st = st;
    if (threadIdx.x == 0) (void)xb_add(&bar[XB_XCNT(b.x)], 1u);
    return b;
}
__device__ __forceinline__ void xcd_barrier_complete(unsigned* bar, unsigned x, unsigned& nloc, unsigned& nx) {
    const unsigned G = gridDim.x * gridDim.y * gridDim.z;
    unsigned sum, cnt, mine, sp = 0u;
    for (;;) {
        sum = 0u; cnt = 0u; mine = 0u;
#pragma unroll
        for (unsigned j = 0; j < 16; ++j) { const unsigned c = xb_ld(&bar[XB_XCNT(j)]); sum += c; cnt += (c > 0u) ? 1u : 0u; mine = (j == x) ? c : mine; }
        if (sum == G) break;
        __builtin_amdgcn_s_sleep(1);
        if ((++sp & 255u) == 0u) { if (xb_ld(&bar[XB_TMO])) break; if (sp > XB_SPIN_CAP) { atomicAdd(&bar[XB_TMO], 1u); break; } }
    }
    nloc = mine > 0u ? mine : 1u; nx = cnt > 0u ? cnt : 1u;
}

__device__ __forceinline__ void xcd_barrier(const XcdBarrier& b) {
    asm volatile("s_waitcnt vmcnt(0)" ::: "memory");
    __syncthreads();
    if (threadIdx.x == 0) {
        unsigned* bar = b.bar;
        __builtin_amdgcn_s_waitcnt(0);
        unsigned nloc = b.st[0], nx = b.st[1];
        if (nloc == 0u) { xcd_barrier_complete(bar, b.x, nloc, nx); b.st[0] = nloc; b.st[1] = nx; }
        const unsigned old = xb_add(&bar[XB_XSUB(b.x)], 1u);
        const unsigned gen = old / nloc;
        if (old + 1u == (gen + 1u) * nloc) {
            __builtin_amdgcn_fence(__ATOMIC_RELEASE, "agent");
            asm volatile("s_waitcnt vmcnt(0)" ::: "memory");
            const unsigned og = xb_add(&bar[XB_TOP], 1u);
            const unsigned tg = og / nx;
            if (og + 1u == (tg + 1u) * nx) xb_add(&bar[XB_TOPGEN], 1u);
            else XB_SPIN(xb_ld(&bar[XB_TOPGEN]) == tg, bar);
            __builtin_amdgcn_fence(__ATOMIC_ACQUIRE, "agent");
            xb_add(&bar[XB_XGEN(b.x)], 1u);
            asm volatile("s_waitcnt vmcnt(0)" ::: "memory");
        } else {
            XB_SPIN(xb_ld(&bar[XB_XGEN(b.x)]) == gen, bar);
            __builtin_amdgcn_fence(__ATOMIC_ACQUIRE, "agent");
            asm volatile("s_waitcnt vmcnt(0)" ::: "memory");
        }
    }
    __syncthreads();
}

constexpr int NWAVES = 8, NTHR = 512;
constexpr int DMODEL = 1024, SEQ = 4096, NB = 4, NS = 32, ST = 8, NPG = 64, PAGE = 128;
constexpr int MP = NB * SEQ, MS = NS * ST, MT = MP + MS;
constexpr int FF = 2752, FFP = 2816, NGU = 2 * FFP, NIE = 2560, NIO = 1536;
constexpr float EPS = 1e-6f;
constexpr float C2 = 0.125f * 1.4426950408889634f;
constexpr float LAM_INIT0 = 0.2f;
constexpr int NSPLIT = 16, PSTR = 132;

constexpr size_t O_Y = 0;
constexpr size_t O_KP = O_Y + (size_t)MT * 1024;
constexpr size_t O_VP = O_KP + (size_t)MP * 512;
constexpr size_t O_CBP = O_VP + (size_t)MP * 512;
constexpr size_t O_HBP = O_CBP + NB * 3 * 512;
constexpr size_t O_CREP = O_HBP + NB * 512;
constexpr size_t O_CIMP = O_CREP + NB * 32 * 64;
constexpr size_t O_CDP = O_CIMP + NB * 32 * 64;
constexpr size_t O_KS = O_CDP + NB * 30 * 512;
constexpr size_t O_VS = O_KS + (size_t)MS * 512;
constexpr size_t O_CBS = O_VS + (size_t)MS * 512;
constexpr size_t O_HBS = O_CBS + NS * 3 * 512;
constexpr size_t O_CRES = O_HBS + NS * 512;
constexpr size_t O_CIMS = O_CRES + NS * 32 * 64;
constexpr size_t O_CDS = O_CIMS + NS * 32 * 64;
constexpr size_t O_END = O_CDS + NS * 30 * 512;
static_assert(O_END == 34852864, "output size");

enum { I_XP = 0, I_XS, I_CK, I_CV, I_SCB, I_SHB, I_SCRE, I_SCIM, I_SCD, I_PT, I_F1G, I_F1GU, I_F1DN, I_MIXG, I_F2G, I_F2GU, I_F2DN, I_EWIN, I_EWOUT, I_AQG, I_AKG, I_ALAM, I_AHG,
       I_BCW, I_BCB, I_BGW, I_BGB, I_BLAM, I_OWIN, I_OWOUT, I_CARE, I_CAIM, I_CLDT, I_CBRE, I_CBIM, I_CCRE, I_CCIM, I_CD, I_CGLUW, I_CGLUB, I_DCW, I_DCB, I_DLNG, I_DLNB, N_IN };
static_assert(N_IN == 44, "inputs");

constexpr size_t MiB = 1u << 20;
constexpr size_t WS_CTL = 0, CTL_ZERO_BYTES = 1 * MiB;
constexpr size_t WS_WGU = 2 * MiB, WGU_BYTES = (size_t)NGU * 1024 * 2;
constexpr size_t WS_WDN = 46 * MiB, WDN_BYTES = (size_t)1024 * FFP * 2;
constexpr size_t WS_WIE = 68 * MiB, WS_WOE = 73 * MiB, WS_WIO = 75 * MiB, WS_WOO = 78 * MiB, WS_WGLU = 80 * MiB;
constexpr size_t WS_XB = 82 * MiB;
constexpr size_t WS_SS = 115 * MiB;
constexpr size_t WS_H = 118 * MiB;
constexpr size_t WS_Q = 208 * MiB, WS_K = 225 * MiB, WS_V = 242 * MiB;
constexpr size_t WS_XBF = 259 * MiB, WS_GBF = 292 * MiB;
constexpr size_t WS_O2 = 325 * MiB;
constexpr size_t WS_MIX = 357 * MiB;
constexpr size_t WS_U = 390 * MiB, WS_G = 423 * MiB;
constexpr size_t WS_Z = 456 * MiB;
constexpr size_t WS_PART = 473 * MiB;
constexpr size_t WS_HL = 492 * MiB, WS_CPD = 525 * MiB;
constexpr size_t WS_TOT = 558 * MiB;
constexpr size_t WS_END = 560 * MiB;
static_assert(WS_WGU + 4 * WGU_BYTES <= WS_WDN && WS_WDN + 4 * WDN_BYTES <= WS_WIE && WS_XB + (size_t)MT * 1024 * 2 <= WS_SS && WS_SS + (size_t)MT * 64 <= WS_H && WS_H + (size_t)MT * FFP * 2 <= WS_Q, "ws map 1");
static_assert(WS_Q + (size_t)MT * 1024 <= WS_K && WS_V + (size_t)MT * 1024 <= WS_XBF && WS_XBF + (size_t)MT * 2048 <= WS_GBF && WS_GBF + (size_t)MT * 2048 <= WS_O2 && WS_O2 + (size_t)MP * 2048 <= WS_MIX, "ws map 2");
static_assert(WS_MIX + (size_t)MT * 2048 <= WS_U && WS_U + (size_t)MT * 2048 <= WS_G && WS_G + (size_t)MT * 2048 <= WS_Z && WS_Z + (size_t)MT * 1024 <= WS_PART && WS_PART + (size_t)NS * 4 * NSPLIT * 16 * PSTR * 4 <= WS_END, "ws map 3");
constexpr int CW_TMO = 0, CW_CODE = 1;
constexpr int CW_BAR = 4096;
constexpr int CW_Q0 = 8192, CW_Q1 = 8192 + 256;

constexpr int RING_OFF = 0, RING_BYTES = 131072;
constexpr int LDSCTL_OFF = RING_BYTES, MISC_OFF = LDSCTL_OFF + 320;
constexpr int RSTAB_OFF = LDSCTL_OFF + 1024, RSTAB_SLOTS = 8;
constexpr int LDS_BYTES = 147456;
static_assert(RSTAB_OFF + RSTAB_SLOTS * 1024 <= LDS_BYTES, "LDS map");

typedef float f32x2 __attribute__((ext_vector_type(2)));
typedef unsigned u32x2 __attribute__((ext_vector_type(2)));
#define DPP_ADD_(v_, ctrl_) v_ += __int_as_float(__builtin_amdgcn_update_dpp(0, __float_as_int(v_), ctrl_, 0xf, 0xf, true))
__device__ __forceinline__ float row16_sum(float v) {
    DPP_ADD_(v, 0xB1);
    DPP_ADD_(v, 0x4E);
    DPP_ADD_(v, 0x124);
    DPP_ADD_(v, 0x128);
    return v;
}
__device__ __forceinline__ float wave_sum(float v) {
    const int r = __float_as_int(row16_sum(v));
    return (__int_as_float(__builtin_amdgcn_readlane(r, 0)) + __int_as_float(__builtin_amdgcn_readlane(r, 16))) + (__int_as_float(__builtin_amdgcn_readlane(r, 32)) + __int_as_float(__builtin_amdgcn_readlane(r, 48)));
}
__device__ __forceinline__ float bf2f(unsigned h) { return __uint_as_float(h << 16); }
__device__ __forceinline__ float sigmoid_f(float x) { return __builtin_amdgcn_rcpf(1.f + __expf(-x)); }
__device__ __forceinline__ float gelu_tanh_f(float x) { return x * sigmoid_f(1.5957691216057308f * (x + 0.044715f * x * x * x)); }
__device__ __forceinline__ v4u pack8(const f32x4 a, const f32x4 b) { v4u w; w.x = pk2(a[0], a[1]); w.y = pk2(a[2], a[3]); w.z = pk2(b[0], b[1]); w.w = pk2(b[2], b[3]); return w; }

template <class Sched> __device__ __forceinline__ void rstd_table_fill(LAS float* tab, const float* SS, const Sched& S, int tid) {
    const int row = tid & 255;
#pragma unroll
    for (int i0 = 0; i0 < RSTAB_SLOTS; i0 += 2) { const int i = i0 + (tid >> 8); pg8::Unit u; const bool ok = S.next(i, u);
        const f32x4* q = (const f32x4*)(SS + (size_t)((ok ? u.pm : 0) * 256 + row) * 16);
        const f32x4 a = q[0], b = q[1], c = q[2], d = q[3];
        const float t = ((a[0] + a[1]) + (a[2] + a[3])) + ((b[0] + b[1]) + (b[2] + b[3])) + ((c[0] + c[1]) + (c[2] + c[3])) + ((d[0] + d[1]) + (d[2] + d[3]));
        if (ok) tab[i * 256 + row] = rsqrtf(t * (1.f / 1024.f) + EPS); }
    __syncthreads();
}
__device__ __forceinline__ void rows_rstd(const LAS float* tab, int ui, int prow0, float (&rs)[2][4]) {
#pragma unroll
    for (int ai = 0; ai < 2; ++ai)
#pragma unroll
        for (int m = 0; m < 4; ++m) rs[ai][m] = tab[ui * 256 + prow0 + ai * 128 + m * 16];
}
using pg8::Unit;
struct EpiSwiGLU {
    static constexpr bool PERM = true, AFTER_DRAIN = false, INIT_ACC = false, HAS_PRE = true;
    const float* SSp; template <class Sched> __device__ __forceinline__ void pre(const Sched& S, int tid) const { rstd_table_fill((LAS float*)TAB, SSp, S, tid); }
    bf16* H; const LAS float* TAB;
    __device__ __forceinline__ void operator()(const f32x4 (&acc)[2][2][4][2], const Unit& u, int wr, int wc, int fr, int fq, int ui) const {
        const int row0 = u.pm * 256 + wr * 64 + fr, col0 = u.pn * 128 + wc * 32 + 8 * fq;
        float rsv[2][4]; rows_rstd(TAB, ui, wr * 64 + fr, rsv);
#pragma unroll
        for (int ai = 0; ai < 2; ++ai)
#pragma unroll
            for (int m = 0; m < 4; ++m) {
                const int r = row0 + ai * 128 + m * 16; const float rs = rsv[ai][m];
                f32x4 hv[2];
#pragma unroll
                for (int n = 0; n < 2; ++n) { const f32x4 g = acc[ai][0][m][n] * rs, up = acc[ai][1][m][n] * rs;
#pragma unroll
                    for (int i = 0; i < 4; ++i) hv[n][i] = g[i] * sigmoid_f(g[i]) * up[i]; }
                *(v4u*)(H + (size_t)r * FFP + col0) = pack8(hv[0], hv[1]);
            }
    }
};
struct EpiResid {
    static constexpr bool PERM = false, AFTER_DRAIN = false, INIT_ACC = true, HAS_PRE = false;
    const GAS float* Xin; GAS float* X; bf16* XB; float* SS; float s, sinv; int wxb;
    __device__ __forceinline__ void init(f32x4 (&acc)[2][2][4][2], const Unit& u, int wr, int wc, int fr, int fq) const {
        const int row0 = u.pm * 256 + wr * 64 + fr, col0 = u.pn * 256 + wc * 32 + 4 * fq;
#pragma unroll
        for (int ai = 0; ai < 2; ++ai)
#pragma unroll
            for (int m = 0; m < 4; ++m)
#pragma unroll
                for (int bj = 0; bj < 2; ++bj)
#pragma unroll
                    for (int n = 0; n < 2; ++n) acc[ai][bj][m][n] = *(const GAS f32x4*)(Xin + (size_t)(row0 + ai * 128 + m * 16) * 1024 + col0 + bj * 128 + n * 16) * sinv;
    }
    __device__ __forceinline__ void operator()(const f32x4 (&acc)[2][2][4][2], const Unit& u, int wr, int wc, int fr, int fq, int ui) const {
        const int row0 = u.pm * 256 + wr * 64 + fr, col0 = u.pn * 256 + wc * 32 + 4 * fq;
#pragma unroll
        for (int ai = 0; ai < 2; ++ai)
#pragma unroll
            for (int m = 0; m < 4; ++m) {
                const int r = row0 + ai * 128 + m * 16; float q = 0.f;
#pragma unroll
                for (int bj = 0; bj < 2; ++bj)
#pragma unroll
                    for (int n = 0; n < 2; ++n) { const size_t off = (size_t)r * 1024 + col0 + bj * 128 + n * 16;
                        const f32x4 x = acc[ai][bj][m][n] * s; *(GAS f32x4*)(X + off) = x;
                        q += (x[0] * x[0] + x[1] * x[1]) + (x[2] * x[2] + x[3] * x[3]);
                        if (wxb) { u32x2 w; w.x = pk2(x[0], x[1]); w.y = pk2(x[2], x[3]); *(u32x2*)(XB + off) = w; } }
                q += __shfl_xor(q, 16); q += __shfl_xor(q, 32);
                if (wxb && fq == 0) SS[(size_t)r * 16 + u.pn * 4 + wc] = q;
            }
    }
};
struct EpiInEven {
    static constexpr bool PERM = true, AFTER_DRAIN = false, INIT_ACC = false, HAS_PRE = true;
    const float* SSp; template <class Sched> __device__ __forceinline__ void pre(const Sched& S, int tid) const { rstd_table_fill((LAS float*)TAB, SSp, S, tid); }
    bf16 *Q, *K, *V, *XBF, *GBF; float *okp, *ovp, *oks, *ovs, *ocbp, *ocbs; const LAS float* TAB; const float *qg, *kg;
    __device__ __forceinline__ void operator()(const f32x4 (&acc)[2][2][4][2], const Unit& u, int wr, int wc, int fr, int fq, int ui) const {
        const int row0 = u.pm * 256 + wr * 64 + fr; const int t = u.pn >> 1, chunk = (u.pn & 1) * 4 + wc, fc0 = chunk * 64 + 8 * fq;
        float rsv[2][4]; rows_rstd(TAB, ui, wr * 64 + fr, rsv);
        f32x4 gn[2][2];
        if (t < 2) { const float* gp = (t == 0 ? qg : kg) + 8 * fq; const float gs = (t == 0) ? C2 : 1.f;
#pragma unroll
            for (int bj = 0; bj < 2; ++bj)
#pragma unroll
                for (int n = 0; n < 2; ++n) gn[bj][n] = *(const f32x4*)(gp + 32 * bj + 4 * n) * gs; }
#pragma unroll
        for (int ai = 0; ai < 2; ++ai)
#pragma unroll
            for (int m = 0; m < 4; ++m) {
                const int r = row0 + ai * 128 + m * 16; const float rs = rsv[ai][m];
                f32x4 v[2][2];
#pragma unroll
                for (int bj = 0; bj < 2; ++bj)
#pragma unroll
                    for (int n = 0; n < 2; ++n) v[bj][n] = acc[ai][bj][m][n] * rs;
                if (t < 2) {
                    float q = 0.f;
#pragma unroll
                    for (int bj = 0; bj < 2; ++bj)
#pragma unroll
                        for (int n = 0; n < 2; ++n) q += (v[bj][n][0] * v[bj][n][0] + v[bj][n][1] * v[bj][n][1]) + (v[bj][n][2] * v[bj][n][2] + v[bj][n][3] * v[bj][n][3]);
                    q += __shfl_xor(q, 16); q += __shfl_xor(q, 32);
                    const float nr = rsqrtf(q * (1.f / 64.f) + EPS);
#pragma unroll
                    for (int bj = 0; bj < 2; ++bj)
#pragma unroll
                        for (int n = 0; n < 2; ++n) v[bj][n] = v[bj][n] * nr * gn[bj][n];
                }
                const size_t o5 = (size_t)r * 512 + fc0;
                if (t == 0) { *(v4u*)(Q + o5) = pack8(v[0][0], v[0][1]); *(v4u*)(Q + o5 + 32) = pack8(v[1][0], v[1][1]); }
                else if (t <= 2) {
                    bf16* B = (t == 1) ? K : V; *(v4u*)(B + o5) = pack8(v[0][0], v[0][1]); *(v4u*)(B + o5 + 32) = pack8(v[1][0], v[1][1]);
                    float* O = (r < MP) ? ((t == 1 ? okp : ovp) + o5) : ((t == 1 ? oks : ovs) + (o5 - (size_t)MP * 512));
                    *(f32x4*)(O) = v[0][0]; *(f32x4*)(O + 4) = v[0][1]; *(f32x4*)(O + 32) = v[1][0]; *(f32x4*)(O + 36) = v[1][1];
                } else if (t == 3) {
                    *(v4u*)(XBF + o5) = pack8(v[0][0], v[0][1]); *(v4u*)(XBF + o5 + 32) = pack8(v[1][0], v[1][1]);
                    float* O = nullptr;
                    if (u.pm * 256 >= MP) { const int rr = r - MP; if ((rr & 7) >= 5) O = ocbs + (size_t)((rr >> 3) * 3 + (rr & 7) - 5) * 512 + fc0; }
                    else if ((u.pm & (SEQ / 256 - 1)) == SEQ / 256 - 1) { const int tq = r & (SEQ - 1); if (tq >= SEQ - 3) O = ocbp + (size_t)((r / SEQ) * 3 + tq - (SEQ - 3)) * 512 + fc0; }
                    if (O) { *(f32x4*)(O) = v[0][0]; *(f32x4*)(O + 4) = v[0][1]; *(f32x4*)(O + 32) = v[1][0]; *(f32x4*)(O + 36) = v[1][1]; }
                } else { *(v4u*)(GBF + o5) = pack8(v[0][0], v[0][1]); *(v4u*)(GBF + o5 + 32) = pack8(v[1][0], v[1][1]); }
            }
    }
};
struct EpiInOdd {
    static constexpr bool PERM = false, AFTER_DRAIN = false, INIT_ACC = false, HAS_PRE = true;
    const float* SSp; template <class Sched> __device__ __forceinline__ void pre(const Sched& S, int tid) const { rstd_table_fill((LAS float*)TAB, SSp, S, tid); }
    bf16 *U, *G; const LAS float* TAB; float *ocdp, *ocds;
    __device__ __forceinline__ void operator()(const f32x4 (&acc)[2][2][4][2], const Unit& u, int wr, int wc, int fr, int fq, int ui) const {
        const int row0 = u.pm * 256 + wr * 64 + fr, cw = wc * 32 + 4 * fq;
        float rsv[2][4]; rows_rstd(TAB, ui, wr * 64 + fr, rsv);
        const bool smp = u.pm * 256 >= MP, tailp = !smp && (u.pm & (SEQ / 256 - 1)) == SEQ / 256 - 1;
#pragma unroll
        for (int ai = 0; ai < 2; ++ai)
#pragma unroll
            for (int m = 0; m < 4; ++m) {
                const int r = row0 + ai * 128 + m * 16; const float rs = rsv[ai][m];
                if (u.pn < 2) {
#pragma unroll
                    for (int bj = 0; bj < 2; ++bj)
#pragma unroll
                        for (int n = 0; n < 2; ++n) { const f32x4 o = acc[ai][bj][m][n] * rs; u32x2 w; w.x = pk2(o[0], o[1]); w.y = pk2(o[2], o[3]); *(u32x2*)(U + (size_t)r * 512 + u.pn * 256 + bj * 128 + cw + n * 16) = w; }
                } else {
#pragma unroll
                    for (int n = 0; n < 2; ++n) { const f32x4 val = acc[ai][0][m][n] * rs, gt = acc[ai][1][m][n] * rs; f32x4 o;
#pragma unroll
                        for (int i = 0; i < 4; ++i) o[i] = val[i] * sigmoid_f(gt[i]);
                        const int col = (u.pn - 2) * 128 + cw + n * 16; u32x2 w; w.x = pk2(o[0], o[1]); w.y = pk2(o[2], o[3]);
                        *(u32x2*)(G + (size_t)r * 512 + col) = w;
                        if (smp) { const int rr = r - MP; *(f32x4*)(ocds + (size_t)((rr >> 3) * 30 + 22 + (rr & 7)) * 512 + col) = o; }
                        else if (tailp) { const int t = r & (SEQ - 1); if (t >= SEQ - 30) *(f32x4*)(ocdp + (size_t)((r / SEQ) * 30 + t - (SEQ - 30)) * 512 + col) = o; } }
                }
            }
    }
};
struct EpiGLU {
    static constexpr bool PERM = true, AFTER_DRAIN = false, INIT_ACC = false, HAS_PRE = false;
    const bf16* Z; bf16* MIX; const float* bias;
    __device__ __forceinline__ void operator()(const f32x4 (&acc)[2][2][4][2], const Unit& u, int wr, int wc, int fr, int fq, int ui) const {
        const int row0 = u.pm * 256 + wr * 64 + fr, col0 = u.pn * 256 + wc * 32 + 8 * fq;
        f32x4 bb[2][2];
#pragma unroll
        for (int bj = 0; bj < 2; ++bj) { bb[bj][0] = *(const f32x4*)(bias + col0 + bj * 128); bb[bj][1] = *(const f32x4*)(bias + col0 + bj * 128 + 4); }
        v4u zz[2][4][2];
#pragma unroll
        for (int ai = 0; ai < 2; ++ai)
#pragma unroll
            for (int m = 0; m < 4; ++m)
#pragma unroll
                for (int bj = 0; bj < 2; ++bj) zz[ai][m][bj] = *(const v4u*)(Z + (size_t)(row0 + ai * 128 + m * 16) * 512 + col0 + bj * 128);
#pragma unroll
        for (int ai = 0; ai < 2; ++ai)
#pragma unroll
            for (int m = 0; m < 4; ++m) {
                const int r = row0 + ai * 128 + m * 16;
#pragma unroll
                for (int bj = 0; bj < 2; ++bj) { const int c = col0 + bj * 128; const v4u z4 = zz[ai][m][bj];
                    const float z[8] = {bf2f(z4.x & 0xffffu), bf2f(z4.x >> 16), bf2f(z4.y & 0xffffu), bf2f(z4.y >> 16), bf2f(z4.z & 0xffffu), bf2f(z4.z >> 16), bf2f(z4.w & 0xffffu), bf2f(z4.w >> 16)};
                    f32x4 o0, o1;
#pragma unroll
                    for (int i = 0; i < 4; ++i) { o0[i] = z[i] * sigmoid_f(acc[ai][bj][m][0][i] + bb[bj][0][i]); o1[i] = z[4 + i] * sigmoid_f(acc[ai][bj][m][1][i] + bb[bj][1][i]); }
                    *(v4u*)(MIX + (size_t)r * 1024 + c) = pack8(o0, o1); }
            }
    }
};

template <int K>
__device__ __forceinline__ void gemm_small_resid(const bf16* A, const bf16* Bt, const GAS float* Xin, GAS float* X, bf16* XB, float* SS, float s, bool wxb, LAS unsigned char* lds, int G, int first, int tid) {
    const int wave = __builtin_amdgcn_readfirstlane(tid >> 6), lane = tid & 63, m16 = lane & 15, quad = lane >> 4;
    constexpr int KW = K / 8, STEPS = KW / 32, GRP = (STEPS + 1) / 2 > 6 ? 6 : (STEPS <= 6 ? STEPS : (STEPS + 1) / 2); static_assert(K % 256 == 0 && STEPS <= 12, "K split");
    LAS float* part = (LAS float*)lds;
    for (int tile = first; tile < 256; tile += G) {
        const int rt = tile >> 4, ct = tile & 15;
        const int row = tid >> 5, cp = tid & 31;
        const size_t off = (size_t)(rt * 16 + row) * 1024 + ct * 64 + cp * 2;
        const f32x2 xin = *(const GAS f32x2*)(Xin + off);
        const bf16* ap = A + (size_t)(rt * 16 + m16) * K + wave * KW + quad * 8;
        const bf16* bp = Bt + (size_t)(ct * 64 + m16) * K + wave * KW + quad * 8;
        f32x4 acc[4];
#pragma unroll
        for (int nt = 0; nt < 4; ++nt) acc[nt] = (f32x4){0.f, 0.f, 0.f, 0.f};
#pragma unroll 1
        for (int s0 = 0; s0 < STEPS; s0 += GRP) {
            bf16x8 af[GRP], bfr[GRP][4];
#pragma unroll
            for (int j = 0; j < GRP; ++j) if (s0 + j < STEPS) { af[j] = *(const bf16x8*)(ap + (s0 + j) * 32);
#pragma unroll
                for (int nt = 0; nt < 4; ++nt) bfr[j][nt] = *(const bf16x8*)(bp + (size_t)nt * 16 * K + (s0 + j) * 32); }
#pragma unroll
            for (int j = 0; j < GRP; ++j) if (s0 + j < STEPS) {
#pragma unroll
                for (int nt = 0; nt < 4; ++nt) acc[nt] = __builtin_amdgcn_mfma_f32_16x16x32_bf16(af[j], bfr[j][nt], acc[nt], 0, 0, 0); }
        }
#pragma unroll
        for (int nt = 0; nt < 4; ++nt)
#pragma unroll
            for (int i = 0; i < 4; ++i) part[(wave * 16 + quad * 4 + i) * 68 + nt * 16 + m16] = acc[nt][i];
        __syncthreads();
        float s0_ = 0.f, s1_ = 0.f;
#pragma unroll
        for (int w = 0; w < 8; ++w) { const f32x2 v = *(const LAS f32x2*)(part + (w * 16 + row) * 68 + cp * 2); s0_ += v.x; s1_ += v.y; }
        f32x2 x = xin; x.x += s * s0_; x.y += s * s1_; *(GAS f32x2*)(X + off) = x;
        float q = x.x * x.x + x.y * x.y;
        if (wxb) *(unsigned*)(XB + off) = pk2(x.x, x.y);
#pragma unroll
        for (int o = 1; o < 32; o <<= 1) q += __shfl_xor(q, o);
        if (wxb && cp == 0) SS[(size_t)(rt * 16 + row) * 16 + ct] = q;
        __syncthreads();
    }
}

struct Args { const void* in[44]; float* out; unsigned char* ws; int ph_lo, ph_hi; };
struct Ctx {
    LAS unsigned char* lds; volatile LAS unsigned* MISC; gu32* ctl;
    int tid, lane, wave, vcu, G;
    GAS float* out; GAS unsigned char* ws;
};
#define INF(i) ((const float*)(const GAS float*)A.in[i])
#define P_XB ((bf16*)(GAS bf16*)(C.ws + WS_XB))
#define P_H ((bf16*)(GAS bf16*)(C.ws + WS_H))
#define P_Q ((bf16*)(GAS bf16*)(C.ws + WS_Q))
#define P_K ((bf16*)(GAS bf16*)(C.ws + WS_K))
#define P_V ((bf16*)(GAS bf16*)(C.ws + WS_V))
#define P_O2 ((bf16*)(GAS bf16*)(C.ws + WS_O2))
#define P_MIX ((bf16*)(GAS bf16*)(C.ws + WS_MIX))
#define P_Z ((bf16*)(GAS bf16*)(C.ws + WS_Z))
#define P_SS ((float*)(GAS float*)(C.ws + WS_SS))
#define P_XBF ((bf16*)(GAS bf16*)(C.ws + WS_XBF))
#define P_GBF ((bf16*)(GAS bf16*)(C.ws + WS_GBF))
#define P_U ((bf16*)(GAS bf16*)(C.ws + WS_U))
#define P_GG ((bf16*)(GAS bf16*)(C.ws + WS_G))
#define P_PART ((float*)(GAS float*)(C.ws + WS_PART))
#define P_HC ((unsigned*)(GAS unsigned*)(C.ws + WS_HL))
#define P_TOT ((float*)(GAS float*)(C.ws + WS_TOT))

struct ConvD { const float* W; const float* gain; bf16* WT; int ldw, scol0, k0, Kdst, drow0; bool valid; };
enum { WT_GU = 0, WT_NAT = 1, WT_INE = 2, WT_INO = 3 };
__device__ __forceinline__ int src_col(int type, int n0) {
    const int pn = n0 >> 8, bj = (n0 >> 7) & 1;
    if (type == WT_GU) { const int j = pn * 128 + (n0 & 127); return j < FF ? bj * FF + j : -1; }
    if (type == WT_INE) { const int t = pn >> 1, wc = (n0 >> 5) & 3; return t * 512 + ((pn & 1) * 4 + wc) * 64 + bj * 32; }
    if (type == WT_INO) { return pn < 2 ? n0 : 512 + bj * 512 + (pn - 2) * 128 + (n0 & 127); }
    return n0;
}
__device__ __forceinline__ ConvD conv_mat(int type, const float* W, int ldw, int Ksrc, const float* gain, bf16* WT, int Kdst, int Ndst, int item) {
    const int nblk = Ndst / 32, kb = item / nblk, nb = item % nblk, k0 = kb * 64, n0 = nb * 32; const int sc = src_col(type, n0);
    ConvD d; d.W = W; d.gain = gain; d.WT = WT; d.ldw = ldw; d.scol0 = sc; d.k0 = k0; d.Kdst = Kdst; d.drow0 = n0; d.valid = (sc >= 0) && (k0 < Ksrc); return d;
}
__device__ __forceinline__ ConvD conv_decode(const Args& A, Ctx& C, int it) {
    constexpr int I_GU = 16 * (NGU / 32), I_DN = (FFP / 64) * 32, I_IE = 16 * (NIE / 32), I_O = 16 * 32, I_IO = 16 * (NIO / 32);
    int r = it;
    if (r < 4 * I_GU) { const int mi = r / I_GU, l = mi >> 1, f = mi & 1; r -= mi * I_GU;
        return conv_mat(WT_GU, (f ? INF(I_F2GU) : INF(I_F1GU)) + (size_t)l * 1024 * 5504, 5504, 1024, (f ? INF(I_F2G) : INF(I_F1G)) + l * 1024, (bf16*)(GAS bf16*)(C.ws + WS_WGU + mi * WGU_BYTES), 1024, NGU, r); }
    r -= 4 * I_GU;
    if (r < 4 * I_DN) { const int mi = r / I_DN, l = mi >> 1, f = mi & 1; r -= mi * I_DN;
        return conv_mat(WT_NAT, (f ? INF(I_F2DN) : INF(I_F1DN)) + (size_t)l * FF * 1024, 1024, FF, nullptr, (bf16*)(GAS bf16*)(C.ws + WS_WDN + mi * WDN_BYTES), FFP, 1024, r); }
    r -= 4 * I_DN;
    if (r < I_IE) return conv_mat(WT_INE, INF(I_EWIN), NIE, 1024, INF(I_MIXG), (bf16*)(GAS bf16*)(C.ws + WS_WIE), 1024, NIE, r);
    r -= I_IE;
    if (r < I_O) return conv_mat(WT_NAT, INF(I_EWOUT), 1024, 1024, nullptr, (bf16*)(GAS bf16*)(C.ws + WS_WOE), 1024, 1024, r);
    r -= I_O;
    if (r < I_IO) return conv_mat(WT_INO, INF(I_OWIN), NIO, 1024, INF(I_MIXG) + 1024, (bf16*)(GAS bf16*)(C.ws + WS_WIO), 1024, NIO, r);
    r -= I_IO;
    if (r < I_O) return conv_mat(WT_NAT, INF(I_OWOUT), 1024, 1024, nullptr, (bf16*)(GAS bf16*)(C.ws + WS_WOO), 1024, 1024, r);
    r -= I_O;
    return conv_mat(WT_NAT, INF(I_CGLUW), 512, 512, nullptr, (bf16*)(GAS bf16*)(C.ws + WS_WGLU), 512, 512, r);
}
__device__ __forceinline__ void conv_load(const ConvD& d, float (&wv)[32], float& g0, int lane) {
    const int sc = d.valid ? d.scol0 : 0, kq = d.valid ? d.k0 : 0;
#pragma unroll
    for (int i = 0; i < 32; ++i) { const int kk = 2 * i + (lane >> 5); wv[i] = d.W[(size_t)(kq + kk) * d.ldw + sc + (lane & 31)]; }
    g0 = d.gain ? d.gain[kq + lane] : 1.f;
}
__device__ __forceinline__ void conv_store(const ConvD& d, const float (&wv)[32], float g0, LAS float* scr, int lane) {
    const int c = lane & 7;
#pragma unroll
    for (int i = 0; i < 32; ++i) { const int kk = 2 * i + (lane >> 5); scr[kk * 33 + (lane & 31)] = d.valid ? wv[i] * __shfl(g0, kk) : 0.f; }
    LDS_WAIT(); asm volatile("" ::: "memory");
#pragma unroll
    for (int j = 0; j < 4; ++j) { const int n = (lane >> 3) + 8 * j; const LAS float* s = scr + (8 * c) * 33 + n;
        v4u o; o.x = pk2(s[0 * 33], s[1 * 33]); o.y = pk2(s[2 * 33], s[3 * 33]); o.z = pk2(s[4 * 33], s[5 * 33]); o.w = pk2(s[6 * 33], s[7 * 33]);
        *(GAS v4u*)(d.WT + (size_t)(d.drow0 + n) * d.Kdst + d.k0 + 8 * c) = o; }
    LDS_WAIT(); asm volatile("" ::: "memory");
}
struct ConvSeg { int start, n; };
template <int R> __device__ __forceinline__ int conv_range_item(int v) {
    constexpr int I_GU = 16 * (NGU / 32), I_DN = (FFP / 64) * 32, I_IE = 16 * (NIE / 32), I_O = 16 * 32, I_IO = 16 * (NIO / 32), I_GL = 8 * 16;
    constexpr int B_DN = 4 * I_GU, B_IE = B_DN + 4 * I_DN, B_OE = B_IE + I_IE, B_IO = B_OE + I_O, B_OO = B_IO + I_IO, B_GL = B_OO + I_O;
    constexpr ConvSeg segs[4][4] = { { {0, I_GU}, {B_DN, I_DN}, {B_IE, I_IE}, {0, 0} },
                                     { {B_OE, I_O}, {I_GU, I_GU}, {B_DN + I_DN, I_DN}, {0, 0} },
                                     { {2 * I_GU, I_GU}, {B_DN + 2 * I_DN, I_DN}, {B_IO, I_IO}, {0, 0} },
                                     { {B_GL, I_GL}, {B_OO, I_O}, {3 * I_GU, I_GU}, {B_DN + 3 * I_DN, I_DN} } };
#pragma unroll
    for (int k = 0; k < 4; ++k) { if (v < segs[R][k].n) return segs[R][k].start + v; v -= segs[R][k].n; }
    return -1;
}
template <int R> __device__ __forceinline__ void conv_run(const Args& A, Ctx& C, int gw, int NGW) {
    LAS float* scr = (LAS float*)(C.lds + RING_OFF + C.wave * 16384);
    for (int v = gw; ; v += 2 * NGW) {
        const int it0 = conv_range_item<R>(v); if (it0 < 0) break;
        const int it1 = conv_range_item<R>(v + NGW); const bool two = it1 >= 0;
        const ConvD d0 = conv_decode(A, C, it0), d1 = conv_decode(A, C, two ? it1 : it0);
        float w0[32], w1[32], g0, g1;
        conv_load(d0, w0, g0, C.lane); conv_load(d1, w1, g1, C.lane);
        conv_store(d0, w0, g0, scr, C.lane);
        if (two) conv_store(d1, w1, g1, scr, C.lane);
    }
}
__device__ __forceinline__ void p0_prologue(const Args& A, Ctx& C) {
    const int gw = C.vcu * NWAVES + C.wave, NGW = C.G * NWAVES;
    conv_run<0>(A, C, gw, NGW);
    for (int m0 = gw; m0 < MT; m0 += 4 * NGW) {
        f32x4 v[4][4]; float sq[4];
#pragma unroll
        for (int u = 0; u < 4; ++u) { const int m = m0 + u * NGW; const int mc = m < MT ? m : m0;
            const float* xrow = (mc < MP) ? INF(I_XP) + (size_t)mc * 1024 : INF(I_XS) + (size_t)(mc - MP) * 1024;
            const GAS f32x4* xr = (const GAS f32x4*)xrow + C.lane; float s = 0.f;
#pragma unroll
            for (int j = 0; j < 4; ++j) { v[u][j] = xr[64 * j]; s += (v[u][j].x * v[u][j].x + v[u][j].y * v[u][j].y) + (v[u][j].z * v[u][j].z + v[u][j].w * v[u][j].w); }
            sq[u] = s; }
#pragma unroll
        for (int u = 0; u < 4; ++u) { const int m = m0 + u * NGW; if (m >= MT) break;
            const float s = wave_sum(sq[u]);
            GAS unsigned long long* o8 = (GAS unsigned long long*)(P_XB + (size_t)m * 1024) + C.lane;
#pragma unroll
            for (int j = 0; j < 4; ++j) o8[64 * j] = (unsigned long long)pk2(v[u][j].x, v[u][j].y) | ((unsigned long long)pk2(v[u][j].z, v[u][j].w) << 32);
            if (C.lane < 16) P_SS[(size_t)m * 16 + C.lane] = (C.lane == 0) ? s : 0.f; }
    }
}

#define LDS_BAR() do { asm volatile("s_waitcnt lgkmcnt(0)" ::: "memory"); __builtin_amdgcn_s_barrier(); asm volatile("" ::: "memory"); } while (0)
__device__ __forceinline__ float lam_value(const float* lv, int lane) {
    const float a = wave_sum(lv[lane] * lv[64 + lane]), b = wave_sum(lv[128 + lane] * lv[192 + lane]);
    return expf(a) - expf(b) + LAM_INIT0;
}

__device__ __forceinline__ void split_hi_lo(const f32x4 a, const f32x4 b, v4u& hi, v4u& lo) {
    hi = pack8(a, b);
    f32x4 ra, rb;
    ra[0] = a[0] - __uint_as_float(hi.x << 16); ra[1] = a[1] - __uint_as_float(hi.x & 0xffff0000u); ra[2] = a[2] - __uint_as_float(hi.y << 16); ra[3] = a[3] - __uint_as_float(hi.y & 0xffff0000u);
    rb[0] = b[0] - __uint_as_float(hi.z << 16); rb[1] = b[1] - __uint_as_float(hi.z & 0xffff0000u); rb[2] = b[2] - __uint_as_float(hi.w << 16); rb[3] = b[3] - __uint_as_float(hi.w & 0xffff0000u);
    lo = pack8(ra, rb);
}
template <bool SAMPLE>
__device__ __forceinline__ void rglru_item(const Args& A, Ctx& C, int bi, int ch, int blk) {
    LAS float* R0 = (LAS float*)(C.lds);
    LAS bf16* XH = (LAS bf16*)(C.lds);
    LAS bf16* XL = (LAS bf16*)(C.lds + 18432);
    LAS float* R1 = (LAS float*)(C.lds + 45056);
    LAS float* R2 = (LAS float*)(C.lds + 45056 + 32768);
    LAS float* RP = (LAS float*)(C.lds + 45056 + 65536);
    LAS float* RH = RP + 512;
    const int c = C.tid & 63, sub = C.wave, ch0 = blk * 64 + c, lane = C.lane, m16 = lane & 15, quad = lane >> 4;
    const int g = sub >> 2, j0 = (sub & 3) * 16;
    v4u wh[2], wl[2];
    { const float* wp = INF(I_BGW) + ((size_t)(g * 8 + blk) * 64 + quad * 8) * 64 + j0 + m16;
#pragma unroll
      for (int ks = 0; ks < 2; ++ks) { f32x4 x0, x1;
#pragma unroll
          for (int i = 0; i < 4; ++i) { x0[i] = wp[(size_t)(ks * 32 + i) * 64]; x1[i] = wp[(size_t)(ks * 32 + 4 + i) * 64]; }
          split_hi_lo(x0, x1, wh[ks], wl[ks]); } }
    const float gbias = INF(I_BGB)[g * 512 + blk * 64 + j0 + m16];
    f32x4 kw[4][4], kb[4];
    { const int cq0 = (C.tid & 3) * 16;
#pragma unroll
      for (int q = 0; q < 4; ++q) { const int cc = blk * 64 + cq0 + q * 4; kb[q] = *(const f32x4*)(INF(I_BCB) + cc);
#pragma unroll
          for (int k = 0; k < 4; ++k) kw[k][q] = *(const f32x4*)(INF(I_BCW) + k * 512 + cc); } }
    const float sp8 = -8.f * log1pf(expf(-INF(I_BLAM)[blk * 64 + j0 + m16]));
    if (!SAMPLE) {
        const int t0 = ch * 128;
#pragma unroll
        for (int e0 = 0; e0 < 131 * 16; e0 += NTHR) { const int e = e0 + C.tid; if (e >= 131 * 16) break; const int i = e >> 4, q4 = (e & 15) * 4, tk = t0 - 3 + i;
            const u32x2 w = *(const u32x2*)(P_XBF + (size_t)(bi * SEQ + (tk < 0 ? 0 : tk)) * 512 + blk * 64 + q4);
            f32x4 v = {__uint_as_float(w.x << 16), __uint_as_float(w.x & 0xffff0000u), __uint_as_float(w.y << 16), __uint_as_float(w.y & 0xffff0000u)};
            if (tk < 0) v = (f32x4){0.f, 0.f, 0.f, 0.f};
            *(LAS f32x4*)(R0 + i * 64 + q4) = v; }
    } else {
#pragma unroll
        for (int e0 = 0; e0 < 176 * 16; e0 += NTHR) { const int e = e0 + C.tid; if (e >= 176 * 16) break; const int i = e >> 4, q4 = (e & 15) * 4, sl = i / 11, k = i % 11, n = bi * 16 + sl;
            f32x4 v;
            if (k < 3) v = *(const f32x4*)(INF(I_SCB) + (size_t)(n * 3 + k) * 512 + blk * 64 + q4);
            else { const u32x2 w = *(const u32x2*)(P_XBF + (size_t)(MP + n * 8 + (k - 3)) * 512 + blk * 64 + q4); v = (f32x4){__uint_as_float(w.x << 16), __uint_as_float(w.x & 0xffff0000u), __uint_as_float(w.y << 16), __uint_as_float(w.y & 0xffff0000u)}; }
            *(LAS f32x4*)(R0 + i * 64 + q4) = v; }
    }
    LDS_BAR();
    { const int lr = C.tid >> 2, cq = (C.tid & 3) * 16; const int base = SAMPLE ? ((lr >> 3) * 11 + (lr & 7)) : lr;
      f32x4 xo[4];
#pragma unroll
      for (int q = 0; q < 4; ++q) { const int cc = cq + q * 4;
          xo[q] = kb[q] + kw[0][q] * *(const LAS f32x4*)(R0 + base * 64 + cc) + kw[1][q] * *(const LAS f32x4*)(R0 + (base + 1) * 64 + cc) + kw[2][q] * *(const LAS f32x4*)(R0 + (base + 2) * 64 + cc) + kw[3][q] * *(const LAS f32x4*)(R0 + (base + 3) * 64 + cc);
          *(LAS f32x4*)(R1 + lr * 64 + cc) = xo[q]; }
      LDS_BAR();
      v4u h0, l0, h1, l1; split_hi_lo(xo[0], xo[1], h0, l0); split_hi_lo(xo[2], xo[3], h1, l1);
      *(LAS v4u*)(XH + lr * 72 + cq) = h0; *(LAS v4u*)(XH + lr * 72 + cq + 8) = h1; *(LAS v4u*)(XL + lr * 72 + cq) = l0; *(LAS v4u*)(XL + lr * 72 + cq + 8) = l1; }
    LDS_BAR();
#pragma unroll 2
    for (int mt = 0; mt < 8; ++mt) { f32x4 acc = (f32x4){0.f, 0.f, 0.f, 0.f};
#pragma unroll
        for (int ks = 0; ks < 2; ++ks) { const int xo_ = (mt * 16 + m16) * 72 + ks * 32 + quad * 8;
            const bf16x8 ah = *(const LAS bf16x8*)(XH + xo_), al = *(const LAS bf16x8*)(XL + xo_), bh_ = __builtin_bit_cast(bf16x8, wh[ks]), bl_ = __builtin_bit_cast(bf16x8, wl[ks]);
            acc = __builtin_amdgcn_mfma_f32_16x16x32_bf16(ah, bh_, acc, 0, 0, 0); acc = __builtin_amdgcn_mfma_f32_16x16x32_bf16(al, bh_, acc, 0, 0, 0); acc = __builtin_amdgcn_mfma_f32_16x16x32_bf16(ah, bl_, acc, 0, 0, 0); }
#pragma unroll
        for (int i = 0; i < 4; ++i) { const int t = mt * 16 + quad * 4 + i, j = j0 + m16; const float sg = sigmoid_f(acc[i] + gbias);
            if (g == 0) R2[t * 64 + j] = sp8 * sg; else R1[t * 64 + j] = sg * R1[t * 64 + j]; } }
    LDS_BAR();
    if (!SAMPLE) {
        float P = 1.f, Hl = 0.f;
#pragma unroll 4
        for (int k = 0; k < 16; ++k) { const int lr = sub * 16 + k; const float la = R2[lr * 64 + c]; const float a = __expf(la), bb = __builtin_amdgcn_sqrtf(fmaxf(1.f - a * a, 0.f)) * R1[lr * 64 + c];
            R2[lr * 64 + c] = a; R1[lr * 64 + c] = bb; P *= a; Hl = a * Hl + bb; }
        RP[sub * 64 + c] = P; RH[sub * 64 + c] = Hl;
        LDS_BAR();
        float h = 0.f, cp = 1.f;
        { float rp_[7], rh_[7];
#pragma unroll
          for (int k2 = 0; k2 < 7; ++k2) { rp_[k2] = RP[k2 * 64 + c]; rh_[k2] = RH[k2 * 64 + c]; }
#pragma unroll
          for (int k2 = 0; k2 < 7; ++k2) if (k2 < sub) { h = rp_[k2] * h + rh_[k2]; cp *= rp_[k2]; } }
        const size_t row0 = (size_t)bi * SEQ + ch * 128 + sub * 16;
#pragma unroll 4
        for (int k = 0; k < 16; ++k) { const int lr = sub * 16 + k; const float a = R2[lr * 64 + c]; h = a * h + R1[lr * 64 + c]; cp *= a;
            P_HC[(row0 + k) * 512 + ch0] = pk2(h, cp); }
        if (sub == 7) { P_TOT[(size_t)(bi * 32 + ch) * 512 + ch0] = cp; P_TOT[(size_t)(128 + bi * 32 + ch) * 512 + ch0] = h; }
    } else {
#pragma unroll
        for (int s2 = 0; s2 < 2; ++s2) { const int sl = sub * 2 + s2, n = bi * 16 + sl; float h = INF(I_SHB)[(size_t)n * 512 + ch0];
#pragma unroll
            for (int t = 0; t < 8; ++t) { const int lr = sl * 8 + t; const float la = R2[lr * 64 + c]; const float a = __expf(la), bb = __builtin_amdgcn_sqrtf(fmaxf(1.f - a * a, 0.f)) * R1[lr * 64 + c];
                h = a * h + bb; const size_t row = (size_t)MP + n * 8 + t;
                const float gv = bf2f((unsigned)(unsigned short)P_GBF[row * 512 + ch0]);
                P_MIX[row * 1024 + 512 + ch0] = (bf16)f2bf(gelu_tanh_f(gv) * h); }
            C.out[O_HBS + (size_t)n * 512 + ch0] = h; }
    }
    LDS_BAR();
}
__device__ __forceinline__ void rglru_fix(const Args& A, Ctx& C, int item) {
    const int b = item >> 6, ch = (item >> 1) & 31, hf = item & 1, c = C.tid;
    float tp[31], th[31];
#pragma unroll
    for (int k = 0; k < 31; ++k) { tp[k] = P_TOT[(size_t)(b * 32 + k) * 512 + c]; th[k] = P_TOT[(size_t)(128 + b * 32 + k) * 512 + c]; }
    float hin = 0.f;
#pragma unroll
    for (int k = 0; k < 31; ++k) hin = (k < ch) ? tp[k] * hin + th[k] : hin;
    const size_t row0 = (size_t)b * SEQ + ch * 128 + hf * 64;
    float h = 0.f;
#pragma unroll 1
    for (int t0 = 0; t0 < 64; t0 += 16) {
        unsigned hc[16]; unsigned gb[16];
#pragma unroll
        for (int k = 0; k < 16; ++k) { const size_t o = (row0 + t0 + k) * 512 + c; hc[k] = P_HC[o]; gb[k] = (unsigned)(unsigned short)P_GBF[o]; }
#pragma unroll
        for (int k = 0; k < 16; ++k) { h = bf2f(hc[k] & 0xffffu) + __uint_as_float(hc[k] & 0xffff0000u) * hin;
            P_MIX[(row0 + t0 + k) * 1024 + 512 + c] = (bf16)(pk2(gelu_tanh_f(bf2f(gb[k])) * h, 0.f) & 0xffffu); } }
    if (ch == 31 && hf == 1) C.out[O_HBP + (size_t)b * 512 + c] = P_TOT[(size_t)(b * 32 + 31) * 512 + c] * hin + P_TOT[(size_t)(128 + b * 32 + 31) * 512 + c];
}

__device__ __forceinline__ bf16x8 cvt8(const f32x4 a, const f32x4 b) { const v4u w = pack8(a, b); return __builtin_bit_cast(bf16x8, w); }
__device__ __forceinline__ void sattn_wave(const Args& A, Ctx& C, int n, int h, int s) {
    const int lane = C.lane, m16 = lane & 15, quad = lane >> 4, j = m16 >> 3, q = m16 & 7;
    bf16x8 bq[4];
#pragma unroll
    for (int kk = 0; kk < 4; ++kk) { bq[kk] = (bf16x8){0, 0, 0, 0, 0, 0, 0, 0};
        if (j == (kk >> 1)) bq[kk] = *(const bf16x8*)(P_Q + (size_t)(MP + n * 8 + q) * 512 + (h * 2 + j) * 64 + (kk & 1) * 32 + quad * 8); }
    float mrow = -1e30f, l = 0.f; f32x4 o[8];
#pragma unroll
    for (int dg = 0; dg < 8; ++dg) o[dg] = (f32x4){0.f, 0.f, 0.f, 0.f};
    constexpr int PPW = NPG / NSPLIT;
    const int* ptab = (const int*)(const GAS int*)A.in[I_PT] + n * NPG + s * PPW;
    const float* ckh = INF(I_CK) + h * 128; const float* cvh = INF(I_CV) + h * 128;
    const unsigned koff = (unsigned)(m16 * 512 + quad * 8);
    const unsigned voff = (unsigned)(quad * 4 * 512 + m16);
    f32x4 kq[16]; float vq[64];
#define SA_LOADK(ph_, ks_) do { const float* kb_ = ckh + ((size_t)(ph_) * PAGE + (ks_) * 32) * 512; \
        _Pragma("unroll") for (int tt = 0; tt < 2; ++tt) { const float* kr_ = kb_ + tt * 8192; asm volatile("" : "+s"(kr_)); \
            _Pragma("unroll") for (int kk = 0; kk < 4; ++kk) { kq[(tt * 4 + kk) * 2] = *(const f32x4*)(kr_ + (koff + (unsigned)(kk * 32))); kq[(tt * 4 + kk) * 2 + 1] = *(const f32x4*)(kr_ + (koff + (unsigned)(kk * 32 + 4))); } } } while (0)
#define SA_LOADV(ph_, ks_) do { const float* vb_ = cvh + ((size_t)(ph_) * PAGE + (ks_) * 32) * 512; \
        _Pragma("unroll") for (int i = 0; i < 4; ++i) { const float* v0_ = vb_ + i * 512; const float* v1_ = vb_ + (16 + i) * 512; asm volatile("" : "+s"(v0_), "+s"(v1_)); \
            _Pragma("unroll") for (int dg = 0; dg < 8; ++dg) { vq[dg * 8 + i] = v0_[voff + (unsigned)(dg * 16)]; vq[dg * 8 + 4 + i] = v1_[voff + (unsigned)(dg * 16)]; } } } while (0)
    int ph = __builtin_amdgcn_readfirstlane(ptab[0]);
    SA_LOADK(ph, 0); SA_LOADV(ph, 0);
#pragma unroll 1
    for (int pg = 0; pg < PPW; ++pg) {
        const bool lastpg = (pg + 1 == PPW); const int phn = __builtin_amdgcn_readfirstlane(ptab[lastpg ? pg : pg + 1]);
#pragma unroll 1
        for (int ks = 0; ks < 4; ++ks) {
            const int nph = (ks < 3) ? ph : phn, nks = (ks + 1) & 3; const bool more = !(lastpg && ks == 3);
            f32x4 sc2[2];
#pragma unroll
            for (int tt = 0; tt < 2; ++tt) { f32x4 acc = (f32x4){0.f, 0.f, 0.f, 0.f};
#pragma unroll
                for (int kk = 0; kk < 4; ++kk) acc = __builtin_amdgcn_mfma_f32_16x16x32_bf16(cvt8(kq[(tt * 4 + kk) * 2], kq[(tt * 4 + kk) * 2 + 1]), bq[kk], acc, 0, 0, 0);
                sc2[tt] = acc; }
            __builtin_amdgcn_sched_barrier(0);
            if (more) SA_LOADK(nph, nks);
            __builtin_amdgcn_sched_barrier(0);
            float mx = fmaxf(fmaxf(fmaxf(sc2[0][0], sc2[0][1]), fmaxf(sc2[0][2], sc2[0][3])), fmaxf(fmaxf(sc2[1][0], sc2[1][1]), fmaxf(sc2[1][2], sc2[1][3])));
            mx = fmaxf(mx, __shfl_xor(mx, 16)); mx = fmaxf(mx, __shfl_xor(mx, 32));
            const float mn = fmaxf(mrow, mx), scl = __builtin_amdgcn_exp2f(mrow - mn); mrow = mn;
            f32x4 p0, p1; float ps = 0.f;
#pragma unroll
            for (int i = 0; i < 4; ++i) { p0[i] = __builtin_amdgcn_exp2f(sc2[0][i] - mn); p1[i] = __builtin_amdgcn_exp2f(sc2[1][i] - mn); ps += p0[i] + p1[i]; }
            l = l * scl + ps;
            const bf16x8 pb = cvt8(p0, p1);
#pragma unroll
            for (int dg = 0; dg < 8; ++dg) { const f32x4 v0 = {vq[dg * 8], vq[dg * 8 + 1], vq[dg * 8 + 2], vq[dg * 8 + 3]}, v1 = {vq[dg * 8 + 4], vq[dg * 8 + 5], vq[dg * 8 + 6], vq[dg * 8 + 7]};
                o[dg] = o[dg] * scl; o[dg] = __builtin_amdgcn_mfma_f32_16x16x32_bf16(cvt8(v0, v1), pb, o[dg], 0, 0, 0); }
            __builtin_amdgcn_sched_barrier(0);
            if (more) SA_LOADV(nph, nks);
            __builtin_amdgcn_sched_barrier(0);
        }
        ph = phn;
    }
#undef SA_LOADK
#undef SA_LOADV
    l += __shfl_xor(l, 16); l += __shfl_xor(l, 32);
    float* pr = P_PART + ((size_t)((n * 4 + h) * NSPLIT + s) * 16 + m16) * PSTR;
#pragma unroll
    for (int dg = 0; dg < 8; ++dg) *(f32x4*)(pr + dg * 16 + quad * 4) = o[dg];
    if (quad == 0) { pr[128] = mrow; pr[129] = l; }
}

__device__ __forceinline__ void p5_combine(const Args& A, Ctx& C) {
    const int gw = C.vcu * NWAVES + C.wave, NGW = C.G * NWAVES, lane = C.lane;
    const float lam = lam_value(INF(I_ALAM), lane);
    const float osc = 1.f - LAM_INIT0;
    for (int it = C.vcu; it < 256; it += C.G) rglru_fix(A, C, it);
    {
        const int hh = lane >> 4, e0 = (lane & 15) * 8;
        const f32x4 g0 = *(const f32x4*)(INF(I_AHG) + e0), g1 = *(const f32x4*)(INF(I_AHG) + e0 + 4);
        for (int r0 = gw; r0 < MP; r0 += 8 * NGW) {
            v4u av[8], bv[8];
#pragma unroll
            for (int k = 0; k < 8; ++k) { const int r = r0 + k * NGW; if (r < MP) { av[k] = *(const v4u*)(P_O2 + (size_t)r * 1024 + hh * 128 + e0); bv[k] = *(const v4u*)(P_O2 + (size_t)r * 1024 + 512 + hh * 128 + e0); } }
#pragma unroll
            for (int k = 0; k < 8; ++k) { const int r = r0 + k * NGW; if (r < MP) { const v4u a = av[k], b = bv[k];
            const unsigned aw[4] = {a.x, a.y, a.z, a.w}, bw[4] = {b.x, b.y, b.z, b.w}; float d[8]; float q = 0.f;
#pragma unroll
            for (int i = 0; i < 4; ++i) { d[2 * i] = bf2f(aw[i] & 0xffffu) - lam * bf2f(bw[i] & 0xffffu); d[2 * i + 1] = bf2f(aw[i] >> 16) - lam * bf2f(bw[i] >> 16); q += d[2 * i] * d[2 * i] + d[2 * i + 1] * d[2 * i + 1]; }
            q = row16_sum(q);
            const float rs = rsqrtf(q * (1.f / 128.f) + EPS) * osc;
            f32x4 o0, o1;
#pragma unroll
            for (int i = 0; i < 4; ++i) { o0[i] = d[i] * rs * g0[i]; o1[i] = d[4 + i] * rs * g1[i]; }
            *(v4u*)(P_MIX + (size_t)r * 1024 + hh * 128 + e0) = pack8(o0, o1); } }
        }
    }
    {
        const int jh = lane >> 5, el = lane & 31, e0 = el * 4;
        const f32x4 hg = *(const f32x4*)(INF(I_AHG) + e0);
        for (int it = gw; it < NS * 4 * 8; it += NGW) {
            const int n = it >> 5, h = (it >> 3) & 3;
            const float* pbase = P_PART + ((size_t)(n * 4 + h) * NSPLIT * 16) * PSTR;
            { const int q = it & 7;
                const int row = jh * 8 + q;
                float ms[NSPLIT], ls[NSPLIT]; float M = -1e30f;
#pragma unroll
                for (int s = 0; s < NSPLIT; ++s) { const float* pr = pbase + ((size_t)s * 16 + row) * PSTR; ms[s] = pr[128]; ls[s] = pr[129]; M = fmaxf(M, ms[s]); }
                const unsigned qw = *(const unsigned*)(P_Q + (size_t)(MP + n * 8 + q) * 512 + (h * 2 + jh) * 64 + el * 2);
                const float q0 = bf2f(qw & 0xffffu), q1 = bf2f(qw >> 16);
                float sc[8];
#pragma unroll
                for (int t = 0; t < 8; ++t) { const f32x2 kv = *(const f32x2*)(C.out + O_KS + (size_t)(n * 8 + t) * 512 + (h * 2 + jh) * 64 + el * 2);
                    float d = row16_sum(q0 * kv.x + q1 * kv.y); d += __shfl_xor(d, 16);
                    sc[t] = (t <= q) ? d : -1e30f; M = fmaxf(M, sc[t]); }
                float L = 0.f; f32x4 O = (f32x4){0.f, 0.f, 0.f, 0.f};
#pragma unroll
                for (int s = 0; s < NSPLIT; ++s) { const float w = exp2f(ms[s] - M); L += ls[s] * w; O = O + *(const f32x4*)(pbase + ((size_t)s * 16 + row) * PSTR + e0) * w; }
#pragma unroll
                for (int t = 0; t < 8; ++t) { const float p = (t <= q) ? exp2f(sc[t] - M) : 0.f; L += p; O = O + *(const f32x4*)(C.out + O_VS + (size_t)(n * 8 + t) * 512 + h * 128 + e0) * p; }
                O = O * (1.f / L);
                f32x4 other;
#pragma unroll
                for (int i = 0; i < 4; ++i) other[i] = __shfl_xor(O[i], 32);
                f32x4 att = (jh == 0) ? (O - other * lam) : (other - O * lam);
                float qq = (att[0] * att[0] + att[1] * att[1]) + (att[2] * att[2] + att[3] * att[3]);
                qq = row16_sum(qq); qq += __shfl_xor(qq, 16);
                const float rs = rsqrtf(qq * (1.f / 128.f) + EPS) * osc;
                if (jh == 0) { u32x2 w; w.x = pk2(att[0] * rs * hg[0], att[1] * rs * hg[1]); w.y = pk2(att[2] * rs * hg[2], att[3] * rs * hg[3]);
                    *(u32x2*)(P_MIX + (size_t)(MP + n * 8 + q) * 1024 + h * 128 + e0) = w; }
            }
        }
    }
}

__device__ __forceinline__ void sincos_f(float x, float& sn, float& cs) {
    const float k = rintf(x * 0.63661977236758134f);
    float r = fmaf(-k, 1.5707963705062866f, x); r = fmaf(-k, -4.3711388286737929e-8f, r);
    const float r2 = r * r;
    const float s = r + r * r2 * (-1.6666654611e-1f + r2 * (8.3321608736e-3f + r2 * (-1.9515295891e-4f)));
    const float c = 1.f - 0.5f * r2 + r2 * r2 * (4.166664568298827e-2f + r2 * (-1.388731625493765e-3f + r2 * 2.443315711809948e-5f));
    const int qd = ((int)k) & 3;
    sn = (qd == 0) ? s : (qd == 1) ? c : (qd == 2) ? -s : -c;
    cs = (qd == 0) ? c : (qd == 1) ? -s : (qd == 2) ? -c : s;
}
__device__ __forceinline__ void s5_consts(const Args& A, int g, int p, float& ar, float& ai, float& cr, float& ci) {
    const float dt = expf(INF(I_CLDT)[g]), are = INF(I_CARE)[g * 64 + p], aim = INF(I_CAIM)[g * 64 + p];
    const float mag = expf(dt * are); float sn, cs; sincos_f(dt * aim, sn, cs);
    ar = mag * cs; ai = mag * sn;
    const float den = are * are + aim * aim, nr = ar - 1.f;
    cr = (nr * are + ai * aim) / den; ci = (ai * are - nr * aim) / den;
}
template <bool SAMPLE>
__device__ __forceinline__ void s5_item(const Args& A, Ctx& C, int bi, int g) {
    LAS float* BU = (LAS float*)(C.lds);
    LAS bf16* S16 = (LAS bf16*)(C.lds + 67584);
    LAS bf16* UB = (LAS bf16*)(C.lds + 67584 + 34816);
    LAS f32x2* Lc = (LAS f32x2*)(C.lds + 67584 + 34816 + 20480);
    LAS f32x2* Ic = Lc + 896;
    static_assert(67584 + 34816 + 20480 + 7168 + 1024 <= RING_BYTES, "S5 LDS map");
    const int p = C.tid & 63, sub = C.wave, lane = C.lane, m16 = lane & 15, quad = lane >> 4;
    float ar, ai;
    { float cr, ci; s5_consts(A, g, p, ar, ai, cr, ci); ((LAS f32x2*)BU)[sub * 64 + p] = (f32x2){cr, ci}; }
    asm volatile("s_waitcnt lgkmcnt(0)" ::: "memory");
    bf16x4 bh[8];
#pragma unroll
    for (int nt = 0; nt < 8; ++nt) { const int n = nt * 16 + m16, pn = n >> 1; const f32x2 cc = ((const LAS f32x2*)BU)[sub * 64 + pn]; const float cr = cc.x, ci = cc.y;
      const f32x4 r0 = *(const f32x4*)(INF(I_CBRE) + ((size_t)g * 64 + pn) * 16 + quad * 4), i0 = *(const f32x4*)(INF(I_CBIM) + ((size_t)g * 64 + pn) * 16 + quad * 4);
      const f32x4 x0 = ((n & 1) == 0) ? (r0 * cr - i0 * ci) : (i0 * cr + r0 * ci);
      u32x2 w; w.x = pk2(x0[0], x0[1]); w.y = pk2(x0[2], x0[3]); bh[nt] = __builtin_bit_cast(bf16x4, w); }
    LDS_BAR();
    bf16x8 cf[4];
#pragma unroll
    for (int ks = 0; ks < 4; ++ks) { const size_t co = ((size_t)g * 16 + m16) * 64 + ks * 16 + quad * 4;
        const f32x4 xr = *(const f32x4*)(INF(I_CCRE) + co), xi = *(const f32x4*)(INF(I_CCIM) + co);
        cf[ks] = cvt8((f32x4){xr[0], -xi[0], xr[1], -xi[1]}, (f32x4){xr[2], -xi[2], xr[3], -xi[3]}); }
    const float dch = INF(I_CD)[g * 16 + m16];
    const size_t gbase = SAMPLE ? (size_t)MP + bi * 128 : (size_t)bi * SEQ;
    const int urow = C.tid >> 2, uq = (C.tid & 3) * 4;
    u32x2 uqv[4];
#define WAVE_LDS() asm volatile("s_waitcnt lgkmcnt(0)" ::: "memory")
#define S5_LOAD(j, chn) uqv[j] = *(const u32x2*)(P_U + (gbase + (size_t)(chn) * 128 + urow) * 512 + g * 16 + uq)
#define S5_PUT_U(buf, j) do { *(LAS u32x2*)(UB + (buf) * 2560 + urow * 20 + uq) = uqv[j]; } while (0)
#define S5_BP(buf) do { const bf16x4 ua = *(const LAS bf16x4*)(UB + (buf) * 2560 + (sub * 16 + m16) * 20 + quad * 4); \
        _Pragma("unroll") for (int nt = 0; nt < 8; ++nt) { \
            const f32x4 acc = __builtin_amdgcn_mfma_f32_16x16x16bf16_1k(ua, bh[nt], (f32x4){0.f, 0.f, 0.f, 0.f}, 0, 0, 0); \
            _Pragma("unroll") for (int i = 0; i < 4; ++i) BU[(sub * 16 + quad * 4 + i) * 132 + nt * 16 + m16] = acc[i]; } } while (0)
#define S5_CP(buf, grow0_) do { f32x4 acc = (f32x4){0.f, 0.f, 0.f, 0.f}; \
        _Pragma("unroll") for (int ks = 0; ks < 4; ++ks) acc = __builtin_amdgcn_mfma_f32_16x16x32_bf16(*(const LAS bf16x8*)(S16 + (sub * 16 + m16) * 136 + ks * 32 + quad * 8), cf[ks], acc, 0, 0, 0); \
        _Pragma("unroll") for (int i = 0; i < 4; ++i) { const int t = sub * 16 + quad * 4 + i; \
            const float y = acc[i] + dch * bf2f(UB[(buf) * 2560 + t * 20 + m16]); P_Z[((grow0_) + t) * 512 + g * 16 + m16] = (bf16)(pk2(gelu_tanh_f(y), 0.f) & 0xffffu); } } while (0)
#define S5_STEP1(sr_, si_, vx_, vy_) do { const float nr_ = fmaf(ar, sr_, fmaf(-ai, si_, (vx_))), ni_ = fmaf(ar, si_, fmaf(ai, sr_, (vy_))); sr_ = nr_; si_ = ni_; } while (0)
    if (SAMPLE) {
        S5_LOAD(0, 0); S5_PUT_U(0, 0);
        WAVE_LDS();
        S5_BP(0);
        WAVE_LDS();
#pragma unroll
        for (int s2 = 0; s2 < 2; ++s2) { const int sl = sub * 2 + s2, n = bi * 16 + sl;
            float sr = INF(I_SCRE)[(size_t)(n * 32 + g) * 64 + p], si = INF(I_SCIM)[(size_t)(n * 32 + g) * 64 + p];
#pragma unroll
            for (int t8 = 0; t8 < 8; ++t8) { const int t = sl * 8 + t8; const f32x2 v = *(const LAS f32x2*)(BU + t * 132 + 2 * p); S5_STEP1(sr, si, v.x, v.y);
                *(LAS unsigned*)(S16 + t * 136 + 2 * p) = pk2(sr, si); }
            C.out[O_CRES + (size_t)(n * 32 + g) * 64 + p] = sr; C.out[O_CIMS + (size_t)(n * 32 + g) * 64 + p] = si; }
        WAVE_LDS();
        S5_CP(0, gbase);
    } else {
        float pwr[16], pwi[16];
        pwr[0] = ar; pwi[0] = ai;
#pragma unroll
        for (int k = 1; k < 16; ++k) { pwr[k] = pwr[k - 1] * ar - pwi[k - 1] * ai; pwi[k] = pwr[k - 1] * ai + pwi[k - 1] * ar; }
        if (C.tid < 128) Ic[C.tid] = (f32x2){0.f, 0.f};
        float slr[16], sli[16];
#define S5_SCAN_A(lbuf) do { float sr = 0.f, si = 0.f; \
        _Pragma("unroll") for (int k = 0; k < 16; ++k) { const f32x2 v = *(const LAS f32x2*)(BU + (sub * 16 + k) * 132 + 2 * p); S5_STEP1(sr, si, v.x, v.y); slr[k] = sr; sli[k] = si; } \
        if (sub < 7) Lc[(lbuf) * 448 + sub * 64 + p] = (f32x2){sr, si}; } while (0)
#define S5_CARRY_B(cur_, ch_) do { const f32x2 q0 = Ic[(cur_) * 64 + p]; float qr = q0.x, qi = q0.y; \
        _Pragma("unroll") for (int k2 = 0; k2 < 7; ++k2) { const f32x2 l_ = Lc[(cur_) * 448 + k2 * 64 + p]; const float nr_ = fmaf(pwr[15], qr, fmaf(-pwi[15], qi, l_.x)), ni_ = fmaf(pwr[15], qi, fmaf(pwi[15], qr, l_.y)); qr = (k2 < sub) ? nr_ : qr; qi = (k2 < sub) ? ni_ : qi; } \
        float sr = 0.f, si = 0.f; \
        _Pragma("unroll") for (int k = 0; k < 16; ++k) { const int t = sub * 16 + k; sr = fmaf(pwr[k], qr, fmaf(-pwi[k], qi, slr[k])); si = fmaf(pwr[k], qi, fmaf(pwi[k], qr, sli[k])); \
            *(LAS unsigned*)(S16 + t * 136 + 2 * p) = pk2(sr, si); } \
        if (sub == 7) { Ic[((cur_) ^ 1) * 64 + p] = (f32x2){sr, si}; \
            if ((ch_) == 31) { C.out[O_CREP + (size_t)(bi * 32 + g) * 64 + p] = sr; C.out[O_CIMP + (size_t)(bi * 32 + g) * 64 + p] = si; } } } while (0)
        S5_LOAD(0, 0); S5_LOAD(1, 1); S5_LOAD(2, 2); S5_LOAD(3, 3);
        S5_PUT_U(0, 0); S5_PUT_U(1, 1);
        S5_LOAD(0, 4); S5_LOAD(1, 5);
        WAVE_LDS();
        S5_BP(0);
        WAVE_LDS();
#pragma unroll 1
        for (int c4 = 0; c4 < 32; c4 += 4) {
#define S5_STEP(J_) do { const int ch = c4 + (J_); constexpr int cur = (J_) & 1; \
            S5_SCAN_A(cur); \
            if (ch + 1 < 32) { S5_BP(cur ^ 1); } \
            LDS_BAR(); \
            S5_CARRY_B(cur, ch); \
            WAVE_LDS(); \
            S5_CP(cur, gbase + (size_t)ch * 128); \
            if (ch + 2 < 32) S5_PUT_U(cur, ((J_) + 2) & 3); \
            if (ch + 6 < 32) S5_LOAD(((J_) + 2) & 3, ch + 6); \
            } while (0)
            S5_STEP(0); S5_STEP(1); S5_STEP(2); S5_STEP(3);
#undef S5_STEP
        }
#undef S5_SCAN_A
#undef S5_CARRY_B
    }
    LDS_BAR();
#undef S5_STEP1
#undef S5_BP
#undef S5_CP
#undef S5_PUT_U
#undef S5_LOAD
#undef WAVE_LDS
}

template <bool SAMPLE>
__device__ __forceinline__ void conf_item(const Args& A, Ctx& C, int bi, int tb) {
    constexpr int NT = SAMPLE ? 8 : 16, NI = NT + 30;
    LAS float* L = (LAS float*)(C.lds);
    LAS float* Cc = (LAS float*)(C.lds + 94208);
    const int c = C.tid;
    float w[31];
#pragma unroll
    for (int k = 0; k < 31; ++k) w[k] = INF(I_DCW)[k * 512 + c];
    const float cb = INF(I_DCB)[c];
    const int t0 = tb * 16;
#pragma unroll
    for (int e0 = 0; e0 < NI * 128; e0 += NTHR) { const int e = e0 + C.tid; if (e >= NI * 128) break; const int i = e >> 7, q4 = (e & 127) * 4; f32x4 v;
        if (!SAMPLE) { v = (f32x4){0.f, 0.f, 0.f, 0.f}; }
        else { if (i < 30) { v = *(const f32x4*)(INF(I_SCD) + (size_t)(bi * 30 + i) * 512 + q4); if (i >= 8) *(f32x4*)(C.out + O_CDS + (size_t)(bi * 30 + (i - 8)) * 512 + q4) = v; }
            else { const u32x2 w = *(const u32x2*)(P_GG + (size_t)(MP + bi * 8 + (i - 30)) * 512 + q4); v = (f32x4){__uint_as_float(w.x << 16), __uint_as_float(w.x & 0xffff0000u), __uint_as_float(w.y << 16), __uint_as_float(w.y & 0xffff0000u)}; } }
        *(LAS f32x4*)(L + i * 512 + q4) = v; }
    LDS_BAR();
#pragma unroll 1
    for (int t = 0; t < NT; t += 2) { float a0 = cb, a1 = cb; const LAS float* lp = L + t * 512 + c;
#pragma unroll
        for (int k = 0; k < 32; ++k) { const float x = lp[k * 512]; if (k < 31) a0 += w[k] * x; if (k >= 1) a1 += w[k - 1] * x; }
        Cc[t * 512 + c] = a0; Cc[(t + 1) * 512 + c] = a1; }
    LDS_BAR();
    { const int lane = C.lane; const f32x4 g0 = *(const f32x4*)(INF(I_DLNG) + lane * 8), g1 = *(const f32x4*)(INF(I_DLNG) + lane * 8 + 4), b0 = *(const f32x4*)(INF(I_DLNB) + lane * 8), b1 = *(const f32x4*)(INF(I_DLNB) + lane * 8 + 4);
      constexpr int TPW = NT / 8;
#pragma unroll 1
      for (int k = 0; k < TPW; ++k) { const int t = C.wave * TPW + k;
          f32x4 x0 = *(const LAS f32x4*)(Cc + t * 512 + lane * 8), x1 = *(const LAS f32x4*)(Cc + t * 512 + lane * 8 + 4);
          const float mean = wave_sum((x0[0] + x0[1]) + (x0[2] + x0[3]) + (x1[0] + x1[1]) + (x1[2] + x1[3])) * (1.f / 512.f);
          x0 = x0 - mean; x1 = x1 - mean;
          const float var = wave_sum((x0[0] * x0[0] + x0[1] * x0[1]) + (x0[2] * x0[2] + x0[3] * x0[3]) + (x1[0] * x1[0] + x1[1] * x1[1]) + (x1[2] * x1[2] + x1[3] * x1[3])) * (1.f / 512.f);
          const float rs = rsqrtf(var + EPS); f32x4 o0, o1;
#pragma unroll
          for (int i = 0; i < 4; ++i) { const float y0 = x0[i] * rs * g0[i] + b0[i], y1 = x1[i] * rs * g1[i] + b1[i]; o0[i] = y0 * sigmoid_f(y0); o1[i] = y1 * sigmoid_f(y1); }
          const size_t row = SAMPLE ? (size_t)MP + bi * 8 + t : (size_t)bi * SEQ + t0 + t;
          *(v4u*)(P_MIX + row * 1024 + 512 + lane * 8) = pack8(o0, o1); } }
    LDS_BAR();
}

__device__ __forceinline__ void conf_item_p(const Args& A, Ctx& C, int bi, int tb) {
    constexpr int NT = 32, NI = NT + 30;
    LAS bf16* L = (LAS bf16*)(C.lds);
    LAS float* Cc = (LAS float*)(C.lds + 65536);
    const int cp = C.tid & 255, th = C.tid >> 8;
    const int t0 = tb * NT;
    { const bf16* gb_ = P_GG + (size_t)bi * SEQ * 512; asm volatile("" : "+s"(gb_));
#pragma unroll
      for (int e0 = 0; e0 < NI * 64; e0 += NTHR) { const int e = e0 + C.tid; if (e >= NI * 64) break; const int i = e >> 6, q8 = (e & 63) * 8; const int tk = t0 - 30 + i;
        v4u v = *(const v4u*)(gb_ + (unsigned)((tk < 0 ? 0 : tk) * 512 + q8)); if (tk < 0) v = (v4u){0u, 0u, 0u, 0u};
        *(LAS v4u*)(L + e * 8) = v; } }
    f32x2 wv[31];
#pragma unroll
    for (int k = 0; k < 31; ++k) wv[k] = *(const f32x2*)(INF(I_DCW) + k * 512 + 2 * cp);
    const f32x2 cb = *(const f32x2*)(INF(I_DCB) + 2 * cp);
    LDS_BAR();
#pragma unroll 1
    for (int r = 0; r < 2; ++r) { f32x2 a[8];
#pragma unroll
        for (int t = 0; t < 8; ++t) a[t] = cb;
        const LAS bf16* lp = L + (th * 16 + r * 8) * 512 + 2 * cp;
#pragma unroll
        for (int j = 0; j < 38; ++j) { const unsigned xb = *(const LAS unsigned*)(lp + j * 512); const f32x2 x = {__uint_as_float(xb << 16), __uint_as_float(xb & 0xffff0000u)};
#pragma unroll
            for (int t = 0; t < 8; ++t) if (j - t >= 0 && j - t <= 30) a[t] = __builtin_elementwise_fma(wv[j - t], x, a[t]); }
#pragma unroll
        for (int t = 0; t < 8; ++t) *(LAS f32x2*)(Cc + (th * 16 + r * 8 + t) * 512 + 2 * cp) = a[t]; }
    LDS_BAR();
    { const int lane = C.lane; const f32x4 g0 = *(const f32x4*)(INF(I_DLNG) + lane * 8), g1 = *(const f32x4*)(INF(I_DLNG) + lane * 8 + 4), b0 = *(const f32x4*)(INF(I_DLNB) + lane * 8), b1 = *(const f32x4*)(INF(I_DLNB) + lane * 8 + 4);
#pragma unroll 1
      for (int k = 0; k < NT / 8; ++k) { const int t = C.wave * (NT / 8) + k;
          f32x4 x0 = *(const LAS f32x4*)(Cc + t * 512 + lane * 8), x1 = *(const LAS f32x4*)(Cc + t * 512 + lane * 8 + 4);
          const float mean = wave_sum((x0[0] + x0[1]) + (x0[2] + x0[3]) + (x1[0] + x1[1]) + (x1[2] + x1[3])) * (1.f / 512.f);
          x0 = x0 - mean; x1 = x1 - mean;
          const float var = wave_sum((x0[0] * x0[0] + x0[1] * x0[1]) + (x0[2] * x0[2] + x0[3] * x0[3]) + (x1[0] * x1[0] + x1[1] * x1[1]) + (x1[2] * x1[2] + x1[3] * x1[3])) * (1.f / 512.f);
          const float rs = rsqrtf(var + EPS); f32x4 o0, o1;
#pragma unroll
          for (int i = 0; i < 4; ++i) { const float y0 = x0[i] * rs * g0[i] + b0[i], y1 = x1[i] * rs * g1[i] + b1[i]; o0[i] = y0 * sigmoid_f(y0); o1[i] = y1 * sigmoid_f(y1); }
          const size_t row = (size_t)bi * SEQ + t0 + t;
          *(v4u*)(P_MIX + row * 1024 + 512 + lane * 8) = pack8(o0, o1); } }
    LDS_BAR();
}

#ifndef MK_N_LAUNCHES
#define MK_N_LAUNCHES 1
#endif
constexpr int N_PHASES = 17;
constexpr int N_LAUNCHES = MK_N_LAUNCHES;
static_assert(N_LAUNCHES == 1 || N_LAUNCHES == N_PHASES, "MK_N_LAUNCHES is 1 or 17");
#ifndef MK_GRP_A
#define MK_GRP_A 4
#endif

#define Q_LOOP(cw, N, var, ...) do { for (;;) { __syncthreads(); if (C.tid == 0) C.MISC[16] = __hip_atomic_fetch_add(C.ctl + (cw), 1u, RLX_AGENT); __syncthreads(); \
            const int var = (int)__builtin_amdgcn_readfirstlane(C.MISC[16]); if (var >= (N)) break; \
            __VA_ARGS__ } } while (0)

template <int LO, int HI> __global__ void __launch_bounds__(NTHR, 2) mega_fwd(Args args) {
    extern __shared__ __attribute__((aligned(16))) unsigned char lds[];
    const Args& A = args;
    Ctx C;
    C.lds = (LAS unsigned char*)lds; C.MISC = (volatile LAS unsigned*)(C.lds + MISC_OFF);
    C.tid = threadIdx.x; C.lane = C.tid & 63; C.wave = __builtin_amdgcn_readfirstlane(C.tid >> 6);
    C.G = gridDim.x; { const int bx = blockIdx.x; C.vcu = (C.G % 8 == 0) ? (bx % 8) * (C.G / 8) + bx / 8 : bx; }
    GAS unsigned char* ws = (GAS unsigned char*)args.ws; C.ws = ws; C.out = (GAS float*)args.out; C.ctl = (gu32*)(ws + WS_CTL);
    for (int u = C.tid; u < (LDS_BYTES - LDSCTL_OFF) / 4; u += NTHR) ((LAS unsigned*)(C.lds + LDSCTL_OFF))[u] = 0u;
    __syncthreads();
    XcdBarrier bar; bar.bar = (unsigned*)(C.ctl + CW_BAR); bar.x = 0; bar.st = nullptr;
    if (HI - LO > 1) bar = xcd_barrier_post((unsigned*)(C.ctl + CW_BAR), C.MISC + 8);
#define IN(k) (LO <= (k) && (k) < HI)
#define PH(k) if (IN(k))
#define END_PH(k) do { if (IN(k) && IN((k) + 1)) xcd_barrier(bar); } while (0)
    LAS unsigned char* ring = C.lds + RING_OFF;
    GAS float* X = C.out;
#define PHASE_BEGIN() do { int t_ = threadIdx.x; asm volatile("" : "+v"(t_)); C.tid = t_; C.lane = t_ & 63; C.wave = __builtin_amdgcn_readfirstlane(t_ >> 6); \
        unsigned char* w_ = args.ws; asm volatile("" : "+s"(w_)); C.ws = (GAS unsigned char*)w_; ws = C.ws; C.ctl = (gu32*)C.ws; float* o_ = args.out; asm volatile("" : "+s"(o_)); C.out = (GAS float*)o_; X = C.out; } while (0)

    PH(0) { PHASE_BEGIN(); p0_prologue(args, C); END_PH(0); }

#define FFN_UP(ph, mi, cslot) PH(ph) { PHASE_BEGIN(); pg8::Gemm g{P_XB, (const bf16*)(GAS bf16*)(ws + WS_WGU + (mi) * WGU_BYTES), MT, NGU, 1024}; pg8::StaticOrder S; S.init(MT, NGU, C.G, (int)blockIdx.x); \
        LAS float* tab_ = (LAS float*)(C.lds + RSTAB_OFF); EpiSwiGLU E{P_SS, P_H, tab_}; pg8::gemm_phase<EpiSwiGLU, pg8::StaticOrder, true, true>(ring, g, S, E); \
        if ((cslot) >= 0) { const int nwg_ = (MT / 256) * (NGU / 256), rounds_ = (nwg_ + C.G - 1) / C.G, first_idle_ = nwg_ - (rounds_ - 1) * C.G;     \
            if ((int)blockIdx.x >= first_idle_) { PHASE_BEGIN(); conv_run<((cslot) < 0 ? 1 : (cslot))>(args, C, ((int)blockIdx.x - first_idle_) * NWAVES + C.wave, (C.G - first_idle_) * NWAVES); } } \
        END_PH(ph); }
#define GEMM_RESID(ph, Aptr, KK, Wptr, scale, wxb, XinP, XinS) PH(ph) { PHASE_BEGIN(); pg8::Gemm g{Aptr, Wptr, MP, 1024, KK}; pg8::StaticOrder S; S.init(MP, 1024, C.G, (int)blockIdx.x); \
        EpiResid E{XinP, X, P_XB, P_SS, scale, 1.f / (scale), wxb}; pg8::gemm_phase<EpiResid, pg8::StaticOrder, true, true>(ring, g, S, E); \
        gemm_small_resid<KK>((Aptr) + (size_t)MP * (KK), Wptr, XinS, X + (size_t)MP * 1024, P_XB + (size_t)MP * 1024, P_SS + (size_t)MP * 16, scale, (wxb) != 0, ring, C.G, (int)blockIdx.x, C.tid); \
        END_PH(ph); }

    FFN_UP(1, 0, 1)
    GEMM_RESID(2, P_H, FFP, (const bf16*)(GAS bf16*)(ws + WS_WDN + 0 * WDN_BYTES), 0.5f, 1, (const GAS float*)args.in[I_XP], (const GAS float*)args.in[I_XS])
    PH(3) { PHASE_BEGIN(); pg8::Gemm g{P_XB, (const bf16*)(GAS bf16*)(ws + WS_WIE), MT, NIE, 1024}; pg8::StaticOrder S; S.init(MT, NIE, C.G, (int)blockIdx.x);
        LAS float* tab_ = (LAS float*)(C.lds + RSTAB_OFF);
        EpiInEven E{P_SS, P_Q, P_K, P_V, P_XBF, P_GBF, (float*)(C.out + O_KP), (float*)(C.out + O_VP), (float*)(C.out + O_KS), (float*)(C.out + O_VS), (float*)(C.out + O_CBP), (float*)(C.out + O_CBS), tab_, INF(I_AQG), INF(I_AKG)};
        pg8::gemm_phase<EpiInEven, pg8::StaticOrder, true, true>(ring, g, S, E); END_PH(3); }
    PH(4) {
        const bool grp_a = (int)((blockIdx.x >> 3) & 7) < MK_GRP_A;
#pragma unroll 1
        for (int pass = 0; pass < 2; ++pass) {
            PHASE_BEGIN();
            if (pass == 1 || grp_a) Q_LOOP(CW_Q0 + 128, 256, a, sattn_wave(args, C, a >> 3, (a >> 1) & 3, (a & 1) * 8 + C.wave););
            if (pass == 0) {
                PHASE_BEGIN();
                Q_LOOP(CW_Q0 + 64, 1024, a, { const int b = a >> 8, qb = 15 - ((a >> 4) & 15), vh = a & 15, h = vh >> 2, j = (vh >> 1) & 1, half = vh & 1;
                    attn_body::attn_unit<8>(b, (h * 2 + j) * 64, h * 128 + half * 64, j * 512 + h * 128 + half * 64, qb, (const attn_body::bf16*)P_Q, (const attn_body::bf16*)P_K, (const attn_body::bf16*)P_V, (attn_body::bf16*)P_O2, (char*)lds + RING_OFF); });
                PHASE_BEGIN();
                Q_LOOP(CW_Q0 + 192, 16, a, rglru_item<true>(args, C, a & 1, 0, a >> 1););
                PHASE_BEGIN();
                Q_LOOP(CW_Q0, 1024, it, rglru_item<false>(args, C, it >> 8, (it >> 3) & 31, it & 7););
            }
        }
        END_PH(4);
    }
    PH(5) { PHASE_BEGIN(); p5_combine(args, C); END_PH(5); }
    GEMM_RESID(6, P_MIX, 1024, (const bf16*)(GAS bf16*)(ws + WS_WOE), 1.0f, 1, (const GAS float*)X, (const GAS float*)(X + (size_t)MP * 1024))
    FFN_UP(7, 1, 2)
    GEMM_RESID(8, P_H, FFP, (const bf16*)(GAS bf16*)(ws + WS_WDN + 1 * WDN_BYTES), 0.5f, 1, (const GAS float*)X, (const GAS float*)(X + (size_t)MP * 1024))

    FFN_UP(9, 2, 3)
    GEMM_RESID(10, P_H, FFP, (const bf16*)(GAS bf16*)(ws + WS_WDN + 2 * WDN_BYTES), 0.5f, 1, (const GAS float*)X, (const GAS float*)(X + (size_t)MP * 1024))
    PH(11) { PHASE_BEGIN(); pg8::Gemm g{P_XB, (const bf16*)(GAS bf16*)(ws + WS_WIO), MT, NIO, 1024}; pg8::StaticOrder S; S.init(MT, NIO, C.G, (int)blockIdx.x);
        LAS float* tab_ = (LAS float*)(C.lds + RSTAB_OFF); EpiInOdd E{P_SS, P_U, P_GG, tab_, (float*)(C.out + O_CDP), (float*)(C.out + O_CDS)}; pg8::gemm_phase<EpiInOdd, pg8::StaticOrder, true, true>(ring, g, S, E); END_PH(11); }
    PH(12) {
        PHASE_BEGIN();
        Q_LOOP(CW_Q1, 128, it, s5_item<false>(args, C, it >> 5, it & 31););
        PHASE_BEGIN();
        Q_LOOP(CW_Q1 + 64, 64, a, s5_item<true>(args, C, a & 1, a >> 1););
        PHASE_BEGIN();
        Q_LOOP(CW_Q1 + 192, 32, a, conf_item<true>(args, C, a, 0););
        PHASE_BEGIN();
        Q_LOOP(CW_Q1 + 128, 512, a, conf_item_p(args, C, a >> 7, a & 127););
        END_PH(12);
    }
    PH(13) { PHASE_BEGIN(); pg8::Gemm g{P_Z, (const bf16*)(GAS bf16*)(ws + WS_WGLU), MT, 512, 512}; pg8::StaticOrder S; S.init(MT, 512, C.G, (int)blockIdx.x);
        EpiGLU E{P_Z, P_MIX, INF(I_CGLUB)}; pg8::gemm_phase<EpiGLU, pg8::StaticOrder, true, true>(ring, g, S, E); END_PH(13); }
    GEMM_RESID(14, P_MIX, 1024, (const bf16*)(GAS bf16*)(ws + WS_WOO), 1.0f, 1, (const GAS float*)X, (const GAS float*)(X + (size_t)MP * 1024))
    FFN_UP(15, 3, -1)
    GEMM_RESID(16, P_H, FFP, (const bf16*)(GAS bf16*)(ws + WS_WDN + 3 * WDN_BYTES), 0.5f, 0, (const GAS float*)X, (const GAS float*)(X + (size_t)MP * 1024))
#undef IN
#undef PH
#undef END_PH
#undef PHASE_BEGIN
#undef FFN_UP
#undef GEMM_RESID
}

template <int K> static bool setup_one() {
    int per_cu = 0;
    if (hipFuncSetAttribute((const void*)mega_fwd<K, (N_LAUNCHES == 1 ? N_PHASES : K + 1)>, hipFuncAttributeMaxDynamicSharedMemorySize, LDS_BYTES) != hipSuccess) { fprintf(stderr, "kernel_launch: hipFuncSetAttribute failed\n"); return false; }
    if (hipOccupancyMaxActiveBlocksPerMultiprocessor(&per_cu, (const void*)mega_fwd<K, (N_LAUNCHES == 1 ? N_PHASES : K + 1)>, NTHR, LDS_BYTES) != hipSuccess || per_cu < 1) fprintf(stderr, "kernel_launch: occupancy query reports %d workgroups per CU\n", per_cu);
    return true;
}
template <int K> static void launch_one(int grid, const Args& a, hipStream_t stream) {
    hipLaunchKernelGGL((mega_fwd<K, (N_LAUNCHES == 1 ? N_PHASES : K + 1)>), dim3(grid), dim3(NTHR), LDS_BYTES, stream, a);
    const hipError_t le = hipPeekAtLastError();
    if (le != hipSuccess) fprintf(stderr, "kernel_launch: launch %d failed: %s\n", K, hipGetErrorName(le));
}
template <int K> struct Seq {
    static bool setup() { if (!setup_one<K>()) return false; if (N_LAUNCHES == 1) return true; return Seq<K + 1>::setup(); }
    static void launch(int grid, const Args& a, hipStream_t stream) { launch_one<K>(grid, a, stream); if (N_LAUNCHES != 1) Seq<K + 1>::launch(grid, a, stream); }
};
template <> struct Seq<(N_LAUNCHES == 1 ? 1 : N_PHASES)> { static bool setup() { return true; } static void launch(int, const Args&, hipStream_t) {} };
static bool setup_all() { return Seq<0>::setup(); }
static void launch_all(int grid, const Args& a, hipStream_t stream) { Seq<0>::launch(grid, a, stream); }
extern "C" void kernel_launch(void* const* d_in, const int* in_sizes, int n_in, void* d_out, int out_size, void* d_ws, size_t ws_size, hipStream_t stream) {
    static int grid = 0;
    if (grid == 0) {
        if (n_in != 44 || out_size != (int)O_END || ws_size < WS_END) { fprintf(stderr, "kernel_launch: unexpected shapes: n_in %d out %d ws %zu; nothing launched\n", n_in, out_size, ws_size); grid = -1; return; }
        int dev = 0, cus = 0, per_cu = 0;
        if (hipGetDevice(&dev) != hipSuccess || hipDeviceGetAttribute(&cus, hipDeviceAttributeMultiprocessorCount, dev) != hipSuccess) { fprintf(stderr, "kernel_launch: device query failed\n"); grid = -1; return; }
        if (!setup_all()) { grid = -1; return; }
        (void)hipGetLastError();
        grid = cus;
    }
    if (grid < 0) return;
    if (hipMemsetAsync((char*)d_ws + WS_CTL, 0, CTL_ZERO_BYTES, stream) != hipSuccess) { fprintf(stderr, "kernel_launch: memset failed\n"); return; }
    Args a{};
    for (int i = 0; i < 44; ++i) a.in[i] = d_in[i];
    a.out = (float*)d_out; a.ws = (unsigned char*)d_ws;
    launch_all(grid, a, stream);
}
```
